# Optimizing an MI355X kernel written in HIP

```python
import jax
import jax.numpy as jnp
from jax import lax
import numpy as np

D_MODEL = 1024
BATCH = 2
SEQ = 8192
DEPTH = 2

HEAD_DIM = 64
BLOCK = 128
NORM_EPS = 1e-6
FOX_HEADS = 4
FORGET_BIAS_MEAN = 2.0
SWA_Q_HEADS = 4
SWA_KV_HEADS = 2
SWA_GROUP = SWA_Q_HEADS // SWA_KV_HEADS
SWA_WINDOW = 128
MLA_HEADS = 4
MLA_Q_LORA = 256
MLA_KV_LORA = 128
MLA_NOPE_DIM = 64
MLA_ROPE_DIM = 32
MLA_V_DIM = 64
ROPE_THETA = 10000.0
DIL_HEADS = 4
DIL_PATTERNS = ((128, 1), (512, 4), (2048, 16))
MIX_WIDTH = (FOX_HEADS + SWA_Q_HEADS + DIL_HEADS) * HEAD_DIM + MLA_HEADS * MLA_V_DIM
IN_SIZES = (
    FOX_HEADS * HEAD_DIM, FOX_HEADS * HEAD_DIM, FOX_HEADS * HEAD_DIM, FOX_HEADS,
    SWA_Q_HEADS * HEAD_DIM, SWA_KV_HEADS * HEAD_DIM, SWA_KV_HEADS * HEAD_DIM,
    MLA_Q_LORA, MLA_KV_LORA, MLA_ROPE_DIM,
    DIL_HEADS * HEAD_DIM, DIL_HEADS * HEAD_DIM, DIL_HEADS * HEAD_DIM,
)
N_IN = sum(IN_SIZES)
FFN_DIM = 3584
N_EXPERTS = 8
TOP_K = 2
N_DENSE = (DEPTH + 1) // 2
N_MOE = DEPTH // 2

kernel_name = "hybrid_parallel_heads_fox_swa_mla_dilated_moe"


def rms_norm(x, g):
    xf = x.astype(jnp.float32)
    y = xf * lax.rsqrt(jnp.mean(xf * xf, axis=-1, keepdims=True) + NORM_EPS)
    return (y * g.astype(jnp.float32)).astype(x.dtype)


def to_heads(t, n_heads):
    B, S, _ = t.shape
    return t.reshape(B, S, n_heads, -1).transpose(0, 2, 1, 3)


def from_heads(t):
    B, H, S, d = t.shape
    return t.transpose(0, 2, 1, 3).reshape(B, S, H * d)


def alibi_slopes():
    n = SWA_Q_HEADS + DIL_HEADS
    return 2.0 ** (-8.0 * jnp.arange(1, n + 1, dtype=jnp.float32) / n)


def rope(t, positions):
    half = t.shape[-1] // 2
    inv_freq = ROPE_THETA ** (-jnp.arange(half, dtype=jnp.float32) / half)
    ang = positions[:, None, :, None].astype(jnp.float32) * inv_freq
    cos, sin = jnp.cos(ang), jnp.sin(ang)
    t1 = t[..., :half].astype(jnp.float32)
    t2 = t[..., half:].astype(jnp.float32)
    return jnp.concatenate([t1 * cos - t2 * sin, t2 * cos + t1 * sin], axis=-1).astype(t.dtype)


def causal_dense_attention(q, k, v, scale, log_decay=None):
    B, H, S, dq = q.shape
    nb = S // BLOCK
    key_pos = jnp.arange(S)
    xs = {"i": jnp.arange(nb), "q": jnp.moveaxis(q.reshape(B, H, nb, BLOCK, dq), 2, 0)}
    if log_decay is not None:
        xs["d"] = jnp.moveaxis(log_decay.reshape(B, H, nb, BLOCK), 2, 0)

    def one_block(blk):
        s = jnp.einsum("bhqd,bhkd->bhqk", blk["q"], k).astype(jnp.float32) * scale
        if "d" in blk:
            s = s + blk["d"][..., :, None] - log_decay[..., None, :]
        q_pos = blk["i"] * BLOCK + jnp.arange(BLOCK)
        s = jnp.where(key_pos[None, :] <= q_pos[:, None], s, -jnp.inf)
        p = jax.nn.softmax(s, axis=-1)
        return jnp.einsum("bhqk,bhkd->bhqd", p.astype(v.dtype), v)

    out = lax.map(one_block, xs)
    return jnp.moveaxis(out, 0, 2).reshape(B, H, S, v.shape[-1])


def banded_attention(q, k, v, span, slopes, dist_unit, scale):
    B, K, G, L, dh = q.shape
    dv = v.shape[-1]
    nb = -(-L // BLOCK)
    pad = nb * BLOCK - L
    q = jnp.pad(q, ((0, 0), (0, 0), (0, 0), (0, pad), (0, 0))).reshape(B, K, G, nb, BLOCK, dh)
    kv_pad = ((0, 0), (0, 0), (BLOCK, pad), (0, 0))
    k = jnp.pad(k, kv_pad).reshape(B, K, nb + 1, BLOCK, dh)
    v = jnp.pad(v, kv_pad).reshape(B, K, nb + 1, BLOCK, dv)
    k_band = jnp.concatenate([k[:, :, :-1], k[:, :, 1:]], axis=3)
    v_band = jnp.concatenate([v[:, :, :-1], v[:, :, 1:]], axis=3)
    s = jnp.einsum("bkgnqd,bknjd->bkgnqj", q, k_band).astype(jnp.float32) * scale
    dist = BLOCK + jnp.arange(BLOCK)[:, None] - jnp.arange(2 * BLOCK)[None, :]
    key_idx = (jnp.arange(nb)[:, None] - 1) * BLOCK + jnp.arange(2 * BLOCK)[None, :]
    valid = ((dist >= 0) & (dist <= span))[None] & (key_idx >= 0)[:, None, :]
    s = s - slopes.astype(jnp.float32)[None, :, :, None, None, None] * (dist * dist_unit).astype(jnp.float32)
    s = jnp.where(valid, s, -jnp.inf)
    m = jnp.max(s, axis=-1, keepdims=True)
    p = jnp.exp(s - m)
    l = jnp.sum(p, axis=-1, keepdims=True)
    o = jnp.einsum("bkgnqj,bknjd->bkgnqd", (p / l).astype(v.dtype), v_band)
    lse = (m + jnp.log(l))[..., 0]
    o = o.reshape(B, K, G, nb * BLOCK, dv)[:, :, :, :L]
    lse = lse.reshape(B, K, G, nb * BLOCK)[:, :, :, :L]
    return o, lse


def fox_mixer(q, k, v, f_logit, b_forget):
    qh, kh, vh = to_heads(q, FOX_HEADS), to_heads(k, FOX_HEADS), to_heads(v, FOX_HEADS)
    log_f = jax.nn.log_sigmoid(f_logit.astype(jnp.float32) + b_forget.astype(jnp.float32))
    cum = jnp.cumsum(jnp.transpose(log_f, (0, 2, 1)), axis=-1)
    return from_heads(causal_dense_attention(qh, kh, vh, HEAD_DIM ** -0.5, cum))


def swa_sink_mixer(q, k, v, sink, slopes):
    B, S, _ = q.shape
    qh = q.reshape(B, S, SWA_KV_HEADS, SWA_GROUP, HEAD_DIM).transpose(0, 2, 3, 1, 4)
    kh, vh = to_heads(k, SWA_KV_HEADS), to_heads(v, SWA_KV_HEADS)
    o, lse = banded_attention(qh, kh, vh, SWA_WINDOW - 1,
                              slopes.reshape(SWA_KV_HEADS, SWA_GROUP), 1, HEAD_DIM ** -0.5)
    sink = sink.astype(jnp.float32).reshape(SWA_KV_HEADS, SWA_GROUP)[None, :, :, None]
    o = o * jax.nn.sigmoid(lse - sink)[..., None].astype(o.dtype)
    return o.transpose(0, 3, 1, 2, 4).reshape(B, S, SWA_Q_HEADS * HEAD_DIM)


def mla_mixer(c_q, c_kv, k_rope, positions, q_norm, w_q_up, kv_norm, w_kv_up):
    B, S, _ = c_q.shape
    q = to_heads(rms_norm(c_q, q_norm) @ w_q_up, MLA_HEADS)
    kv = to_heads(rms_norm(c_kv, kv_norm) @ w_kv_up, MLA_HEADS)
    q = jnp.concatenate([q[..., :MLA_NOPE_DIM], rope(q[..., MLA_NOPE_DIM:], positions)], axis=-1)
    k_r = rope(k_rope[:, None], positions)
    k = jnp.concatenate([kv[..., :MLA_NOPE_DIM],
                         jnp.broadcast_to(k_r, (B, MLA_HEADS, S, MLA_ROPE_DIM))], axis=-1)
    o = causal_dense_attention(q, k, kv[..., MLA_NOPE_DIM:], (MLA_NOPE_DIM + MLA_ROPE_DIM) ** -0.5)
    return from_heads(o)


def by_residue(t, dil):
    B, H, S, d = t.shape
    return t.reshape(B, H, S // dil, dil, d).transpose(0, 1, 3, 2, 4).reshape(B, H * dil, S // dil, d)


def dilated_mixer(q, k, v, slopes):
    B, S, _ = q.shape
    qh, kh, vh = to_heads(q, DIL_HEADS), to_heads(k, DIL_HEADS), to_heads(v, DIL_HEADS)
    outs, lses = [], []
    for window, dil in DIL_PATTERNS:
        L = S // dil
        o, lse = banded_attention(by_residue(qh, dil)[:, :, None], by_residue(kh, dil), by_residue(vh, dil),
                                  window // dil, jnp.repeat(slopes, dil)[:, None], dil, HEAD_DIM ** -0.5)
        outs.append(o[:, :, 0].reshape(B, DIL_HEADS, dil, L, HEAD_DIM).transpose(0, 1, 3, 2, 4)
                    .reshape(B, DIL_HEADS, S, HEAD_DIM))
        lses.append(lse[:, :, 0].reshape(B, DIL_HEADS, dil, L).transpose(0, 1, 3, 2).reshape(B, DIL_HEADS, S))
    w = jax.nn.softmax(jnp.stack(lses), axis=0)
    o = jnp.sum(w[..., None].astype(qh.dtype) * jnp.stack(outs), axis=0)
    return from_heads(o)


def swiglu(t, w_gate, w_up, w_down):
    return (jax.nn.silu(t @ w_gate) * (t @ w_up)) @ w_down


def moe_swiglu(h, router, w_gate, w_up, w_down):
    B, S, D = h.shape
    t = h.reshape(B * S, D)
    logits = (t @ router).astype(jnp.float32)
    top_val, top_idx = lax.top_k(logits, TOP_K)
    gates = jax.nn.softmax(top_val, axis=-1)
    combine = jnp.sum(jax.nn.one_hot(top_idx, N_EXPERTS, dtype=jnp.float32) * gates[..., None], axis=1)
    out = jnp.zeros_like(t)
    for e in range(N_EXPERTS):
        out = out + combine[:, e:e + 1].astype(t.dtype) * swiglu(t, w_gate[e], w_up[e], w_down[e])
    return out.reshape(B, S, D)


def setup_inputs(seed: int = 0) -> dict:
    key = jax.random.key(seed)
    ks = jax.random.split(key, 24)
    f32 = jnp.float32

    def nrm(k, shape, fan_in):
        return jax.random.normal(k, shape, f32) * fan_in ** -0.5

    def gain(k, shape):
        return 1.0 + 0.02 * jax.random.normal(k, shape, f32)

    x = jax.random.normal(ks[0], (BATCH, SEQ, D_MODEL), f32)
    start = jax.random.randint(ks[1], (BATCH, 1), 0, 1024, dtype=jnp.int32)
    positions = start + jnp.arange(SEQ, dtype=jnp.int32)[None, :]
    return {
        "x": x,
        "positions": positions,
        "attn_norm": gain(ks[2], (DEPTH, D_MODEL)),
        "w_in": nrm(ks[3], (DEPTH, D_MODEL, N_IN), D_MODEL),
        "b_forget": FORGET_BIAS_MEAN + 0.1 * jax.random.normal(ks[4], (DEPTH, FOX_HEADS), f32),
        "mla_q_norm": gain(ks[5], (DEPTH, MLA_Q_LORA)),
        "w_q_up": nrm(ks[6], (DEPTH, MLA_Q_LORA, MLA_HEADS * (MLA_NOPE_DIM + MLA_ROPE_DIM)), MLA_Q_LORA),
        "mla_kv_norm": gain(ks[7], (DEPTH, MLA_KV_LORA)),
        "w_kv_up": nrm(ks[8], (DEPTH, MLA_KV_LORA, MLA_HEADS * (MLA_NOPE_DIM + MLA_V_DIM)), MLA_KV_LORA),
        "sinks": 0.5 * jax.random.normal(ks[9], (DEPTH, SWA_Q_HEADS), f32),
        "w_out": nrm(ks[10], (DEPTH, MIX_WIDTH, D_MODEL), MIX_WIDTH),
        "ffn_norm": gain(ks[11], (DEPTH, D_MODEL)),
        "dense_w_gate": nrm(ks[12], (N_DENSE, D_MODEL, FFN_DIM), D_MODEL),
        "dense_w_up": nrm(ks[13], (N_DENSE, D_MODEL, FFN_DIM), D_MODEL),
        "dense_w_down": nrm(ks[14], (N_DENSE, FFN_DIM, D_MODEL), FFN_DIM),
        "router": nrm(ks[15], (N_MOE, D_MODEL, N_EXPERTS), D_MODEL),
        "moe_w_gate": nrm(ks[16], (N_MOE, N_EXPERTS, D_MODEL, FFN_DIM), D_MODEL),
        "moe_w_up": nrm(ks[17], (N_MOE, N_EXPERTS, D_MODEL, FFN_DIM), D_MODEL),
        "moe_w_down": nrm(ks[18], (N_MOE, N_EXPERTS, FFN_DIM, D_MODEL), FFN_DIM),
        "final_norm": gain(ks[19], (D_MODEL,)),
    }


def reference(x, positions, attn_norm, w_in, b_forget, mla_q_norm, w_q_up, mla_kv_norm, w_kv_up, sinks,
              w_out, ffn_norm, dense_w_gate, dense_w_up, dense_w_down, router, moe_w_gate, moe_w_up,
              moe_w_down, final_norm):
    slopes = alibi_slopes()
    splits = np.cumsum(IN_SIZES)[:-1].tolist()
    for layer in range(DEPTH):
        h = rms_norm(x, attn_norm[layer])
        (fq, fk, fv, ff, sq, sk, sv, cq, ckv, kr, dq, dk, dv) = jnp.split(h @ w_in[layer], splits, axis=-1)
        y_a = fox_mixer(fq, fk, fv, ff, b_forget[layer])
        y_b = swa_sink_mixer(sq, sk, sv, sinks[layer], slopes[:SWA_Q_HEADS])
        y_c = mla_mixer(cq, ckv, kr, positions, mla_q_norm[layer], w_q_up[layer],
                        mla_kv_norm[layer], w_kv_up[layer])
        y_d = dilated_mixer(dq, dk, dv, slopes[SWA_Q_HEADS:])
        mixed = jnp.concatenate([y_a, y_b, y_c, y_d], axis=-1)
        x = x + mixed @ w_out[layer]
        h = rms_norm(x, ffn_norm[layer])
        j = layer // 2
        if layer % 2 == 0:
            x = x + swiglu(h, dense_w_gate[j], dense_w_up[j], dense_w_down[j])
        else:
            x = x + moe_swiglu(h, router[j], moe_w_gate[j], moe_w_up[j], moe_w_down[j])
    return rms_norm(x, final_norm)
```

```cpp
#include <hip/hip_runtime.h>
#include <cstdio>
#include <cstdint>

#ifndef MK_ONE_LAUNCH
#define MK_ONE_LAUNCH 0
#endif

#define GAS __attribute__((address_space(1)))
#define LAS __attribute__((address_space(3)))
typedef unsigned short bf16_t;
typedef short bf16x8 __attribute__((ext_vector_type(8)));
typedef short s16x4 __attribute__((ext_vector_type(4)));
typedef float f32x2 __attribute__((ext_vector_type(2)));
typedef float f32x4 __attribute__((ext_vector_type(4)));
typedef float f32x16 __attribute__((ext_vector_type(16)));
typedef unsigned u32x2 __attribute__((ext_vector_type(2)));
typedef unsigned u32x4 __attribute__((ext_vector_type(4)));
typedef __bf16 bf16x2_t __attribute__((ext_vector_type(2)));
typedef GAS unsigned gu32;

constexpr int NB = 2, SEQ = 8192, T = NB * SEQ, D = 1024, NY = 2560, FF = 3584, NEXP = 8;
constexpr int NIN = 2468;
constexpr float EPS = 1e-6f;
constexpr float LOG2E = 1.4426950408889634f;
constexpr float C2_64 = 0.125f * LOG2E;
constexpr float C2_96 = 0.10206207261596575f * LOG2E;
constexpr int Y_FQ = 0, Y_FK = 256, Y_FV = 512, Y_SQ = 768, Y_SK = 1024, Y_SV = 1152, Y_CQ = 1280, Y_DQ = 1536, Y_DK = 1792, Y_DV = 2048,
              Y_CKV = 2304, Y_KR = 2432, Y_FF = 2464;
constexpr int MOE_MAX_TILES = 136, MOE_MAX_ROWS = MOE_MAX_TILES * 256;

constexpr size_t MiB = 1u << 20, KiB = 1u << 10;
constexpr size_t WS_CTL = 0, CTL_ZERO_BYTES = 1 * MiB;
constexpr size_t WS_SM = 1 * MiB;
constexpr size_t SM_RSTD0 = WS_SM, SM_PARTQ = WS_SM + 64 * KiB, SM_PARTKV = WS_SM + 320 * KiB, SM_FF = WS_SM + 576 * KiB, SM_CSL = WS_SM + 832 * KiB,
                 SM_PART = WS_SM + 1088 * KiB, SM_ROPE = WS_SM + 2112 * KiB, SM_TOKE = WS_SM + 4160 * KiB, SM_TOKG = WS_SM + 4288 * KiB,
                 SM_RSTDT = WS_SM + 4416 * KiB, SM_SLOT = WS_SM + 4480 * KiB, SM_RSTDG = WS_SM + 4608 * KiB, SM_HIST = WS_SM + 4800 * KiB, SM_MOETAB = WS_SM + 4808 * KiB;
constexpr size_t WS_WIN = 9 * MiB;
constexpr size_t WS_WQUP = 19 * MiB;
constexpr size_t WS_WKVUP = 19 * MiB + 512 * KiB;
constexpr size_t WS_WOUT = 20 * MiB;
constexpr size_t WS_WGU0 = 24 * MiB;
constexpr size_t WS_WD0 = 38 * MiB;
constexpr size_t WS_WGU1 = 45 * MiB;
constexpr size_t WS_WD1 = 45 * MiB;
constexpr size_t WS_XB = 157 * MiB;
constexpr size_t WS_Y = 189 * MiB;
constexpr size_t WS_QM = 269 * MiB, WS_KM = 281 * MiB, WS_VM = 293 * MiB;
constexpr size_t WS_MIX = 301 * MiB;
constexpr size_t WS_DP = 333 * MiB;
constexpr size_t WS_DL = 357 * MiB;
constexpr size_t WS_HID = 189 * MiB;
constexpr size_t WS_XG = 157 * MiB;
constexpr size_t WS_HG = 225 * MiB;
constexpr size_t WS_END = 463 * MiB;
constexpr int CW_BAR = 4096;
constexpr int CW_QUEUE = 16384;

constexpr int RING_BYTES = 131072;
constexpr int LDSCTL_OFF = RING_BYTES, MISC_OFF = LDSCTL_OFF + 320;
constexpr int LDS_BYTES = 147456;
constexpr int NWAVES = 8;

#define LDS_WAIT() asm volatile("s_waitcnt lgkmcnt(0)" ::: "memory")
#define VM_WAIT() asm volatile("s_waitcnt vmcnt(0)" ::: "memory")
#define RLX_AGENT __ATOMIC_RELAXED, __HIP_MEMORY_SCOPE_AGENT

__device__ __forceinline__ unsigned cvtpk(float lo, float hi) { f32x2 v = {lo, hi}; bf16x2_t b = __builtin_convertvector(v, bf16x2_t); return __builtin_bit_cast(unsigned, b); }
__device__ __forceinline__ float bf2f(unsigned short h) { return __uint_as_float((unsigned)h << 16); }
__device__ __forceinline__ float wave_sum(float v) {
#pragma unroll
    for (int o = 1; o < 64; o <<= 1) v += __shfl_xor(v, o);
    return v;
}

namespace pg8 {
constexpr int BM = 256, BK = 64, HALF = 128, HTB = HALF * BK * 2, STAGE_BYTES = 8 * HTB, NXCD = 8, WGM = 8;
__host__ __device__ __forceinline__ int lds_byte(int r, int c) { const int st = (r >> 4) * 2 + (c >> 5), rr = r & 15, cc = c & 31, ob = rr * 64 + cc * 2; return st * 1024 + (ob ^ (((ob >> 9) & 1) << 5)); }
__host__ __device__ __forceinline__ void stage_rc(int b, int& R, int& C) { const int st = b / 1024, sb = b % 1024, swz = sb ^ (((sb >> 9) & 1) << 5); R = (st >> 1) * 16 + swz / 64; C = (st & 1) * 32 + (swz % 64) / 2; }
__host__ __device__ __forceinline__ int perm32(int rho) { const int n = rho >> 4, i = rho & 15; return 8 * (i >> 2) + 4 * n + (i & 3); }

struct Unit { int pm, pn, e; };
struct Gemm { const bf16_t* A; const bf16_t* Bt; int lda, ldb, K; };

struct StaticOrder {
    int nM, nN, nwg, G, c;
    __device__ void init(int M, int N, int G_, int c_) { nM = M / BM; nN = N / BM; nwg = nM * nN; G = G_; c = c_; }
    __device__ bool next(int i, Unit& u) const {
        const long L = (long)i * G + c; if (L >= nwg) return false;
        int wgid = (int)L; { const int q = nwg / NXCD, r = nwg % NXCD, xcd = wgid % NXCD, off = wgid / NXCD; wgid = (xcd < r ? xcd * (q + 1) : r * (q + 1) + (xcd - r) * q) + off; }
        const int nig = WGM * nN, gid = wgid / nig, fm = gid * WGM, gsz = (nM - fm) < WGM ? (nM - fm) : WGM;
        u.pm = fm + ((wgid % nig) % gsz); u.pn = (wgid % nig) / gsz; u.e = 0; return true;
    }
};
struct SchedStatic {
    StaticOrder o;
    __device__ __forceinline__ bool next(int i, Unit& u) const { return o.next(i, u); }
    __device__ __forceinline__ const char* abase(const Gemm& g, const Unit& u) const { return (const char*)g.A + (size_t)u.pm * BM * g.lda * 2; }
    __device__ __forceinline__ const char* bbase(const Gemm& g, const Unit& u) const { return (const char*)g.Bt + (size_t)u.pn * BM * g.ldb * 2; }
};
struct SchedMoe {
    StaticOrder o; int tb[9]; size_t estride;
    __device__ __forceinline__ bool next(int i, Unit& u) const {
        if (!o.next(i, u)) return false; int e = 0;
#pragma unroll
        for (int j = 1; j < 8; ++j) e += (u.pm >= tb[j]) ? 1 : 0;
        u.e = e; return true;
    }
    __device__ __forceinline__ const char* abase(const Gemm& g, const Unit& u) const { return (const char*)g.A + (size_t)u.pm * BM * g.lda * 2; }
    __device__ __forceinline__ const char* bbase(const Gemm& g, const Unit& u) const { return (const char*)g.Bt + (size_t)u.e * estride + (size_t)u.pn * BM * g.ldb * 2; }
};
struct SchedOne {
    bool has; Unit un;
    __device__ __forceinline__ bool next(int i, Unit& u) const { if (i > 0 || !has) return false; u = un; return true; }
    __device__ __forceinline__ const char* abase(const Gemm& g, const Unit& u) const { return (const char*)g.A + (size_t)u.pm * BM * g.lda * 2; }
    __device__ __forceinline__ const char* bbase(const Gemm& g, const Unit& u) const { return (const char*)g.Bt + (size_t)u.pn * BM * g.ldb * 2; }
};

template <class Epi, class Sched, bool ALIGN_EPI>
__device__ __forceinline__ void gemm_phase(LAS unsigned char* lds, const Gemm g_in, const Sched& S, const Epi& E) {
    Gemm g = g_in; asm volatile("" : "+s"(g.A), "+s"(g.Bt), "+s"(g.K));
    int tid_l = threadIdx.x; asm volatile("" : "+v"(tid_l));
    const int tid = tid_l, wid = __builtin_amdgcn_readfirstlane(tid >> 6), lane = tid & 63, wr = wid >> 2, wc = wid & 3, fr = lane & 15, fq = lane >> 4;
    const int K = g.K, nt = K / BK;
    unsigned voffA[2], voffB[2];
#pragma unroll
    for (int i = 0; i < 2; ++i) { int R, C; stage_rc(tid * 16 + i * 8192, R, C); const int Rb = Epi::PERM ? ((R & ~31) + perm32(R & 31)) : R;
        voffA[i] = (unsigned)(R * g.lda + C) * 2u; voffB[i] = (unsigned)(Rb * g.ldb + C) * 2u; }
    const size_t kstep = (size_t)(BK * 2);
    const size_t hstepA = (size_t)HALF * g.lda * 2, hstepB = (size_t)HALF * g.ldb * 2;
    const unsigned ldsw = (unsigned)wid * 1024u;
    const int aoff = lds_byte(wr * 64 + fr, fq * 8), boff = lds_byte(wc * 32 + fr, fq * 8);
#define PG8_SA(b, h) (((b) * 2 + (h)) * HTB)
#define PG8_SB(b, h) ((4 + (b) * 2 + (h)) * HTB)
#define PG8_STAGE(bufoff, gbase, voff) do { _Pragma("unroll") for (int _i = 0; _i < 2; ++_i) \
        __builtin_amdgcn_global_load_lds((const unsigned*)((const char*)(gbase) + (voff)[_i]), (LAS unsigned*)(lds + (bufoff) + ldsw + _i * 8192), 16, 0, 0); } while (0)
#define PG8_LDA(dst, b, h) do { _Pragma("unroll") for (int m = 0; m < 4; ++m) _Pragma("unroll") for (int k = 0; k < 2; ++k) dst[m][k] = *(const LAS bf16x8*)(lds + PG8_SA(b, h) + aoff + m * 2048 + k * 1024); } while (0)
#define PG8_LDB(dst, b, h) do { _Pragma("unroll") for (int n = 0; n < 2; ++n) _Pragma("unroll") for (int k = 0; k < 2; ++k) dst[n][k] = *(const LAS bf16x8*)(lds + PG8_SB(b, h) + boff + n * 2048 + k * 1024); } while (0)
#define PG8_MMA(ai, bj, At, Bt) do { __builtin_amdgcn_s_setprio(1); _Pragma("unroll") for (int m = 0; m < 4; ++m) _Pragma("unroll") for (int n = 0; n < 2; ++n) _Pragma("unroll") for (int k = 0; k < 2; ++k) \
        acc[ai][bj][m][n] = __builtin_amdgcn_mfma_f32_16x16x32_bf16(Bt[n][k], At[m][k], acc[ai][bj][m][n], 0, 0, 0); __builtin_amdgcn_s_setprio(0); } while (0)
#define PG8_WAIT_V(n) asm volatile("s_waitcnt vmcnt(" #n ")" ::: "memory")
#define PG8_WAIT_L(n) asm volatile("s_waitcnt lgkmcnt(" #n ")" ::: "memory")
#define PG8_BAR __builtin_amdgcn_s_barrier()
#define PG8_SCHED __builtin_amdgcn_sched_barrier(0)
    Unit cur, nxt; int ui = 0;
    if (!S.next(0, cur)) return;
    f32x4 acc[2][2][4][2];
#pragma unroll
    for (int a = 0; a < 2; ++a)
#pragma unroll
        for (int b = 0; b < 2; ++b)
#pragma unroll
            for (int m = 0; m < 4; ++m)
#pragma unroll
                for (int n = 0; n < 2; ++n) acc[a][b][m][n] = (f32x4){0.f, 0.f, 0.f, 0.f};
    bf16x8 At[4][2], B0[2][2], B1[2][2];
    const char* cA = S.abase(g, cur); const char* cB = S.bbase(g, cur);
    PG8_STAGE(PG8_SB(0, 0), cB, voffB); PG8_STAGE(PG8_SB(0, 1), cB + hstepB, voffB); PG8_STAGE(PG8_SA(0, 0), cA, voffA); PG8_STAGE(PG8_SA(0, 1), cA + hstepA, voffA);
    if (wr == 1) PG8_BAR;
    PG8_WAIT_V(2); PG8_BAR;
    PG8_STAGE(PG8_SB(1, 0), cB + kstep, voffB); PG8_STAGE(PG8_SA(1, 0), cA + kstep, voffA); PG8_STAGE(PG8_SB(1, 1), cB + hstepB + kstep, voffB);
    PG8_WAIT_V(6); PG8_BAR;
    for (;;) {
        const bool has_next = S.next(ui + 1, nxt);
        const char* nA = has_next ? S.abase(g, nxt) : cA; const char* nB = has_next ? S.bbase(g, nxt) : cB;
        for (int t = 0; t < nt; t += 2) {
            const bool last = (t == nt - 2);
            const char* a1 = cA + (size_t)(t + 1) * kstep;
            const char* a2 = last ? nA : cA + (size_t)(t + 2) * kstep; const char* b2 = last ? nB : cB + (size_t)(t + 2) * kstep;
            const char* a3 = a2 + kstep; const char* b3 = b2 + kstep;
            PG8_LDB(B0, 0, 0); PG8_LDB(B1, 0, 1); PG8_SCHED; PG8_LDA(At, 0, 0); PG8_STAGE(PG8_SA(1, 1), a1 + hstepA, voffA);
            PG8_WAIT_V(8); PG8_WAIT_L(0); PG8_BAR; PG8_MMA(0, 0, At, B0); PG8_MMA(0, 1, At, B1); PG8_BAR; PG8_SCHED;
            PG8_LDA(At, 0, 1); PG8_STAGE(PG8_SB(0, 0), b2, voffB); PG8_STAGE(PG8_SB(0, 1), b2 + hstepB, voffB); PG8_STAGE(PG8_SA(0, 0), a2, voffA);
            PG8_WAIT_V(8); PG8_WAIT_L(0); PG8_BAR; PG8_MMA(1, 0, At, B0); PG8_MMA(1, 1, At, B1); PG8_BAR; PG8_SCHED;
            PG8_LDB(B0, 1, 0); PG8_LDB(B1, 1, 1); PG8_SCHED; PG8_LDA(At, 1, 0); PG8_STAGE(PG8_SA(0, 1), a2 + hstepA, voffA);
            PG8_WAIT_V(8); PG8_WAIT_L(0); PG8_BAR; PG8_MMA(0, 0, At, B0); PG8_MMA(0, 1, At, B1); PG8_BAR; PG8_SCHED;
            PG8_LDA(At, 1, 1); PG8_STAGE(PG8_SB(1, 0), b3, voffB); PG8_STAGE(PG8_SB(1, 1), b3 + hstepB, voffB); PG8_STAGE(PG8_SA(1, 0), a3, voffA);
            PG8_WAIT_V(8); PG8_WAIT_L(0); PG8_BAR; PG8_MMA(1, 0, At, B0); PG8_MMA(1, 1, At, B1); PG8_BAR; PG8_SCHED;
        }
        if constexpr (ALIGN_EPI) { if (wr == 0) PG8_BAR; }
        E(acc, cur, wr, wc, fr, fq);
        if (!has_next) break;
#pragma unroll
        for (int a = 0; a < 2; ++a)
#pragma unroll
            for (int b = 0; b < 2; ++b)
#pragma unroll
                for (int m = 0; m < 4; ++m)
#pragma unroll
                    for (int n = 0; n < 2; ++n) acc[a][b][m][n] = (f32x4){0.f, 0.f, 0.f, 0.f};
        cur = nxt; cA = nA; cB = nB; ++ui;
        if constexpr (ALIGN_EPI) { if (wr == 1) PG8_BAR; }
    }
    PG8_WAIT_V(0);
    if constexpr (!ALIGN_EPI) { if (wr == 0) PG8_BAR; }
    PG8_BAR;
#undef PG8_SA
#undef PG8_SB
#undef PG8_STAGE
#undef PG8_LDA
#undef PG8_LDB
#undef PG8_MMA
#undef PG8_WAIT_V
#undef PG8_WAIT_L
#undef PG8_BAR
#undef PG8_SCHED
}

__device__ __forceinline__ float rstd_part(const float* part, int row) {
    const f32x4* p = (const f32x4*)(part + (size_t)row * 16);
    const f32x4 a = p[0], b = p[1], c = p[2], d = p[3];
    const float s = ((a[0] + a[1]) + (a[2] + a[3])) + ((b[0] + b[1]) + (b[2] + b[3])) + ((c[0] + c[1]) + (c[2] + c[3])) + ((d[0] + d[1]) + (d[2] + d[3]));
    return 1.0f / sqrtf(s * (1.0f / D) + EPS);
}
__device__ __forceinline__ u32x4 pack8(const f32x4 v0, const f32x4 v1) { u32x4 w; w.x = cvtpk(v0[0], v0[1]); w.y = cvtpk(v0[2], v0[3]); w.z = cvtpk(v1[0], v1[1]); w.w = cvtpk(v1[2], v1[3]); return w; }

struct EpiG1 {
    static constexpr bool PERM = true;
    bf16_t* Y; const float* rstd_direct; const float* part; float* partq; float* partkv; float* ff; bf16_t* Km; const float* rope;
    __device__ __forceinline__ void operator()(const f32x4 (&acc)[2][2][4][2], const Unit& u, int wr, int wc, int fr, int fq) const {
#pragma unroll
        for (int ai = 0; ai < 2; ++ai)
#pragma unroll
            for (int m = 0; m < 4; ++m) {
                asm volatile("" ::: "memory");
                const int row = u.pm * BM + ai * HALF + wr * 64 + m * 16 + fr;
                const float rs = rstd_direct ? rstd_direct[row] : rstd_part(part, row);
                f32x4 v[2][2];
#pragma unroll
                for (int bj = 0; bj < 2; ++bj) { v[bj][0] = acc[ai][bj][m][0] * rs; v[bj][1] = acc[ai][bj][m][1] * rs;
                    *(u32x4*)(Y + (size_t)row * NY + u.pn * BM + bj * HALF + wc * 32 + 8 * fq) = pack8(v[bj][0], v[bj][1]); }
                if (u.pn == Y_CQ / 256) {
                    float s = 0.f;
#pragma unroll
                    for (int bj = 0; bj < 2; ++bj)
#pragma unroll
                        for (int n = 0; n < 2; ++n) { const f32x4 x = v[bj][n]; s += (x[0] * x[0] + x[1] * x[1]) + (x[2] * x[2] + x[3] * x[3]); }
                    s += __shfl_xor(s, 16); s += __shfl_xor(s, 32);
                    if (fq == 0) partq[row * 4 + wc] = s;
                }
                if (u.pn == Y_CKV / 256) {
                    float s = 0.f;
#pragma unroll
                    for (int n = 0; n < 2; ++n) { const f32x4 x = v[0][n]; s += (x[0] * x[0] + x[1] * x[1]) + (x[2] * x[2] + x[3] * x[3]); }
                    s += __shfl_xor(s, 16); s += __shfl_xor(s, 32);
                    if (fq == 0) partkv[row * 4 + wc] = s;
                    if (wc == 0) {
                        const f32x4* rp = (const f32x4*)(rope + (size_t)row * 32 + 8 * fq);
                        const f32x4 cs0 = rp[0], cs1 = rp[1];
                        const f32x4 t1 = v[1][0], t2 = v[1][1];
                        f32x4 o1, o2;
                        o1[0] = t1[0] * cs0[0] - t2[0] * cs0[1]; o2[0] = t2[0] * cs0[0] + t1[0] * cs0[1];
                        o1[1] = t1[1] * cs0[2] - t2[1] * cs0[3]; o2[1] = t2[1] * cs0[2] + t1[1] * cs0[3];
                        o1[2] = t1[2] * cs1[0] - t2[2] * cs1[1]; o2[2] = t2[2] * cs1[0] + t1[2] * cs1[1];
                        o1[3] = t1[3] * cs1[2] - t2[3] * cs1[3]; o2[3] = t2[3] * cs1[2] + t1[3] * cs1[3];
                        const u32x4 w = pack8(o1, o2);
#pragma unroll
                        for (int h = 0; h < 4; ++h) *(u32x4*)(Km + (size_t)row * 384 + h * 96 + 64 + 8 * fq) = w;
                    }
                    if (wc == 1 && fq == 0) *(f32x4*)(ff + (size_t)row * 4) = v[1][0];
                }
            }
    }
};
struct EpiQup {
    static constexpr bool PERM = true;
    bf16_t* Qm; const float* partq; const float* rope;
    __device__ __forceinline__ void operator()(const f32x4 (&acc)[2][2][4][2], const Unit& u, int wr, int wc, int fr, int fq) const {
#pragma unroll
        for (int ai = 0; ai < 2; ++ai)
#pragma unroll
            for (int m = 0; m < 4; ++m) {
                asm volatile("" ::: "memory");
                const int row = u.pm * BM + ai * HALF + wr * 64 + m * 16 + fr;
                const f32x4 pq = *(const f32x4*)(partq + (size_t)row * 4);
                const float rs = 1.0f / sqrtf(((pq[0] + pq[1]) + (pq[2] + pq[3])) * (1.0f / 256.0f) + EPS);
#pragma unroll
                for (int bj = 0; bj < 2; ++bj) {
                    const int col = u.pn * BM + bj * HALF + wc * 32 + 8 * fq;
                    if (col < 384) {
                        f32x4 v0 = acc[ai][bj][m][0] * rs, v1 = acc[ai][bj][m][1] * rs;
                        const int cm = col % 96;
                        if (cm >= 64) {
                            const f32x4* rp = (const f32x4*)(rope + (size_t)row * 32 + (cm - 64));
                            const f32x4 cs0 = rp[0], cs1 = rp[1];
                            const f32x4 t1 = v0, t2 = v1;
                            v0[0] = t1[0] * cs0[0] - t2[0] * cs0[1]; v1[0] = t2[0] * cs0[0] + t1[0] * cs0[1];
                            v0[1] = t1[1] * cs0[2] - t2[1] * cs0[3]; v1[1] = t2[1] * cs0[2] + t1[1] * cs0[3];
                            v0[2] = t1[2] * cs1[0] - t2[2] * cs1[1]; v1[2] = t2[2] * cs1[0] + t1[2] * cs1[1];
                            v0[3] = t1[3] * cs1[2] - t2[3] * cs1[3]; v1[3] = t2[3] * cs1[2] + t1[3] * cs1[3];
                        }
                        *(u32x4*)(Qm + (size_t)row * 384 + col) = pack8(v0, v1);
                    }
                }
            }
    }
};
struct EpiKVup {
    static constexpr bool PERM = true;
    bf16_t* Km; bf16_t* Vm; const float* partkv;
    __device__ __forceinline__ void operator()(const f32x4 (&acc)[2][2][4][2], const Unit& u, int wr, int wc, int fr, int fq) const {
#pragma unroll
        for (int ai = 0; ai < 2; ++ai)
#pragma unroll
            for (int m = 0; m < 4; ++m) {
                asm volatile("" ::: "memory");
                const int row = u.pm * BM + ai * HALF + wr * 64 + m * 16 + fr;
                const f32x4 pq = *(const f32x4*)(partkv + (size_t)row * 4);
                const float rs = 1.0f / sqrtf(((pq[0] + pq[1]) + (pq[2] + pq[3])) * (1.0f / 128.0f) + EPS);
#pragma unroll
                for (int bj = 0; bj < 2; ++bj) {
                    const int col = u.pn * BM + bj * HALF + wc * 32 + 8 * fq;
                    const int h = col >> 7, c = col & 127;
                    const u32x4 w = pack8(acc[ai][bj][m][0] * rs, acc[ai][bj][m][1] * rs);
                    if (c < 64) *(u32x4*)(Km + (size_t)row * 384 + h * 96 + c) = w;
                    else *(u32x4*)(Vm + (size_t)row * 256 + h * 64 + (c - 64)) = w;
                }
            }
    }
};
struct EpiRes {
    static constexpr bool PERM = false;
    const float* base; float* out; bf16_t* xb; float* part;
    __device__ __forceinline__ void operator()(const f32x4 (&acc)[2][2][4][2], const Unit& u, int wr, int wc, int fr, int fq) const {
#pragma unroll
        for (int ai = 0; ai < 2; ++ai)
#pragma unroll
            for (int m = 0; m < 4; ++m) {
                asm volatile("" ::: "memory");
                const int row = u.pm * BM + ai * HALF + wr * 64 + m * 16 + fr;
                float s = 0.f;
#pragma unroll
                for (int bj = 0; bj < 2; ++bj)
#pragma unroll
                    for (int n = 0; n < 2; ++n) {
                        const size_t off = (size_t)row * D + u.pn * BM + bj * HALF + wc * 32 + n * 16 + 4 * fq;
                        const f32x4 x = *(const f32x4*)(base + off) + acc[ai][bj][m][n];
                        *(f32x4*)(out + off) = x;
                        s += (x[0] * x[0] + x[1] * x[1]) + (x[2] * x[2] + x[3] * x[3]);
                        if (xb) { u32x2 w; w.x = cvtpk(x[0], x[1]); w.y = cvtpk(x[2], x[3]); *(u32x2*)(xb + off) = w; }
                    }
                s += __shfl_xor(s, 16); s += __shfl_xor(s, 32);
                if (fq == 0) part[(size_t)row * 16 + u.pn * 4 + wc] = s;
            }
    }
};
struct EpiSwiglu {
    static constexpr bool PERM = true;
    bf16_t* H; const float* rstd_direct; const float* part;
    __device__ __forceinline__ void operator()(const f32x4 (&acc)[2][2][4][2], const Unit& u, int wr, int wc, int fr, int fq) const {
#pragma unroll
        for (int ai = 0; ai < 2; ++ai)
#pragma unroll
            for (int m = 0; m < 4; ++m) {
                asm volatile("" ::: "memory");
                const int row = u.pm * BM + ai * HALF + wr * 64 + m * 16 + fr;
                const float rs = rstd_direct ? rstd_direct[row] : rstd_part(part, row);
                f32x4 hv[2];
#pragma unroll
                for (int n = 0; n < 2; ++n) {
                    const f32x4 gt = acc[ai][0][m][n] * rs, up = acc[ai][1][m][n] * rs;
#pragma unroll
                    for (int e = 0; e < 4; ++e) { const float sg = __builtin_amdgcn_rcpf(1.0f + __builtin_amdgcn_exp2f(-gt[e] * LOG2E)); hv[n][e] = gt[e] * sg * up[e]; }
                }
                *(u32x4*)(H + (size_t)row * FF + u.pn * HALF + wc * 32 + 8 * fq) = pack8(hv[0], hv[1]);
            }
    }
};
struct EpiY {
    static constexpr bool PERM = true;
    bf16_t* O;
    __device__ __forceinline__ void operator()(const f32x4 (&acc)[2][2][4][2], const Unit& u, int wr, int wc, int fr, int fq) const {
#pragma unroll
        for (int ai = 0; ai < 2; ++ai)
#pragma unroll
            for (int m = 0; m < 4; ++m) {
                asm volatile("" ::: "memory");
                const int row = u.pm * BM + ai * HALF + wr * 64 + m * 16 + fr;
#pragma unroll
                for (int bj = 0; bj < 2; ++bj) *(u32x4*)(O + (size_t)row * D + u.pn * BM + bj * HALF + wc * 32 + 8 * fq) = pack8(acc[ai][bj][m][0], acc[ai][bj][m][1]);
            }
    }
};
}

namespace att {
constexpr int KSLOT = 12288, VSLOT = 8192;
constexpr int LDS_K = 0, LDS_V = 2 * KSLOT, LDS_WS = LDS_V + 2 * VSLOT, LDS_OST = LDS_WS + 8 * 256, LDS_CB = LDS_OST + 8 * 4096, LDS_TOTAL = LDS_CB + 32768;
static_assert(LDS_TOTAL <= RING_BYTES, "attention LDS");
struct AU {
    const bf16_t* Q; const bf16_t* K; const bf16_t* V; bf16_t* O; float* lse; const float* colb;
    int qpitch, kpitch, vpitch, opitch, lpitch;
    int q0, kt0, kt1, span; float alibi, sink2;
};
__device__ __forceinline__ int crow(int r, int hi) { return (r & 3) + 8 * (r >> 2) + 4 * hi; }
__device__ __forceinline__ void glds16(const void* gsrc, unsigned lds_dst) { unsigned keep;
    asm volatile("s_mov_b32 %0, m0\n\ts_mov_b32 m0, %2\n\ts_nop 0\n\tglobal_load_lds_dwordx4 %1, off\n\ts_mov_b32 m0, %0" : "=&s"(keep) : "v"(gsrc), "s"(lds_dst) : "memory"); }
#define ATT_WAIT_BAR() asm volatile("s_waitcnt vmcnt(0) lgkmcnt(0)\n\ts_barrier" ::: "memory")
__device__ __forceinline__ float permswap_max(float m) { auto rr = __builtin_amdgcn_permlane32_swap(__float_as_uint(m), __float_as_uint(m), false, false); return fmaxf(__uint_as_float(rr[0]), __uint_as_float(rr[1])); }
__device__ __forceinline__ float permswap_sum(float m) { auto rr = __builtin_amdgcn_permlane32_swap(__float_as_uint(m), __float_as_uint(m), false, false); return __uint_as_float(rr[0]) + __uint_as_float(rr[1]); }

template <int NDK, int MODE>
__device__ __forceinline__ void attn_unit(const AU& u, LAS unsigned char* shm) {
    int tid_l = threadIdx.x; asm volatile("" : "+v"(tid_l));
    const int tid = tid_l, lane = tid & 63, r32 = lane & 31, hi = lane >> 5; const int wid = __builtin_amdgcn_readfirstlane(tid >> 6);
    const unsigned lds0 = (unsigned)(uintptr_t)shm;
    LAS float* wsf = (LAS float*)(shm + LDS_WS) + wid * 64;
    LAS float* cb = (LAS float*)(shm + LDS_CB);
    const int q = u.q0 + wid * 32 + r32;
    const int qmin = u.q0 + wid * 32, qmax = qmin + 31;
    float cq = 0.f;
    if (MODE == 1) {
        const int nk = (u.kt1 - u.kt0) * 64;
        for (int i = tid; i < nk; i += 512) cb[i] = u.colb[u.kt0 * 64 + i];
        cq = u.colb[q];
    }
    bf16x8 qr[NDK];
    { const bf16_t* qp = u.Q + (size_t)q * u.qpitch + hi * 8;
#pragma unroll
      for (int d0 = 0; d0 < NDK; ++d0) qr[d0] = *(const bf16x8*)(qp + d0 * 16); }
#define ATT_ISSUE(kt_, s_) do { \
        const bf16_t* kp_ = u.K + (size_t)((kt_) * 64 + lane) * u.kpitch; \
        glds16(kp_ + wid * 8, (unsigned)__builtin_amdgcn_readfirstlane(lds0 + LDS_K + (s_) * KSLOT + wid * 1024)); \
        if (NDK == 6) { if (wid < 4) glds16(kp_ + (wid + 8) * 8, (unsigned)__builtin_amdgcn_readfirstlane(lds0 + LDS_K + (s_) * KSLOT + (wid + 8) * 1024)); } \
        const bf16_t* vp_ = u.V + (size_t)((kt_) * 64 + 16 * (wid & 3) + (lane >> 2)) * u.vpitch + (wid >> 2) * 32 + (lane & 3) * 8; \
        glds16(vp_, (unsigned)__builtin_amdgcn_readfirstlane(lds0 + LDS_V + (s_) * VSLOT + wid * 1024)); } while (0)
    float mrun = -3.0e38f, lrun = 0.f;
    f32x16 o0 = {}, o1 = {};
    ATT_ISSUE(u.kt0, 0);
    for (int kt = u.kt0; kt < u.kt1; ++kt) {
        const int s = (kt - u.kt0) & 1;
        ATT_WAIT_BAR();
        if (kt + 1 < u.kt1) ATT_ISSUE(kt + 1, s ^ 1);
        const int kmin = kt * 64, kmax = kmin + 63;
        if (kmin > qmax) continue;
        if (MODE == 2 && kmax < qmin - u.span) continue;
        f32x16 p0 = {}, p1 = {};
        { const LAS unsigned char* kb = shm + LDS_K + s * KSLOT + hi * 1024 + r32 * 16;
#pragma unroll
          for (int d0 = 0; d0 < NDK; ++d0) {
              const bf16x8 b0 = *(const LAS bf16x8*)(kb + d0 * 2048), b1 = *(const LAS bf16x8*)(kb + d0 * 2048 + 512);
              p0 = __builtin_amdgcn_mfma_f32_32x32x16_bf16(b0, qr[d0], p0, 0, 0, 0);
              p1 = __builtin_amdgcn_mfma_f32_32x32x16_bf16(b1, qr[d0], p1, 0, 0, 0);
          } }
        if (MODE == 1) {
            const LAS f32x4* cp = (const LAS f32x4*)(cb + (kt - u.kt0) * 64 + 4 * hi);
#pragma unroll
            for (int j = 0; j < 4; ++j) { const f32x4 c0 = cp[2 * j], c1 = cp[2 * j + 8];
#pragma unroll
                for (int e = 0; e < 4; ++e) { p0[4 * j + e] += cq - c0[e]; p1[4 * j + e] += cq - c1[e]; } }
        }
        if (MODE == 2) {
#pragma unroll
            for (int r = 0; r < 16; ++r) { const int d0 = q - (kmin + crow(r, hi)), d1 = d0 - 32;
                p0[r] = ((unsigned)d0 <= (unsigned)u.span) ? p0[r] - u.alibi * (float)d0 : -INFINITY;
                p1[r] = ((unsigned)d1 <= (unsigned)u.span) ? p1[r] - u.alibi * (float)d1 : -INFINITY; }
        } else if (kmax > qmin) {
#pragma unroll
            for (int r = 0; r < 16; ++r) { const int kj = kmin + crow(r, hi); if (kj > q) p0[r] = -INFINITY; if (kj + 32 > q) p1[r] = -INFINITY; }
        }
        float rm = fmaxf(p0[0], p1[0]);
#pragma unroll
        for (int r = 1; r < 16; ++r) rm = fmaxf(rm, fmaxf(p0[r], p1[r]));
        rm = permswap_max(rm);
        const float mn = fmaxf(mrun, rm), alpha = __builtin_amdgcn_exp2f(mrun - mn);
        mrun = mn;
        float sum = 0.f;
#pragma unroll
        for (int r = 0; r < 16; ++r) { p0[r] = __builtin_amdgcn_exp2f(p0[r] - mn); p1[r] = __builtin_amdgcn_exp2f(p1[r] - mn); sum += p0[r] + p1[r]; }
        lrun = lrun * alpha + sum;
        if (!__all(alpha == 1.0f)) {
            if (hi == 0) wsf[r32] = alpha;
            LDS_WAIT();
#pragma unroll
            for (int j = 0; j < 4; ++j) { const f32x4 f = *(const LAS f32x4*)(wsf + 8 * j + 4 * hi);
#pragma unroll
                for (int e = 0; e < 4; ++e) { o0[4 * j + e] *= f[e]; o1[4 * j + e] *= f[e]; } }
        }
        u32x4 pw0, pw1, pw2, pw3;
        pw0 = (u32x4){cvtpk(p0[0], p0[1]), cvtpk(p0[2], p0[3]), cvtpk(p0[4], p0[5]), cvtpk(p0[6], p0[7])};
        pw1 = (u32x4){cvtpk(p0[8], p0[9]), cvtpk(p0[10], p0[11]), cvtpk(p0[12], p0[13]), cvtpk(p0[14], p0[15])};
        pw2 = (u32x4){cvtpk(p1[0], p1[1]), cvtpk(p1[2], p1[3]), cvtpk(p1[4], p1[5]), cvtpk(p1[6], p1[7])};
        pw3 = (u32x4){cvtpk(p1[8], p1[9]), cvtpk(p1[10], p1[11]), cvtpk(p1[12], p1[13]), cvtpk(p1[14], p1[15])};
        { const LAS unsigned char* vb = shm + LDS_V + s * VSLOT + ((lane >> 4) & 1) * 32 + (lane & 3) * 8 + (4 * hi + ((lane & 15) >> 2)) * 64;
#pragma unroll
          for (int d0 = 0; d0 < 2; ++d0) {
              bf16x8 vf[4];
#pragma unroll
              for (int ks = 0; ks < 4; ++ks) {
                  const s16x4 lo = __builtin_bit_cast(s16x4, __builtin_amdgcn_ds_read_tr16_b64_v4i16((LAS s16x4*)(vb + d0 * 4096 + ks * 1024)));
                  const s16x4 hh = __builtin_bit_cast(s16x4, __builtin_amdgcn_ds_read_tr16_b64_v4i16((LAS s16x4*)(vb + d0 * 4096 + ks * 1024 + 512)));
                  vf[ks] = (bf16x8){lo[0], lo[1], lo[2], lo[3], hh[0], hh[1], hh[2], hh[3]};
              }
              f32x16& od = d0 ? o1 : o0;
              od = __builtin_amdgcn_mfma_f32_32x32x16_bf16(__builtin_bit_cast(bf16x8, pw0), vf[0], od, 0, 0, 0);
              od = __builtin_amdgcn_mfma_f32_32x32x16_bf16(__builtin_bit_cast(bf16x8, pw1), vf[1], od, 0, 0, 0);
              od = __builtin_amdgcn_mfma_f32_32x32x16_bf16(__builtin_bit_cast(bf16x8, pw2), vf[2], od, 0, 0, 0);
              od = __builtin_amdgcn_mfma_f32_32x32x16_bf16(__builtin_bit_cast(bf16x8, pw3), vf[3], od, 0, 0, 0);
          } }
    }
    float ltot = permswap_sum(lrun);
    if (u.lse && hi == 0) u.lse[(size_t)q * u.lpitch] = mrun + __builtin_amdgcn_logf(ltot);
    if (MODE == 2) ltot += __builtin_amdgcn_exp2f(u.sink2 - mrun);
    if (hi == 0) wsf[32 + r32] = ltot;
    LDS_WAIT();
    float rli[16];
#pragma unroll
    for (int j = 0; j < 4; ++j) { const f32x4 f = *(const LAS f32x4*)(wsf + 32 + 8 * j + 4 * hi);
#pragma unroll
        for (int e = 0; e < 4; ++e) rli[4 * j + e] = __builtin_amdgcn_rcpf(f[e]); }
    { LAS bf16_t* stg = (LAS bf16_t*)(shm + LDS_OST) + wid * 2048;
#pragma unroll
      for (int r = 0; r < 16; ++r) { const int orow = crow(r, hi);
          stg[orow * 64 + r32] = (bf16_t)(cvtpk(o0[r] * rli[r], 0.f) & 0xffffu);
          stg[orow * 64 + 32 + r32] = (bf16_t)(cvtpk(o1[r] * rli[r], 0.f) & 0xffffu); }
      LDS_WAIT();
      bf16_t* Ow = u.O + (size_t)(u.q0 + wid * 32) * u.opitch;
#pragma unroll
      for (int i = 0; i < 4; ++i) { const int row = i * 8 + (lane >> 3), ch = lane & 7; const u32x4 v = *(const LAS u32x4*)(stg + row * 64 + ch * 8); *(u32x4*)(Ow + (size_t)row * u.opitch + ch * 8) = v; } }
    ATT_WAIT_BAR();
#undef ATT_ISSUE
}
}

#define XB_TMO      128
#define XB_XCNT(j)  (256  + 64 * (j))
#define XB_XSUB(j)  (1280 + 64 * (j))
#define XB_XGEN(j)  (2304 + 64 * (j))
#define XB_TOP      3328
#define XB_TOPGEN   3392
#define XCD_BAR_WORDS 3456
#define XB_SPIN_CAP (1u << 18)
__device__ __forceinline__ unsigned xb_ld(unsigned* p)              { return __hip_atomic_load(p, __ATOMIC_RELAXED, __HIP_MEMORY_SCOPE_AGENT); }
__device__ __forceinline__ unsigned xb_add(unsigned* p, unsigned v) { return __hip_atomic_fetch_add(p, v, __ATOMIC_RELAXED, __HIP_MEMORY_SCOPE_AGENT); }
__device__ __forceinline__ unsigned xb_xcc_id() { return (unsigned)__builtin_amdgcn_s_getreg((3 << 11) | 20) & 0xFu; }
#define XB_SPIN(cond, bar) do { unsigned _sp = 0; while (cond) { __builtin_amdgcn_s_sleep(1); \
    if ((++_sp & 255u) == 0u) { if (xb_ld(&(bar)[XB_TMO])) break; if (_sp > XB_SPIN_CAP) { atomicAdd(&(bar)[XB_TMO], 1u); break; } } } } while (0)
struct XcdBarrier { unsigned* bar; unsigned x; volatile LAS unsigned* st; };
__device__ __forceinline__ XcdBarrier xcd_barrier_post(unsigned* bar, volatile LAS unsigned* st) {
    XcdBarrier b; b.bar = bar; b.x = xb_xcc_id(); b.st = st;
    if (threadIdx.x == 0) (void)xb_add(&bar[XB_XCNT(b.x)], 1u);
    return b;
}
__device__ __forceinline__ void xcd_barrier_complete(unsigned* bar, unsigned x, unsigned& nloc, unsigned& nx) {
    const unsigned G = gridDim.x * gridDim.y * gridDim.z;
    unsigned sum, cnt, mine, sp = 0u;
    for (;;) {
        sum = 0u; cnt = 0u; mine = 0u;
#pragma unroll
        for (unsigned j = 0; j < 16; ++j) { const unsigned c = xb_ld(&bar[XB_XCNT(j)]); sum += c; cnt += (c > 0u) ? 1u : 0u; mine = (j == x) ? c : mine; }
        if (sum == G) break;
        __builtin_amdgcn_s_sleep(1);
        if ((++sp & 255u) == 0u) { if (xb_ld(&bar[XB_TMO])) break; if (sp > XB_SPIN_CAP) { atomicAdd(&bar[XB_TMO], 1u); break; } }
    }
    nloc = mine > 0u ? mine : 1u; nx = cnt > 0u ? cnt : 1u;
}
__device__ __forceinline__ void xcd_barrier(const XcdBarrier& b) {
    asm volatile("s_waitcnt vmcnt(0)" ::: "memory");
    __syncthreads();
    if (threadIdx.x == 0) {
        unsigned* bar = b.bar;
        __builtin_amdgcn_s_waitcnt(0);
        unsigned nloc = b.st[0], nx = b.st[1];
        if (nloc == 0u) { xcd_barrier_complete(bar, b.x, nloc, nx); b.st[0] = nloc; b.st[1] = nx; }
        const unsigned old = xb_add(&bar[XB_XSUB(b.x)], 1u);
        const unsigned gen = old / nloc;
        if (old + 1u == (gen + 1u) * nloc) {
            __builtin_amdgcn_fence(__ATOMIC_RELEASE, "agent");
            asm volatile("s_waitcnt vmcnt(0)" ::: "memory");
            const unsigned og = xb_add(&bar[XB_TOP], 1u);
            const unsigned tg = og / nx;
            if (og + 1u == (tg + 1u) * nx) xb_add(&bar[XB_TOPGEN], 1u);
            else XB_SPIN(xb_ld(&bar[XB_TOPGEN]) == tg, bar);
            __builtin_amdgcn_fence(__ATOMIC_ACQUIRE, "agent");
            xb_add(&bar[XB_XGEN(b.x)], 1u);
            asm volatile("s_waitcnt vmcnt(0)" ::: "memory");
        } else {
            XB_SPIN(xb_ld(&bar[XB_XGEN(b.x)]) == gen, bar);
            __builtin_amdgcn_fence(__ATOMIC_ACQUIRE, "agent");
            asm volatile("s_waitcnt vmcnt(0)" ::: "memory");
        }
    }
    __syncthreads();
}

struct Args {
    const float* x; const int* pos; const float* attn_norm; const float* w_in; const float* b_forget; const float* mla_q_norm; const float* w_q_up;
    const float* mla_kv_norm; const float* w_kv_up; const float* sinks; const float* w_out; const float* ffn_norm; const float* dense_w_gate; const float* dense_w_up;
    const float* dense_w_down; const float* router; const float* moe_w_gate; const float* moe_w_up; const float* moe_w_down; const float* final_norm;
    float* out; unsigned char* ws; int ph_lo, ph_hi;
};
struct Frame {
    LAS unsigned char* lds; int tid, lane, wave, G, c;
};

__device__ __forceinline__ int rope_perm(int j) { const int i = j & 15, t2 = j >> 4; return 8 * (i >> 2) + 4 * t2 + (i & 3); }
__device__ __forceinline__ int map_col(int kind, int n, float& sc) {
    sc = 1.0f;
    if (kind == 0) return n;
    if (kind == 1) {
        if (n < 256) { sc = C2_64; return Y_FQ + n; }
        if (n < 512) return Y_FK + (n - 256);
        if (n < 768) return Y_FV + (n - 512);
        if (n < 772) return Y_FF + (n - 768);
        if (n < 1028) { sc = C2_64; return Y_SQ + (n - 772); }
        if (n < 1156) return Y_SK + (n - 1028);
        if (n < 1284) return Y_SV + (n - 1156);
        if (n < 1540) return Y_CQ + (n - 1284);
        if (n < 1668) return Y_CKV + (n - 1540);
        if (n < 1700) return Y_KR + rope_perm(n - 1668);
        if (n < 1956) { sc = C2_64; return Y_DQ + (n - 1700); }
        if (n < 2212) return Y_DK + (n - 1956);
        if (n < 2468) return Y_DV + (n - 2212);
        return -1;
    }
    if (kind == 2) { sc = C2_96; const int h = n / 96, c = n % 96; return h * 96 + (c < 64 ? c : 64 + rope_perm(c - 64)); }
    if (kind == 3) return 256 * (n >> 7) + (n & 127);
    return 256 * (n >> 7) + 128 + (n & 127);
}
__device__ __forceinline__ void transpose_item(const float* W, int K, int N, bf16_t* WT, const float* gain, int kind, LAS float* scr, int item, int lane) {
    const int nblk = (N + 31) / 32, kb = item / nblk, nb = item % nblk, k0 = 64 * kb, n0 = 32 * nb;
    const int nn = n0 + (lane & 31);
#pragma unroll 8
    for (int i = 0; i < 32; ++i) { const int kk = 2 * i + (lane >> 5); scr[kk * 33 + (lane & 31)] = (nn < N) ? W[(size_t)(k0 + kk) * N + nn] : 0.f; }
    LDS_WAIT(); asm volatile("" ::: "memory");
    const int c = lane & 7;
    float gk[8];
#pragma unroll
    for (int e = 0; e < 8; ++e) gk[e] = gain ? gain[k0 + 8 * c + e] : 1.0f;
#pragma unroll
    for (int j = 0; j < 4; ++j) { const int n = (lane >> 3) + 8 * j; const LAS float* s = scr + (8 * c) * 33 + n;
        float sc; const int dr = (n0 + n < N) ? map_col(kind, n0 + n, sc) : -1;
        if (dr >= 0) {
            u32x4 o; o.x = cvtpk(s[0 * 33] * gk[0] * sc, s[1 * 33] * gk[1] * sc); o.y = cvtpk(s[2 * 33] * gk[2] * sc, s[3 * 33] * gk[3] * sc);
            o.z = cvtpk(s[4 * 33] * gk[4] * sc, s[5 * 33] * gk[5] * sc); o.w = cvtpk(s[6 * 33] * gk[6] * sc, s[7 * 33] * gk[7] * sc);
            *(u32x4*)(WT + (size_t)dr * K + k0 + 8 * c) = o; } }
    LDS_WAIT(); asm volatile("" ::: "memory");
}
__device__ __forceinline__ void sincos_acc(double a, float& s, float& c) {
    const double n = rint(a * 0.63661977236758134308);
    double r = fma(-n, 1.5707963267948966192, a); r = fma(-n, 6.123233995736766e-17, r);
    const int qd = (int)((long long)n & 3);
    const float x = (float)r, x2 = x * x;
    const float sp = x + x * x2 * (-1.6666667163e-1f + x2 * (8.3333337680e-3f + x2 * (-1.9841270114e-4f + x2 * 2.7557314297e-6f)));
    const float cp = 1.0f + x2 * (-0.5f + x2 * (4.1666667908e-2f + x2 * (-1.3888889225e-3f + x2 * 2.4801587642e-5f)));
    s = (qd == 0) ? sp : (qd == 1) ? cp : (qd == 2) ? -sp : -cp;
    c = (qd == 0) ? cp : (qd == 1) ? -sp : (qd == 2) ? -cp : sp;
}

constexpr int NPH = 17;
typedef __attribute__((address_space(4))) const Args* ArgsP;
__device__ __forceinline__ ArgsP get_args() { ArgsP p = (ArgsP)__builtin_amdgcn_kernarg_segment_ptr(); asm volatile("" : "+s"(p)); return p; }
#define WSP(T_, off) ((T_*)(ws + (off)))

__global__ void __launch_bounds__(NWAVES * 64, 2) mega_fwd(Args a_unused) {
    extern __shared__ __attribute__((aligned(16))) unsigned char lds_raw[];
    Frame F;
    F.lds = (LAS unsigned char*)lds_raw;
    F.tid = threadIdx.x; F.lane = F.tid & 63; F.wave = __builtin_amdgcn_readfirstlane(F.tid >> 6);
    F.G = gridDim.x; F.c = blockIdx.x;
    volatile LAS unsigned* MISC = (volatile LAS unsigned*)(F.lds + MISC_OFF);
    for (int u = F.tid; u < (LDS_BYTES - LDSCTL_OFF) / 4; u += NWAVES * 64) ((LAS unsigned*)(F.lds + LDSCTL_OFF))[u] = 0u;
    __syncthreads();
#if MK_ONE_LAUNCH
    XcdBarrier bar = xcd_barrier_post((unsigned*)(get_args()->ws + WS_CTL) + CW_BAR, MISC + 8);
#define GRID_BAR() do { bar.bar = (unsigned*)(get_args()->ws + WS_CTL) + CW_BAR; xcd_barrier(bar); } while (0)
#else
    (void)MISC;
#define GRID_BAR() do { } while (0)
#endif
    const int lo = get_args()->ph_lo, hi = get_args()->ph_hi;
#ifndef PHMASK
#define PHMASK 0x1ffff
#endif
#define IN(k) ((((PHMASK) >> (k)) & 1) && lo <= (k) && (k) < hi)
#define SEAM(k) do { if (IN(k) && IN((k) + 1)) GRID_BAR(); } while (0)
    const int gw = F.c * NWAVES + F.wave, NGW = F.G * NWAVES;

    if (IN(0)) {
        ArgsP a = get_args(); unsigned char* ws = a->ws;
        LAS float* scr = (LAS float*)(F.lds + F.wave * 16384);
        bf16_t* Win_t = WSP(bf16_t, WS_WIN); bf16_t* Wqup_t = WSP(bf16_t, WS_WQUP); bf16_t* Wkvup_t = WSP(bf16_t, WS_WKVUP); bf16_t* Wout_t = WSP(bf16_t, WS_WOUT);
        bf16_t* Wgu0_t = WSP(bf16_t, WS_WGU0); bf16_t* Wd0_t = WSP(bf16_t, WS_WD0); bf16_t* Wgu1_t = WSP(bf16_t, WS_WGU1);
        constexpr int I_IN = 16 * 78, I_QU = 4 * 12, I_KV = 2 * 16, I_WO = 16 * 32, I_GU = 16 * 112, I_DN = 56 * 32;
        constexpr int NIT = 2 * I_IN + 2 * I_QU + 2 * I_KV + 2 * I_WO + 2 * I_GU + I_DN + 16 * I_GU;
        for (int it = gw; it < NIT; it += NGW) {
            int r = it;
            if (r < 2 * I_IN) { const int l = r / I_IN; transpose_item(a->w_in + (size_t)l * D * NIN, D, NIN, Win_t + (size_t)l * NY * D, a->attn_norm + l * D, 1, scr, r % I_IN, F.lane); continue; } r -= 2 * I_IN;
            if (r < 2 * I_QU) { const int l = r / I_QU; transpose_item(a->w_q_up + (size_t)l * 256 * 384, 256, 384, Wqup_t + (size_t)l * 512 * 256, a->mla_q_norm + l * 256, 2, scr, r % I_QU, F.lane); continue; } r -= 2 * I_QU;
            if (r < 2 * I_KV) { const int l = r / I_KV; transpose_item(a->w_kv_up + (size_t)l * 128 * 512, 128, 512, Wkvup_t + (size_t)l * 512 * 128, a->mla_kv_norm + l * 128, 0, scr, r % I_KV, F.lane); continue; } r -= 2 * I_KV;
            if (r < 2 * I_WO) { const int l = r / I_WO; transpose_item(a->w_out + (size_t)l * D * D, D, D, Wout_t + (size_t)l * D * D, nullptr, 0, scr, r % I_WO, F.lane); continue; } r -= 2 * I_WO;
            if (r < I_GU) { transpose_item(a->dense_w_gate, D, FF, Wgu0_t, a->ffn_norm, 3, scr, r, F.lane); continue; } r -= I_GU;
            if (r < I_GU) { transpose_item(a->dense_w_up, D, FF, Wgu0_t, a->ffn_norm, 4, scr, r, F.lane); continue; } r -= I_GU;
            if (r < I_DN) { transpose_item(a->dense_w_down, FF, D, Wd0_t, nullptr, 0, scr, r, F.lane); continue; } r -= I_DN;
            if (r < 8 * I_GU) { const int e = r / I_GU; transpose_item(a->moe_w_gate + (size_t)e * D * FF, D, FF, Wgu1_t + (size_t)e * 2 * FF * D, a->ffn_norm + D, 3, scr, r % I_GU, F.lane); continue; } r -= 8 * I_GU;
            { const int e = r / I_GU; transpose_item(a->moe_w_up + (size_t)e * D * FF, D, FF, Wgu1_t + (size_t)e * 2 * FF * D, a->ffn_norm + D, 4, scr, r % I_GU, F.lane); }
        }
        const float* x = a->x; const int* pos = a->pos; bf16_t* XB = WSP(bf16_t, WS_XB); float* rstd0 = WSP(float, SM_RSTD0); float* rope = WSP(float, SM_ROPE);
        for (int m = gw; m < T; m += NGW) {
            const f32x4* xr = (const f32x4*)(x + (size_t)m * D) + F.lane;
            f32x4 v[4]; float s = 0.f;
#pragma unroll
            for (int j = 0; j < 4; ++j) { v[j] = xr[64 * j]; s += (v[j][0] * v[j][0] + v[j][1] * v[j][1]) + (v[j][2] * v[j][2] + v[j][3] * v[j][3]); }
            s = wave_sum(s);
            u32x2* o8 = (u32x2*)(XB + (size_t)m * D) + F.lane;
#pragma unroll
            for (int j = 0; j < 4; ++j) { u32x2 w; w.x = cvtpk(v[j][0], v[j][1]); w.y = cvtpk(v[j][2], v[j][3]); o8[64 * j] = w; }
            if (F.lane == 0) rstd0[m] = 1.0f / sqrtf(s * (1.0f / D) + EPS);
            if (F.lane < 16) {
                const float invf = powf(10000.0f, -(float)F.lane / 16.0f);
                const float ang = (float)pos[m] * invf;
                float sn, cs; sincos_acc((double)ang, sn, cs);
                *(f32x2*)(rope + (size_t)m * 32 + 2 * F.lane) = (f32x2){cs, sn};
            }
        }
    }
    SEAM(0);

    for (int l = 0; l < 2; ++l) {
        const int pb = 1 + 6 * l;
        if (IN(pb)) {
            unsigned char* ws = get_args()->ws;
            pg8::Gemm g{WSP(bf16_t, WS_XB), WSP(bf16_t, WS_WIN) + (size_t)l * NY * D, D, D, D};
            pg8::SchedStatic S; S.o.init(T, NY, F.G, F.c);
            pg8::EpiG1 E{WSP(bf16_t, WS_Y), l == 0 ? WSP(float, SM_RSTD0) : nullptr, WSP(float, SM_PART), WSP(float, SM_PARTQ), WSP(float, SM_PARTKV), WSP(float, SM_FF), WSP(bf16_t, WS_KM), WSP(float, SM_ROPE)};
            pg8::gemm_phase<pg8::EpiG1, pg8::SchedStatic, true>(F.lds, g, S, E);
        }
        SEAM(pb);
        if (IN(pb + 1)) {
#ifndef P2MASK
#define P2MASK 15
#endif
            if ((P2MASK & 1) && F.c < 128) {
                unsigned char* ws = get_args()->ws;
                pg8::Gemm g{WSP(bf16_t, WS_Y) + Y_CQ, WSP(bf16_t, WS_WQUP) + (size_t)l * 512 * 256, NY, 256, 256};
                pg8::SchedOne S; S.has = true; S.un.pm = F.c >> 1; S.un.pn = F.c & 1; S.un.e = 0;
                pg8::EpiQup E{WSP(bf16_t, WS_QM), WSP(float, SM_PARTQ), WSP(float, SM_ROPE)};
                pg8::gemm_phase<pg8::EpiQup, pg8::SchedOne, false>(F.lds, g, S, E);
            } else if (P2MASK & 2) {
                unsigned char* ws = get_args()->ws;
                pg8::Gemm g{WSP(bf16_t, WS_Y) + Y_CKV, WSP(bf16_t, WS_WKVUP) + (size_t)l * 512 * 128, NY, 128, 128};
                pg8::SchedOne S; S.has = F.c < 256; S.un.pm = (F.c - 128) >> 1; S.un.pn = F.c & 1; S.un.e = 0;
                pg8::EpiKVup E{WSP(bf16_t, WS_KM), WSP(bf16_t, WS_VM), WSP(float, SM_PARTKV)};
                pg8::gemm_phase<pg8::EpiKVup, pg8::SchedOne, false>(F.lds, g, S, E);
            }
            __syncthreads();
            if (P2MASK & 4) for (int sq = F.c; sq < 8; sq += F.G) {
                ArgsP a = get_args(); unsigned char* ws = a->ws; const float* ffb = WSP(float, SM_FF); float* csl = WSP(float, SM_CSL);
                const int b = sq >> 2, h = sq & 3; const float bfv = a->b_forget[l * 4 + h];
                LAS double* sd = (LAS double*)F.lds;
                double loc[16]; double run = 0.0;
#pragma unroll
                for (int i = 0; i < 16; ++i) { const float z = ffb[(size_t)(b * SEQ + F.tid * 16 + i) * 4 + h] + bfv;
                    const float ls = fminf(z, 0.f) - log1pf(expf(-fabsf(z))); run += (double)ls; loc[i] = run; }
                double incl = run;
#pragma unroll
                for (int o = 1; o < 64; o <<= 1) { const double t = __shfl_up(incl, o); if (F.lane >= o) incl += t; }
                if (F.lane == 63) sd[F.wave] = incl;
                __syncthreads();
                double base = 0.0;
                for (int w = 0; w < F.wave; ++w) base += sd[w];
                const double excl = base + incl - run;
#pragma unroll
                for (int i = 0; i < 16; ++i) csl[(size_t)sq * SEQ + F.tid * 16 + i] = (float)((excl + loc[i]) * (double)LOG2E);
                __syncthreads();
            }
            if (P2MASK & 8) for (int idx = F.c; idx < 1024; idx += F.G) {
                ArgsP a = get_args(); unsigned char* ws = a->ws; const bf16_t* Y = WSP(bf16_t, WS_Y);
                att::AU u;
                if (idx < 256) {
                    const int b = idx >> 7, hq = (idx >> 5) & 3, qb = idx & 31;
                    const bf16_t* yb = Y + (size_t)b * SEQ * NY;
                    u.Q = yb + Y_SQ + hq * 64; u.K = yb + Y_SK + (hq >> 1) * 64; u.V = yb + Y_SV + (hq >> 1) * 64; u.qpitch = u.kpitch = u.vpitch = NY;
                    u.O = WSP(bf16_t, WS_MIX) + (size_t)b * SEQ * D + 256 + hq * 64; u.opitch = D; u.lse = nullptr; u.lpitch = 0; u.colb = nullptr;
                    u.q0 = qb * 256; u.span = 127; u.alibi = exp2f(-(float)(hq + 1)) * LOG2E; u.sink2 = a->sinks[l * 4 + hq] * LOG2E;
                } else {
                    const int p = (idx - 256) >> 8, rem = (idx - 256) & 255, b = rem >> 7, h = (rem >> 5) & 3, j = rem & 31;
                    const int dil = (p == 0) ? 1 : (p == 1) ? 4 : 16, nqb = (SEQ / dil) / 256, r = j / nqb, qb = j % nqb;
                    const bf16_t* yb = Y + (size_t)(b * SEQ + r) * NY;
                    u.Q = yb + Y_DQ + h * 64; u.K = yb + Y_DK + h * 64; u.V = yb + Y_DV + h * 64; u.qpitch = u.kpitch = u.vpitch = dil * NY;
                    u.O = WSP(bf16_t, WS_DP) + (size_t)p * T * 256 + (size_t)(b * SEQ + r) * 256 + h * 64; u.opitch = dil * 256;
                    u.lse = WSP(float, WS_DL) + (size_t)p * T * 4 + (size_t)(b * SEQ + r) * 4 + h; u.lpitch = dil * 4; u.colb = nullptr;
                    u.q0 = qb * 256; u.span = 128; u.alibi = exp2f(-(float)(h + 5)) * (float)dil * LOG2E; u.sink2 = -INFINITY;
                }
                u.kt0 = u.q0 / 64 - 2; if (u.kt0 < 0) u.kt0 = 0; u.kt1 = u.q0 / 64 + 4;
                att::attn_unit<4, 2>(u, F.lds);
            }
        }
        SEAM(pb + 1);
        if (IN(pb + 2)) {
            LAS unsigned* qslot = (LAS unsigned*)(F.lds + LDSCTL_OFF + 64);
            for (;;) {
                unsigned char* ws = get_args()->ws;
                if (F.tid == 0) *qslot = __hip_atomic_fetch_add((gu32*)(ws + WS_CTL) + CW_QUEUE + 64 * l, 1u, RLX_AGENT);
                __syncthreads();
                const int idx = (int)*qslot;
                __syncthreads();
                if (idx >= 768) break;
                if (idx < 512) {
                    const int qb = 31 - (idx >> 4), sub = idx & 15, bh = sub & 7, b = bh >> 2, h = bh & 3;
                    att::AU u; u.lse = nullptr; u.lpitch = 0; u.q0 = qb * 256; u.kt0 = 0; u.kt1 = 4 * qb + 4; u.span = 1 << 30; u.alibi = 0.f; u.sink2 = -INFINITY; u.opitch = D;
                    if (sub < 8) {
                        u.Q = WSP(bf16_t, WS_QM) + (size_t)b * SEQ * 384 + h * 96; u.K = WSP(bf16_t, WS_KM) + (size_t)b * SEQ * 384 + h * 96; u.V = WSP(bf16_t, WS_VM) + (size_t)b * SEQ * 256 + h * 64;
                        u.qpitch = 384; u.kpitch = 384; u.vpitch = 256; u.O = WSP(bf16_t, WS_MIX) + (size_t)b * SEQ * D + 512 + h * 64; u.colb = nullptr;
                        att::attn_unit<6, 0>(u, F.lds);
                    } else {
                        const bf16_t* yb = WSP(bf16_t, WS_Y) + (size_t)b * SEQ * NY;
                        u.Q = yb + Y_FQ + h * 64; u.K = yb + Y_FK + h * 64; u.V = yb + Y_FV + h * 64; u.qpitch = u.kpitch = u.vpitch = NY;
                        u.O = WSP(bf16_t, WS_MIX) + (size_t)b * SEQ * D + h * 64; u.colb = WSP(float, SM_CSL) + (size_t)bh * SEQ;
                        att::attn_unit<4, 1>(u, F.lds);
                    }
                } else {
                    const bf16_t* Dp = WSP(bf16_t, WS_DP); const float* Dl = WSP(float, WS_DL); bf16_t* MIX = WSP(bf16_t, WS_MIX);
                    const int t = (idx - 512) * 64 + (F.tid >> 3), dc = F.tid & 7;
#pragma unroll
                    for (int h = 0; h < 4; ++h) {
                        const float l0 = Dl[(size_t)t * 4 + h], l1 = Dl[(size_t)(T + t) * 4 + h], l2 = Dl[(size_t)(2 * T + t) * 4 + h];
                        const float mx = fmaxf(l0, fmaxf(l1, l2));
                        float w0 = __builtin_amdgcn_exp2f(l0 - mx), w1 = __builtin_amdgcn_exp2f(l1 - mx), w2 = __builtin_amdgcn_exp2f(l2 - mx);
                        const float inv = 1.0f / (w0 + w1 + w2); w0 *= inv; w1 *= inv; w2 *= inv;
                        const u32x4 a0 = *(const u32x4*)(Dp + (size_t)t * 256 + h * 64 + dc * 8), a1 = *(const u32x4*)(Dp + (size_t)(T + t) * 256 + h * 64 + dc * 8),
                                    a2 = *(const u32x4*)(Dp + (size_t)(2 * T + t) * 256 + h * 64 + dc * 8);
                        u32x4 o;
#pragma unroll
                        for (int e = 0; e < 4; ++e) {
                            const float lo_ = w0 * __uint_as_float(a0[e] << 16) + w1 * __uint_as_float(a1[e] << 16) + w2 * __uint_as_float(a2[e] << 16);
                            const float hi_ = w0 * __uint_as_float(a0[e] & 0xffff0000u) + w1 * __uint_as_float(a1[e] & 0xffff0000u) + w2 * __uint_as_float(a2[e] & 0xffff0000u);
                            o[e] = cvtpk(lo_, hi_);
                        }
                        *(u32x4*)(MIX + (size_t)t * D + 768 + h * 64 + dc * 8) = o;
                    }
                }
            }
        }
        SEAM(pb + 2);
        if (IN(pb + 3)) {
            ArgsP a = get_args(); unsigned char* ws = a->ws;
            pg8::Gemm g{WSP(bf16_t, WS_MIX), WSP(bf16_t, WS_WOUT) + (size_t)l * D * D, D, D, D};
            pg8::SchedStatic S; S.o.init(T, D, F.G, F.c);
            pg8::EpiRes E{l == 0 ? a->x : a->out, a->out, l == 0 ? WSP(bf16_t, WS_XB) : nullptr, WSP(float, SM_PART)};
            pg8::gemm_phase<pg8::EpiRes, pg8::SchedStatic, true>(F.lds, g, S, E);
        }
        SEAM(pb + 3);
        if (l == 0) {
            if (IN(5)) {
                unsigned char* ws = get_args()->ws;
                pg8::Gemm g{WSP(bf16_t, WS_XB), WSP(bf16_t, WS_WGU0), D, D, D};
                pg8::SchedStatic S; S.o.init(T, 2 * FF, F.G, F.c);
                pg8::EpiSwiglu E{WSP(bf16_t, WS_HID), nullptr, WSP(float, SM_PART)};
                pg8::gemm_phase<pg8::EpiSwiglu, pg8::SchedStatic, true>(F.lds, g, S, E);
            }
            SEAM(5);
            if (IN(6)) {
                ArgsP a = get_args(); unsigned char* ws = a->ws;
                pg8::Gemm g{WSP(bf16_t, WS_HID), WSP(bf16_t, WS_WD0), FF, FF, FF};
                pg8::SchedStatic S; S.o.init(T, D, F.G, F.c);
                pg8::EpiRes E{a->out, a->out, WSP(bf16_t, WS_XB), WSP(float, SM_PART)};
                pg8::gemm_phase<pg8::EpiRes, pg8::SchedStatic, true>(F.lds, g, S, E);
            }
            SEAM(6);
        }
    }
    if (IN(11)) {
        ArgsP a = get_args(); unsigned char* ws = a->ws; const float* xres = a->out;
        int* tok_e = WSP(int, SM_TOKE); float* tok_g = WSP(float, SM_TOKG); float* rstd_tok = WSP(float, SM_RSTDT); int* histg = WSP(int, SM_HIST);
        LAS float* Rg = (LAS float*)F.lds;
        LAS int* hist = (LAS int*)(F.lds + 32768);
        for (int i = F.tid; i < D * 8; i += 512) Rg[i] = a->router[i] * a->ffn_norm[D + (i >> 3)];
        for (int ch = F.c; ch < 256; ch += F.G) {
            if (F.tid < 8) hist[F.tid] = 0;
            __syncthreads();
            for (int j = 0; j < 8; ++j) {
                const int t = ch * 64 + F.wave * 8 + j;
                const f32x4* xr = (const f32x4*)(xres + (size_t)t * D) + F.lane;
                float acc[8] = {0.f, 0.f, 0.f, 0.f, 0.f, 0.f, 0.f, 0.f}; float ss = 0.f;
#pragma unroll
                for (int jj = 0; jj < 4; ++jj) { const f32x4 v = xr[64 * jj];
#pragma unroll
                    for (int e4 = 0; e4 < 4; ++e4) { const int k = 4 * F.lane + 256 * jj + e4; const float xv = v[e4]; ss += xv * xv;
                        const f32x4 r0 = *(const LAS f32x4*)(Rg + k * 8), r1 = *(const LAS f32x4*)(Rg + k * 8 + 4);
#pragma unroll
                        for (int e = 0; e < 4; ++e) { acc[e] += xv * r0[e]; acc[4 + e] += xv * r1[e]; } } }
                ss = wave_sum(ss);
#pragma unroll
                for (int e = 0; e < 8; ++e) acc[e] = wave_sum(acc[e]);
                const float rs = 1.0f / sqrtf(ss * (1.0f / D) + EPS);
                float v1 = -INFINITY; int e1 = 0;
#pragma unroll
                for (int e = 0; e < 8; ++e) { const float lg = acc[e] * rs; if (lg > v1) { v1 = lg; e1 = e; } }
                float v2 = -INFINITY; int e2 = 0;
#pragma unroll
                for (int e = 0; e < 8; ++e) { const float lg = acc[e] * rs; if (e != e1 && lg > v2) { v2 = lg; e2 = e; } }
                const float g1 = 1.0f / (1.0f + expf(v2 - v1));
                if (F.lane == 0) { tok_e[2 * t] = e1; tok_e[2 * t + 1] = e2; tok_g[2 * t] = g1; tok_g[2 * t + 1] = 1.0f - g1; rstd_tok[t] = rs;
                    atomicAdd((int*)&hist[e1], 1); atomicAdd((int*)&hist[e2], 1); }
            }
            __syncthreads();
            if (F.tid < 8) histg[ch * 8 + F.tid] = hist[F.tid];
            __syncthreads();
        }
    }
    SEAM(11);
    if (IN(12)) {
        ArgsP a = get_args(); unsigned char* ws = a->ws; const float* xres = a->out;
        const int* tok_e = WSP(int, SM_TOKE); const float* rstd_tok = WSP(float, SM_RSTDT); const int* histg = WSP(int, SM_HIST);
        int* slot = WSP(int, SM_SLOT); float* rstdg = WSP(float, SM_RSTDG); int* moetab = WSP(int, SM_MOETAB); bf16_t* XG = WSP(bf16_t, WS_XG);
        LAS int* tot = (LAS int*)F.lds; LAS int* pre = tot + 8; LAS int* rows = tot + 16;
        for (int ch = F.c; ch < 256; ch += F.G) {
            if (F.tid < 16) tot[F.tid] = 0;
            __syncthreads();
            { const int cch = F.tid >> 1, e0 = (F.tid & 1) * 4;
#pragma unroll
              for (int e = 0; e < 4; ++e) { const int v = histg[cch * 8 + e0 + e]; atomicAdd((int*)&tot[e0 + e], v); if (cch < ch) atomicAdd((int*)&pre[e0 + e], v); } }
            __syncthreads();
            int tbase[9]; tbase[0] = 0;
#pragma unroll
            for (int e = 0; e < 8; ++e) tbase[e + 1] = tbase[e] + (tot[e] + 255) / 256;
            if (ch == 0 && F.tid == 0) {
#pragma unroll
                for (int e = 0; e < 9; ++e) moetab[e] = tbase[e];
            }
            if (F.wave == 0) {
                const int t = ch * 64 + F.lane; const int e1 = tok_e[2 * t], e2 = tok_e[2 * t + 1];
                int r1 = 0, r2 = 0;
#pragma unroll
                for (int e = 0; e < 8; ++e) {
                    const unsigned long long mk = __ballot(e1 == e || e2 == e);
                    const int rank = __popcll(mk & ((1ull << F.lane) - 1ull));
                    const int row = tbase[e] * 256 + pre[e] + rank;
                    if (e1 == e) r1 = row; if (e2 == e) r2 = row;
                }
                slot[2 * t] = r1; slot[2 * t + 1] = r2; rows[2 * F.lane] = r1; rows[2 * F.lane + 1] = r2;
                const float rs = rstd_tok[t]; rstdg[r1] = rs; rstdg[r2] = rs;
            }
            __syncthreads();
            for (int j = 0; j < 8; ++j) {
                const int tl = F.wave * 8 + j, t = ch * 64 + tl; const int r1 = rows[2 * tl], r2 = rows[2 * tl + 1];
                const f32x4* xr = (const f32x4*)(xres + (size_t)t * D) + F.lane;
                u32x2* o1 = (u32x2*)(XG + (size_t)r1 * D) + F.lane; u32x2* o2 = (u32x2*)(XG + (size_t)r2 * D) + F.lane;
#pragma unroll
                for (int jj = 0; jj < 4; ++jj) { const f32x4 v = xr[64 * jj]; u32x2 w; w.x = cvtpk(v[0], v[1]); w.y = cvtpk(v[2], v[3]); o1[64 * jj] = w; o2[64 * jj] = w; }
            }
            __syncthreads();
        }
    }
    SEAM(12);
    if (IN(13)) {
        unsigned char* ws = get_args()->ws; const int* moetab = WSP(int, SM_MOETAB);
        pg8::Gemm g{WSP(bf16_t, WS_XG), WSP(bf16_t, WS_WGU1), D, D, D};
        pg8::SchedMoe S;
#pragma unroll
        for (int e = 0; e < 9; ++e) S.tb[e] = __builtin_amdgcn_readfirstlane(moetab[e]);
        S.o.init(S.tb[8] * 256, 2 * FF, F.G, F.c); S.estride = (size_t)2 * FF * D * 2;
        pg8::EpiSwiglu E{WSP(bf16_t, WS_HG), WSP(float, SM_RSTDG), nullptr};
        pg8::gemm_phase<pg8::EpiSwiglu, pg8::SchedMoe, true>(F.lds, g, S, E);
    }
    SEAM(13);
    if (IN(14)) {
        ArgsP a = get_args(); unsigned char* ws = a->ws;
        LAS float* scr = (LAS float*)(F.lds + F.wave * 16384);
        constexpr int I_DN = 56 * 32;
        for (int it = gw; it < 8 * I_DN; it += NGW) { const int e = it / I_DN; transpose_item(a->moe_w_down + (size_t)e * FF * D, FF, D, WSP(bf16_t, WS_WD1) + (size_t)e * D * FF, nullptr, 0, scr, it % I_DN, F.lane); }
    }
    SEAM(14);
    if (IN(15)) {
        unsigned char* ws = get_args()->ws; const int* moetab = WSP(int, SM_MOETAB);
        pg8::Gemm g{WSP(bf16_t, WS_HG), WSP(bf16_t, WS_WD1), FF, FF, FF};
        pg8::SchedMoe S;
#pragma unroll
        for (int e = 0; e < 9; ++e) S.tb[e] = __builtin_amdgcn_readfirstlane(moetab[e]);
        S.o.init(S.tb[8] * 256, D, F.G, F.c); S.estride = (size_t)D * FF * 2;
        pg8::EpiY E{WSP(bf16_t, WS_XG)};
        pg8::gemm_phase<pg8::EpiY, pg8::SchedMoe, true>(F.lds, g, S, E);
    }
    SEAM(15);
    if (IN(16)) {
        ArgsP a = get_args(); unsigned char* ws = a->ws; float* out = a->out; const float* fn = a->final_norm;
        const int* slot = WSP(int, SM_SLOT); const float* tok_g = WSP(float, SM_TOKG); const bf16_t* YG = WSP(bf16_t, WS_XG);
        for (int t = gw; t < T; t += NGW) {
            const f32x4* xr = (const f32x4*)(out + (size_t)t * D) + F.lane;
            const int r1 = slot[2 * t], r2 = slot[2 * t + 1]; const float g1 = tok_g[2 * t], g2 = tok_g[2 * t + 1];
            const u32x2* y1 = (const u32x2*)(YG + (size_t)r1 * D) + F.lane; const u32x2* y2 = (const u32x2*)(YG + (size_t)r2 * D) + F.lane;
            f32x4 v[4]; float s = 0.f;
#pragma unroll
            for (int j = 0; j < 4; ++j) { v[j] = xr[64 * j]; const u32x2 p = y1[64 * j], q = y2[64 * j];
                v[j][0] += g1 * __uint_as_float(p.x << 16) + g2 * __uint_as_float(q.x << 16);
                v[j][1] += g1 * __uint_as_float(p.x & 0xffff0000u) + g2 * __uint_as_float(q.x & 0xffff0000u);
                v[j][2] += g1 * __uint_as_float(p.y << 16) + g2 * __uint_as_float(q.y << 16);
                v[j][3] += g1 * __uint_as_float(p.y & 0xffff0000u) + g2 * __uint_as_float(q.y & 0xffff0000u);
                s += (v[j][0] * v[j][0] + v[j][1] * v[j][1]) + (v[j][2] * v[j][2] + v[j][3] * v[j][3]); }
            s = wave_sum(s);
            const float rs = 1.0f / sqrtf(s * (1.0f / D) + EPS);
            f32x4* o = (f32x4*)(out + (size_t)t * D) + F.lane; const f32x4* gn = (const f32x4*)fn + F.lane;
#pragma unroll
            for (int j = 0; j < 4; ++j) o[64 * j] = v[j] * rs * gn[64 * j];
        }
    }
#undef IN
#undef SEAM
}

extern "C" void kernel_launch(void* const* d_in, const int* in_sizes, int n_in, void* d_out, int out_size, void* d_ws, size_t ws_size, hipStream_t stream) {
    static int grid = 0;
    if (grid == 0) {
        int dev = 0, cus = 0;
        if (n_in != 20 || ws_size < WS_END) { fprintf(stderr, "kernel_launch: unexpected inputs (n_in %d, ws %zu)\n", n_in, ws_size); grid = -1; return; }
        if (hipGetDevice(&dev) != hipSuccess || hipDeviceGetAttribute(&cus, hipDeviceAttributeMultiprocessorCount, dev) != hipSuccess) { grid = -1; return; }
        if (hipFuncSetAttribute((const void*)mega_fwd, hipFuncAttributeMaxDynamicSharedMemorySize, LDS_BYTES) != hipSuccess) { grid = -1; return; }
        int per_cu = 0;
        (void)hipOccupancyMaxActiveBlocksPerMultiprocessor(&per_cu, (const void*)mega_fwd, NWAVES * 64, LDS_BYTES);
        (void)hipGetLastError();
        grid = cus;
    }
    if (grid < 0) return;
    (void)hipMemsetAsync((char*)d_ws + WS_CTL, 0, CTL_ZERO_BYTES, stream);
    Args a{};
    a.x = (const float*)d_in[0]; a.pos = (const int*)d_in[1]; a.attn_norm = (const float*)d_in[2]; a.w_in = (const float*)d_in[3]; a.b_forget = (const float*)d_in[4];
    a.mla_q_norm = (const float*)d_in[5]; a.w_q_up = (const float*)d_in[6]; a.mla_kv_norm = (const float*)d_in[7]; a.w_kv_up = (const float*)d_in[8]; a.sinks = (const float*)d_in[9];
    a.w_out = (const float*)d_in[10]; a.ffn_norm = (const float*)d_in[11]; a.dense_w_gate = (const float*)d_in[12]; a.dense_w_up = (const float*)d_in[13]; a.dense_w_down = (const float*)d_in[14];
    a.router = (const float*)d_in[15]; a.moe_w_gate = (const float*)d_in[16]; a.moe_w_up = (const float*)d_in[17]; a.moe_w_down = (const float*)d_in[18]; a.final_norm = (const float*)d_in[19];
    a.out = (float*)d_out; a.ws = (unsigned char*)d_ws;
#if MK_ONE_LAUNCH
    a.ph_lo = 0; a.ph_hi = NPH;
    hipLaunchKernelGGL(mega_fwd, dim3(grid), dim3(NWAVES * 64), LDS_BYTES, stream, a);
#else
    for (int p = 0; p < NPH; ++p) { a.ph_lo = p; a.ph_hi = p + 1; hipLaunchKernelGGL(mega_fwd, dim3(grid), dim3(NWAVES * 64), LDS_BYTES, stream, a); }
#endif
}
```

```cpp
#include <hip/hip_runtime.h>
#include <cstdio>
#include <cstdint>

#ifndef MK_ONE_LAUNCH
#define MK_ONE_LAUNCH 1
#endif

#define GAS __attribute__((address_space(1)))
#define LAS __attribute__((address_space(3)))
typedef unsigned short bf16_t;
typedef short bf16x8 __attribute__((ext_vector_type(8)));
typedef short s16x4 __attribute__((ext_vector_type(4)));
typedef float f32x2 __attribute__((ext_vector_type(2)));
typedef float f32x4 __attribute__((ext_vector_type(4)));
typedef float f32x16 __attribute__((ext_vector_type(16)));
typedef unsigned u32x2 __attribute__((ext_vector_type(2)));
typedef unsigned u32x4 __attribute__((ext_vector_type(4)));
typedef __bf16 bf16x2_t __attribute__((ext_vector_type(2)));
typedef GAS unsigned gu32;

constexpr int NB = 2, SEQ = 8192, T = NB * SEQ, D = 1024, NY = 2560, FF = 3584, NEXP = 8;
constexpr int NIN = 2468;
constexpr float EPS = 1e-6f;
constexpr float LOG2E = 1.4426950408889634f;
constexpr float C2_64 = 0.125f * LOG2E;
constexpr float C2_96 = 0.10206207261596575f * LOG2E;
constexpr int Y_FQ = 0, Y_FK = 256, Y_FV = 512, Y_SQ = 768, Y_SK = 1024, Y_SV = 1152, Y_CQ = 1280, Y_DQ = 1536, Y_DK = 1792, Y_DV = 2048,
              Y_CKV = 2304, Y_KR = 2432, Y_FF = 2464;
constexpr int MOE_MAX_TILES = 136, MOE_MAX_ROWS = MOE_MAX_TILES * 256;

constexpr size_t MiB = 1u << 20, KiB = 1u << 10;
constexpr size_t WS_CTL = 0, CTL_ZERO_BYTES = 1 * MiB;
constexpr size_t WS_SM = 1 * MiB;
constexpr size_t SM_RSTD0 = WS_SM, SM_PARTQ = WS_SM + 64 * KiB, SM_PARTKV = WS_SM + 320 * KiB, SM_FF = WS_SM + 576 * KiB, SM_CSL = WS_SM + 832 * KiB,
                 SM_PART = WS_SM + 1088 * KiB, SM_ROPE = WS_SM + 2112 * KiB, SM_TOKE = WS_SM + 4160 * KiB, SM_TOKG = WS_SM + 4288 * KiB,
                 SM_RSTDT = WS_SM + 4416 * KiB, SM_SLOT = WS_SM + 4480 * KiB, SM_RSTDG = WS_SM + 4608 * KiB, SM_HIST = WS_SM + 4800 * KiB, SM_MOETAB = WS_SM + 4808 * KiB;
constexpr size_t WS_WIN = 9 * MiB;
constexpr size_t WS_WQUP = 19 * MiB;
constexpr size_t WS_WKVUP = 19 * MiB + 512 * KiB;
constexpr size_t WS_WOUT = 20 * MiB;
constexpr size_t WS_WGU0 = 24 * MiB;
constexpr size_t WS_WD0 = 38 * MiB;
constexpr size_t WS_WGU1 = 45 * MiB;
constexpr size_t WS_WD1 = 45 * MiB;
constexpr size_t WS_XB = 157 * MiB;
constexpr size_t WS_Y = 189 * MiB;
constexpr size_t WS_QM = 269 * MiB, WS_KM = 281 * MiB, WS_VM = 293 * MiB;
constexpr size_t WS_MIX = 301 * MiB;
constexpr size_t WS_DP = 333 * MiB;
constexpr size_t WS_DL = 357 * MiB;
constexpr size_t WS_HID = 189 * MiB;
constexpr size_t WS_XG = 157 * MiB;
constexpr size_t WS_HG = 225 * MiB;
constexpr size_t WS_END = 463 * MiB;
constexpr int CW_BAR = 4096;
constexpr int CW_QUEUE = 16384;

constexpr int RING_BYTES = 131072;
constexpr int LDSCTL_OFF = RING_BYTES, MISC_OFF = LDSCTL_OFF + 320;
constexpr int LDS_BYTES = 147456;
constexpr int NWAVES = 8;

#define LDS_WAIT() asm volatile("s_waitcnt lgkmcnt(0)" ::: "memory")
#define VM_WAIT() asm volatile("s_waitcnt vmcnt(0)" ::: "memory")
#define RLX_AGENT __ATOMIC_RELAXED, __HIP_MEMORY_SCOPE_AGENT

__device__ __forceinline__ unsigned cvtpk(float lo, float hi) { f32x2 v = {lo, hi}; bf16x2_t b = __builtin_convertvector(v, bf16x2_t); return __builtin_bit_cast(unsigned, b); }
__device__ __forceinline__ float bf2f(unsigned short h) { return __uint_as_float((unsigned)h << 16); }
__device__ __forceinline__ float wave_sum(float v) {
#pragma unroll
    for (int o = 1; o < 64; o <<= 1) v += __shfl_xor(v, o);
    return v;
}

namespace pg8 {
constexpr int BM = 256, BK = 64, HALF = 128, HTB = HALF * BK * 2, STAGE_BYTES = 8 * HTB, NXCD = 8, WGM = 8;
__host__ __device__ __forceinline__ int lds_byte(int r, int c) { const int st = (r >> 4) * 2 + (c >> 5), rr = r & 15, cc = c & 31, ob = rr * 64 + cc * 2; return st * 1024 + (ob ^ (((ob >> 9) & 1) << 5)); }
__host__ __device__ __forceinline__ void stage_rc(int b, int& R, int& C) { const int st = b / 1024, sb = b % 1024, swz = sb ^ (((sb >> 9) & 1) << 5); R = (st >> 1) * 16 + swz / 64; C = (st & 1) * 32 + (swz % 64) / 2; }
__host__ __device__ __forceinline__ int perm32(int rho) { const int n = rho >> 4, i = rho & 15; return 8 * (i >> 2) + 4 * n + (i & 3); }

struct Unit { int pm, pn, e; };
struct Gemm { const bf16_t* A; const bf16_t* Bt; int lda, ldb, K; };

struct StaticOrder {
    int nM, nN, nwg, G, c;
    __device__ void init(int M, int N, int G_, int c_) { nM = M / BM; nN = N / BM; nwg = nM * nN; G = G_; c = c_; }
    __device__ bool next(int i, Unit& u) const {
        const long L = (long)i * G + c; if (L >= nwg) return false;
        int wgid = (int)L; { const int q = nwg / NXCD, r = nwg % NXCD, xcd = wgid % NXCD, off = wgid / NXCD; wgid = (xcd < r ? xcd * (q + 1) : r * (q + 1) + (xcd - r) * q) + off; }
        const int nig = WGM * nN, gid = wgid / nig, fm = gid * WGM, gsz = (nM - fm) < WGM ? (nM - fm) : WGM;
        u.pm = fm + ((wgid % nig) % gsz); u.pn = (wgid % nig) / gsz; u.e = 0; return true;
    }
};
struct SchedStatic {
    StaticOrder o;
    __device__ __forceinline__ bool next(int i, Unit& u) const { return o.next(i, u); }
    __device__ __forceinline__ const char* abase(const Gemm& g, const Unit& u) const { return (const char*)g.A + (size_t)u.pm * BM * g.lda * 2; }
    __device__ __forceinline__ const char* bbase(const Gemm& g, const Unit& u) const { return (const char*)g.Bt + (size_t)u.pn * BM * g.ldb * 2; }
};
struct SchedMoe {
    StaticOrder o; int tb[9]; size_t estride;
    __device__ __forceinline__ bool next(int i, Unit& u) const {
        if (!o.next(i, u)) return false; int e = 0;
#pragma unroll
        for (int j = 1; j < 8; ++j) e += (u.pm >= tb[j]) ? 1 : 0;
        u.e = e; return true;
    }
    __device__ __forceinline__ const char* abase(const Gemm& g, const Unit& u) const { return (const char*)g.A + (size_t)u.pm * BM * g.lda * 2; }
    __device__ __forceinline__ const char* bbase(const Gemm& g, const Unit& u) const { return (const char*)g.Bt + (size_t)u.e * estride + (size_t)u.pn * BM * g.ldb * 2; }
};
struct SchedOne {
    bool has; Unit un;
    __device__ __forceinline__ bool next(int i, Unit& u) const { if (i > 0 || !has) return false; u = un; return true; }
    __device__ __forceinline__ const char* abase(const Gemm& g, const Unit& u) const { return (const char*)g.A + (size_t)u.pm * BM * g.lda * 2; }
    __device__ __forceinline__ const char* bbase(const Gemm& g, const Unit& u) const { return (const char*)g.Bt + (size_t)u.pn * BM * g.ldb * 2; }
};

template <class Epi, class Sched, bool ALIGN_EPI>
__device__ __forceinline__ void gemm_phase(LAS unsigned char* lds, const Gemm g_in, const Sched& S, const Epi& E) {
    Gemm g = g_in; asm volatile("" : "+s"(g.A), "+s"(g.Bt), "+s"(g.K));
    int tid_l = threadIdx.x; asm volatile("" : "+v"(tid_l));
    const int tid = tid_l, wid = __builtin_amdgcn_readfirstlane(tid >> 6), lane = tid & 63, wr = wid >> 2, wc = wid & 3, fr = lane & 15, fq = lane >> 4;
    const int K = g.K, nt = K / BK;
    unsigned voffA[2], voffB[2];
#pragma unroll
    for (int i = 0; i < 2; ++i) { int R, C; stage_rc(tid * 16 + i * 8192, R, C); const int Rb = Epi::PERM ? ((R & ~31) + perm32(R & 31)) : R;
        voffA[i] = (unsigned)(R * g.lda + C) * 2u; voffB[i] = (unsigned)(Rb * g.ldb + C) * 2u; }
    const size_t kstep = (size_t)(BK * 2);
    const size_t hstepA = (size_t)HALF * g.lda * 2, hstepB = (size_t)HALF * g.ldb * 2;
    const unsigned ldsw = (unsigned)wid * 1024u;
    const int aoff = lds_byte(wr * 64 + fr, fq * 8), boff = lds_byte(wc * 32 + fr, fq * 8);
#define PG8_SA(b, h) (((b) * 2 + (h)) * HTB)
#define PG8_SB(b, h) ((4 + (b) * 2 + (h)) * HTB)
#define PG8_STAGE(bufoff, gbase, voff) do { _Pragma("unroll") for (int _i = 0; _i < 2; ++_i) \
        __builtin_amdgcn_global_load_lds((const unsigned*)((const char*)(gbase) + (voff)[_i]), (LAS unsigned*)(lds + (bufoff) + ldsw + _i * 8192), 16, 0, 0); } while (0)
#define PG8_LDA(dst, b, h) do { _Pragma("unroll") for (int m = 0; m < 4; ++m) _Pragma("unroll") for (int k = 0; k < 2; ++k) dst[m][k] = *(const LAS bf16x8*)(lds + PG8_SA(b, h) + aoff + m * 2048 + k * 1024); } while (0)
#define PG8_LDB(dst, b, h) do { _Pragma("unroll") for (int n = 0; n < 2; ++n) _Pragma("unroll") for (int k = 0; k < 2; ++k) dst[n][k] = *(const LAS bf16x8*)(lds + PG8_SB(b, h) + boff + n * 2048 + k * 1024); } while (0)
#define PG8_MMA(ai, bj, At, Bt) do { __builtin_amdgcn_s_setprio(1); _Pragma("unroll") for (int m = 0; m < 4; ++m) _Pragma("unroll") for (int n = 0; n < 2; ++n) _Pragma("unroll") for (int k = 0; k < 2; ++k) \
        acc[ai][bj][m][n] = __builtin_amdgcn_mfma_f32_16x16x32_bf16(Bt[n][k], At[m][k], acc[ai][bj][m][n], 0, 0, 0); __builtin_amdgcn_s_setprio(0); } while (0)
#define PG8_WAIT_V(n) asm volatile("s_waitcnt vmcnt(" #n ")" ::: "memory")
#define PG8_WAIT_L(n) asm volatile("s_waitcnt lgkmcnt(" #n ")" ::: "memory")
#define PG8_BAR __builtin_amdgcn_s_barrier()
#define PG8_SCHED __builtin_amdgcn_sched_barrier(0)
    Unit cur, nxt; int ui = 0;
    if (!S.next(0, cur)) return;
    f32x4 acc[2][2][4][2];
#pragma unroll
    for (int a = 0; a < 2; ++a)
#pragma unroll
        for (int b = 0; b < 2; ++b)
#pragma unroll
            for (int m = 0; m < 4; ++m)
#pragma unroll
                for (int n = 0; n < 2; ++n) acc[a][b][m][n] = (f32x4){0.f, 0.f, 0.f, 0.f};
    bf16x8 At[4][2], B0[2][2], B1[2][2];
    const char* cA = S.abase(g, cur); const char* cB = S.bbase(g, cur);
    PG8_STAGE(PG8_SB(0, 0), cB, voffB); PG8_STAGE(PG8_SB(0, 1), cB + hstepB, voffB); PG8_STAGE(PG8_SA(0, 0), cA, voffA); PG8_STAGE(PG8_SA(0, 1), cA + hstepA, voffA);
    if (wr == 1) PG8_BAR;
    PG8_WAIT_V(2); PG8_BAR;
    PG8_STAGE(PG8_SB(1, 0), cB + kstep, voffB); PG8_STAGE(PG8_SA(1, 0), cA + kstep, voffA); PG8_STAGE(PG8_SB(1, 1), cB + hstepB + kstep, voffB);
    PG8_WAIT_V(6); PG8_BAR;
    for (;;) {
        const bool has_next = S.next(ui + 1, nxt);
        const char* nA = has_next ? S.abase(g, nxt) : cA; const char* nB = has_next ? S.bbase(g, nxt) : cB;
        for (int t = 0; t < nt; t += 2) {
            const bool last = (t == nt - 2);
            const char* a1 = cA + (size_t)(t + 1) * kstep;
            const char* a2 = last ? nA : cA + (size_t)(t + 2) * kstep; const char* b2 = last ? nB : cB + (size_t)(t + 2) * kstep;
            const char* a3 = a2 + kstep; const char* b3 = b2 + kstep;
            PG8_LDB(B0, 0, 0); PG8_LDB(B1, 0, 1); PG8_SCHED; PG8_LDA(At, 0, 0); PG8_STAGE(PG8_SA(1, 1), a1 + hstepA, voffA);
            PG8_WAIT_V(8); PG8_WAIT_L(0); PG8_BAR; PG8_MMA(0, 0, At, B0); PG8_MMA(0, 1, At, B1); PG8_BAR; PG8_SCHED;
            PG8_LDA(At, 0, 1); PG8_STAGE(PG8_SB(0, 0), b2, voffB); PG8_STAGE(PG8_SB(0, 1), b2 + hstepB, voffB); PG8_STAGE(PG8_SA(0, 0), a2, voffA);
            PG8_WAIT_V(8); PG8_WAIT_L(0); PG8_BAR; PG8_MMA(1, 0, At, B0); PG8_MMA(1, 1, At, B1); PG8_BAR; PG8_SCHED;
            PG8_LDB(B0, 1, 0); PG8_LDB(B1, 1, 1); PG8_SCHED; PG8_LDA(At, 1, 0); PG8_STAGE(PG8_SA(0, 1), a2 + hstepA, voffA);
            PG8_WAIT_V(8); PG8_WAIT_L(0); PG8_BAR; PG8_MMA(0, 0, At, B0); PG8_MMA(0, 1, At, B1); PG8_BAR; PG8_SCHED;
            PG8_LDA(At, 1, 1); PG8_STAGE(PG8_SB(1, 0), b3, voffB); PG8_STAGE(PG8_SB(1, 1), b3 + hstepB, voffB); PG8_STAGE(PG8_SA(1, 0), a3, voffA);
            PG8_WAIT_V(8); PG8_WAIT_L(0); PG8_BAR; PG8_MMA(1, 0, At, B0); PG8_MMA(1, 1, At, B1); PG8_BAR; PG8_SCHED;
        }
        if constexpr (ALIGN_EPI) { if (wr == 0) PG8_BAR; }
        E(acc, cur, wr, wc, fr, fq);
        if (!has_next) break;
#pragma unroll
        for (int a = 0; a < 2; ++a)
#pragma unroll
            for (int b = 0; b < 2; ++b)
#pragma unroll
                for (int m = 0; m < 4; ++m)
#pragma unroll
                    for (int n = 0; n < 2; ++n) acc[a][b][m][n] = (f32x4){0.f, 0.f, 0.f, 0.f};
        cur = nxt; cA = nA; cB = nB; ++ui;
        if constexpr (ALIGN_EPI) { if (wr == 1) PG8_BAR; }
    }
    PG8_WAIT_V(0);
    if constexpr (!ALIGN_EPI) { if (wr == 0) PG8_BAR; }
    PG8_BAR;
#undef PG8_SA
#undef PG8_SB
#undef PG8_STAGE
#undef PG8_LDA
#undef PG8_LDB
#undef PG8_MMA
#undef PG8_WAIT_V
#undef PG8_WAIT_L
#undef PG8_BAR
#undef PG8_SCHED
}

__device__ __forceinline__ float rstd_part(const float* part, int row) {
    const f32x4* p = (const f32x4*)(part + (size_t)row * 16);
    const f32x4 a = p[0], b = p[1], c = p[2], d = p[3];
    const float s = ((a[0] + a[1]) + (a[2] + a[3])) + ((b[0] + b[1]) + (b[2] + b[3])) + ((c[0] + c[1]) + (c[2] + c[3])) + ((d[0] + d[1]) + (d[2] + d[3]));
    return 1.0f / sqrtf(s * (1.0f / D) + EPS);
}
__device__ __forceinline__ u32x4 pack8(const f32x4 v0, const f32x4 v1) { u32x4 w; w.x = cvtpk(v0[0], v0[1]); w.y = cvtpk(v0[2], v0[3]); w.z = cvtpk(v1[0], v1[1]); w.w = cvtpk(v1[2], v1[3]); return w; }

struct EpiG1 {
    static constexpr bool PERM = true;
    bf16_t* Y; const float* rstd_direct; const float* part; float* partq; float* partkv; float* ff; bf16_t* Km; const float* rope;
    __device__ __forceinline__ void operator()(const f32x4 (&acc)[2][2][4][2], const Unit& u, int wr, int wc, int fr, int fq) const {
#pragma unroll
        for (int ai = 0; ai < 2; ++ai)
#pragma unroll
            for (int m = 0; m < 4; ++m) {
                asm volatile("" ::: "memory");
                const int row = u.pm * BM + ai * HALF + wr * 64 + m * 16 + fr;
                const float rs = rstd_direct ? rstd_direct[row] : rstd_part(part, row);
                f32x4 v[2][2];
#pragma unroll
                for (int bj = 0; bj < 2; ++bj) { v[bj][0] = acc[ai][bj][m][0] * rs; v[bj][1] = acc[ai][bj][m][1] * rs;
                    *(u32x4*)(Y + (size_t)row * NY + u.pn * BM + bj * HALF + wc * 32 + 8 * fq) = pack8(v[bj][0], v[bj][1]); }
                if (u.pn == Y_CQ / 256) {
                    float s = 0.f;
#pragma unroll
                    for (int bj = 0; bj < 2; ++bj)
#pragma unroll
                        for (int n = 0; n < 2; ++n) { const f32x4 x = v[bj][n]; s += (x[0] * x[0] + x[1] * x[1]) + (x[2] * x[2] + x[3] * x[3]); }
                    s += __shfl_xor(s, 16); s += __shfl_xor(s, 32);
                    if (fq == 0) partq[row * 4 + wc] = s;
                }
                if (u.pn == Y_CKV / 256) {
                    float s = 0.f;
#pragma unroll
                    for (int n = 0; n < 2; ++n) { const f32x4 x = v[0][n]; s += (x[0] * x[0] + x[1] * x[1]) + (x[2] * x[2] + x[3] * x[3]); }
                    s += __shfl_xor(s, 16); s += __shfl_xor(s, 32);
                    if (fq == 0) partkv[row * 4 + wc] = s;
                    if (wc == 0) {
                        const f32x4* rp = (const f32x4*)(rope + (size_t)row * 32 + 8 * fq);
                        const f32x4 cs0 = rp[0], cs1 = rp[1];
                        const f32x4 t1 = v[1][0], t2 = v[1][1];
                        f32x4 o1, o2;
                        o1[0] = t1[0] * cs0[0] - t2[0] * cs0[1]; o2[0] = t2[0] * cs0[0] + t1[0] * cs0[1];
                        o1[1] = t1[1] * cs0[2] - t2[1] * cs0[3]; o2[1] = t2[1] * cs0[2] + t1[1] * cs0[3];
                        o1[2] = t1[2] * cs1[0] - t2[2] * cs1[1]; o2[2] = t2[2] * cs1[0] + t1[2] * cs1[1];
                        o1[3] = t1[3] * cs1[2] - t2[3] * cs1[3]; o2[3] = t2[3] * cs1[2] + t1[3] * cs1[3];
                        const u32x4 w = pack8(o1, o2);
#pragma unroll
                        for (int h = 0; h < 4; ++h) *(u32x4*)(Km + (size_t)row * 384 + h * 96 + 64 + 8 * fq) = w;
                    }
                    if (wc == 1 && fq == 0) *(f32x4*)(ff + (size_t)row * 4) = v[1][0];
                }
            }
    }
};
struct EpiQup {
    static constexpr bool PERM = true;
    bf16_t* Qm; const float* partq; const float* rope;
    __device__ __forceinline__ void operator()(const f32x4 (&acc)[2][2][4][2], const Unit& u, int wr, int wc, int fr, int fq) const {
#pragma unroll
        for (int ai = 0; ai < 2; ++ai)
#pragma unroll
            for (int m = 0; m < 4; ++m) {
                asm volatile("" ::: "memory");
                const int row = u.pm * BM + ai * HALF + wr * 64 + m * 16 + fr;
                const f32x4 pq = *(const f32x4*)(partq + (size_t)row * 4);
                const float rs = 1.0f / sqrtf(((pq[0] + pq[1]) + (pq[2] + pq[3])) * (1.0f / 256.0f) + EPS);
#pragma unroll
                for (int bj = 0; bj < 2; ++bj) {
                    const int col = u.pn * BM + bj * HALF + wc * 32 + 8 * fq;
                    if (col < 384) {
                        f32x4 v0 = acc[ai][bj][m][0] * rs, v1 = acc[ai][bj][m][1] * rs;
                        const int cm = col % 96;
                        if (cm >= 64) {
                            const f32x4* rp = (const f32x4*)(rope + (size_t)row * 32 + (cm - 64));
                            const f32x4 cs0 = rp[0], cs1 = rp[1];
                            const f32x4 t1 = v0, t2 = v1;
                            v0[0] = t1[0] * cs0[0] - t2[0] * cs0[1]; v1[0] = t2[0] * cs0[0] + t1[0] * cs0[1];
                            v0[1] = t1[1] * cs0[2] - t2[1] * cs0[3]; v1[1] = t2[1] * cs0[2] + t1[1] * cs0[3];
                            v0[2] = t1[2] * cs1[0] - t2[2] * cs1[1]; v1[2] = t2[2] * cs1[0] + t1[2] * cs1[1];
                            v0[3] = t1[3] * cs1[2] - t2[3] * cs1[3]; v1[3] = t2[3] * cs1[2] + t1[3] * cs1[3];
                        }
                        *(u32x4*)(Qm + (size_t)row * 384 + col) = pack8(v0, v1);
                    }
                }
            }
    }
};
struct EpiKVup {
    static constexpr bool PERM = true;
    bf16_t* Km; bf16_t* Vm; const float* partkv;
    __device__ __forceinline__ void operator()(const f32x4 (&acc)[2][2][4][2], const Unit& u, int wr, int wc, int fr, int fq) const {
#pragma unroll
        for (int ai = 0; ai < 2; ++ai)
#pragma unroll
            for (int m = 0; m < 4; ++m) {
                asm volatile("" ::: "memory");
                const int row = u.pm * BM + ai * HALF + wr * 64 + m * 16 + fr;
                const f32x4 pq = *(const f32x4*)(partkv + (size_t)row * 4);
                const float rs = 1.0f / sqrtf(((pq[0] + pq[1]) + (pq[2] + pq[3])) * (1.0f / 128.0f) + EPS);
#pragma unroll
                for (int bj = 0; bj < 2; ++bj) {
                    const int col = u.pn * BM + bj * HALF + wc * 32 + 8 * fq;
                    const int h = col >> 7, c = col & 127;
                    const u32x4 w = pack8(acc[ai][bj][m][0] * rs, acc[ai][bj][m][1] * rs);
                    if (c < 64) *(u32x4*)(Km + (size_t)row * 384 + h * 96 + c) = w;
                    else *(u32x4*)(Vm + (size_t)row * 256 + h * 64 + (c - 64)) = w;
                }
            }
    }
};
struct EpiRes {
    static constexpr bool PERM = false;
    const float* base; float* out; bf16_t* xb; float* part;
    __device__ __forceinline__ void operator()(const f32x4 (&acc)[2][2][4][2], const Unit& u, int wr, int wc, int fr, int fq) const {
#pragma unroll
        for (int ai = 0; ai < 2; ++ai)
#pragma unroll
            for (int m = 0; m < 4; ++m) {
                asm volatile("" ::: "memory");
                const int row = u.pm * BM + ai * HALF + wr * 64 + m * 16 + fr;
                float s = 0.f;
#pragma unroll
                for (int bj = 0; bj < 2; ++bj)
#pragma unroll
                    for (int n = 0; n < 2; ++n) {
                        const size_t off = (size_t)row * D + u.pn * BM + bj * HALF + wc * 32 + n * 16 + 4 * fq;
                        const f32x4 x = *(const f32x4*)(base + off) + acc[ai][bj][m][n];
                        *(f32x4*)(out + off) = x;
                        s += (x[0] * x[0] + x[1] * x[1]) + (x[2] * x[2] + x[3] * x[3]);
                        if (xb) { u32x2 w; w.x = cvtpk(x[0], x[1]); w.y = cvtpk(x[2], x[3]); *(u32x2*)(xb + off) = w; }
                    }
                s += __shfl_xor(s, 16); s += __shfl_xor(s, 32);
                if (fq == 0) part[(size_t)row * 16 + u.pn * 4 + wc] = s;
            }
    }
};
struct EpiSwiglu {
    static constexpr bool PERM = true;
    bf16_t* H; const float* rstd_direct; const float* part;
    __device__ __forceinline__ void operator()(const f32x4 (&acc)[2][2][4][2], const Unit& u, int wr, int wc, int fr, int fq) const {
#pragma unroll
        for (int ai = 0; ai < 2; ++ai)
#pragma unroll
            for (int m = 0; m < 4; ++m) {
                asm volatile("" ::: "memory");
                const int row = u.pm * BM + ai * HALF + wr * 64 + m * 16 + fr;
                const float rs = rstd_direct ? rstd_direct[row] : rstd_part(part, row);
                f32x4 hv[2];
#pragma unroll
                for (int n = 0; n < 2; ++n) {
                    const f32x4 gt = acc[ai][0][m][n] * rs, up = acc[ai][1][m][n] * rs;
#pragma unroll
                    for (int e = 0; e < 4; ++e) { const float sg = __builtin_amdgcn_rcpf(1.0f + __builtin_amdgcn_exp2f(-gt[e] * LOG2E)); hv[n][e] = gt[e] * sg * up[e]; }
                }
                *(u32x4*)(H + (size_t)row * FF + u.pn * HALF + wc * 32 + 8 * fq) = pack8(hv[0], hv[1]);
            }
    }
};
struct EpiY {
    static constexpr bool PERM = true;
    bf16_t* O;
    __device__ __forceinline__ void operator()(const f32x4 (&acc)[2][2][4][2], const Unit& u, int wr, int wc, int fr, int fq) const {
#pragma unroll
        for (int ai = 0; ai < 2; ++ai)
#pragma unroll
            for (int m = 0; m < 4; ++m) {
                asm volatile("" ::: "memory");
                const int row = u.pm * BM + ai * HALF + wr * 64 + m * 16 + fr;
#pragma unroll
                for (int bj = 0; bj < 2; ++bj) *(u32x4*)(O + (size_t)row * D + u.pn * BM + bj * HALF + wc * 32 + 8 * fq) = pack8(acc[ai][bj][m][0], acc[ai][bj][m][1]);
            }
    }
};
}

namespace att {
constexpr int KSLOT = 12288, VSLOT = 8192;
constexpr int LDS_K = 0, LDS_V = 2 * KSLOT, LDS_WS = LDS_V + 2 * VSLOT, LDS_OST = LDS_WS + 8 * 256, LDS_CB = LDS_OST + 8 * 4096, LDS_TOTAL = LDS_CB + 32768;
static_assert(LDS_TOTAL <= RING_BYTES, "attention LDS");
struct AU {
    const bf16_t* Q; const bf16_t* K; const bf16_t* V; bf16_t* O; float* lse; const float* colb;
    int qpitch, kpitch, vpitch, opitch, lpitch;
    int q0, kt0, kt1, span; float alibi, sink2;
};
__device__ __forceinline__ int crow(int r, int hi) { return (r & 3) + 8 * (r >> 2) + 4 * hi; }
__device__ __forceinline__ void glds16(const void* gsrc, unsigned lds_dst) { unsigned keep;
    asm volatile("s_mov_b32 %0, m0\n\ts_mov_b32 m0, %2\n\ts_nop 0\n\tglobal_load_lds_dwordx4 %1, off\n\ts_mov_b32 m0, %0" : "=&s"(keep) : "v"(gsrc), "s"(lds_dst) : "memory"); }
#define ATT_WAIT_BAR() asm volatile("s_waitcnt vmcnt(0) lgkmcnt(0)\n\ts_barrier" ::: "memory")
__device__ __forceinline__ float permswap_max(float m) { auto rr = __builtin_amdgcn_permlane32_swap(__float_as_uint(m), __float_as_uint(m), false, false); return fmaxf(__uint_as_float(rr[0]), __uint_as_float(rr[1])); }
__device__ __forceinline__ float permswap_sum(float m) { auto rr = __builtin_amdgcn_permlane32_swap(__float_as_uint(m), __float_as_uint(m), false, false); return __uint_as_float(rr[0]) + __uint_as_float(rr[1]); }

template <int NDK, int MODE>
__device__ __forceinline__ void attn_unit(const AU& u, LAS unsigned char* shm) {
    int tid_l = threadIdx.x; asm volatile("" : "+v"(tid_l));
    const int tid = tid_l, lane = tid & 63, r32 = lane & 31, hi = lane >> 5; const int wid = __builtin_amdgcn_readfirstlane(tid >> 6);
    const unsigned lds0 = (unsigned)(uintptr_t)shm;
    LAS float* wsf = (LAS float*)(shm + LDS_WS) + wid * 64;
    LAS float* cb = (LAS float*)(shm + LDS_CB);
    const int q = u.q0 + wid * 32 + r32;
    const int qmin = u.q0 + wid * 32, qmax = qmin + 31;
    float cq = 0.f;
    if (MODE == 1) {
        const int nk = (u.kt1 - u.kt0) * 64;
        for (int i = tid; i < nk; i += 512) cb[i] = u.colb[u.kt0 * 64 + i];
        cq = u.colb[q];
    }
    bf16x8 qr[NDK];
    { const bf16_t* qp = u.Q + (size_t)q * u.qpitch + hi * 8;
#pragma unroll
      for (int d0 = 0; d0 < NDK; ++d0) qr[d0] = *(const bf16x8*)(qp + d0 * 16); }
#define ATT_ISSUE(kt_, s_) do { \
        const bf16_t* kp_ = u.K + (size_t)((kt_) * 64 + lane) * u.kpitch; \
        glds16(kp_ + wid * 8, (unsigned)__builtin_amdgcn_readfirstlane(lds0 + LDS_K + (s_) * KSLOT + wid * 1024)); \
        if (NDK == 6) { if (wid < 4) glds16(kp_ + (wid + 8) * 8, (unsigned)__builtin_amdgcn_readfirstlane(lds0 + LDS_K + (s_) * KSLOT + (wid + 8) * 1024)); } \
        const bf16_t* vp_ = u.V + (size_t)((kt_) * 64 + 16 * (wid & 3) + (lane >> 2)) * u.vpitch + (wid >> 2) * 32 + (lane & 3) * 8; \
        glds16(vp_, (unsigned)__builtin_amdgcn_readfirstlane(lds0 + LDS_V + (s_) * VSLOT + wid * 1024)); } while (0)
    float mrun = -3.0e38f, lrun = 0.f;
    f32x16 o0 = {}, o1 = {};
    ATT_ISSUE(u.kt0, 0);
    for (int kt = u.kt0; kt < u.kt1; ++kt) {
        const int s = (kt - u.kt0) & 1;
        ATT_WAIT_BAR();
        if (kt + 1 < u.kt1) ATT_ISSUE(kt + 1, s ^ 1);
        const int kmin = kt * 64, kmax = kmin + 63;
        if (kmin > qmax) continue;
        if (MODE == 2 && kmax < qmin - u.span) continue;
        f32x16 p0 = {}, p1 = {};
        { const LAS unsigned char* kb = shm + LDS_K + s * KSLOT + hi * 1024 + r32 * 16;
#pragma unroll
          for (int d0 = 0; d0 < NDK; ++d0) {
              const bf16x8 b0 = *(const LAS bf16x8*)(kb + d0 * 2048), b1 = *(const LAS bf16x8*)(kb + d0 * 2048 + 512);
              p0 = __builtin_amdgcn_mfma_f32_32x32x16_bf16(b0, qr[d0], p0, 0, 0, 0);
              p1 = __builtin_amdgcn_mfma_f32_32x32x16_bf16(b1, qr[d0], p1, 0, 0, 0);
          } }
        if (MODE == 1) {
            const LAS f32x4* cp = (const LAS f32x4*)(cb + (kt - u.kt0) * 64 + 4 * hi);
#pragma unroll
            for (int j = 0; j < 4; ++j) { const f32x4 c0 = cp[2 * j], c1 = cp[2 * j + 8];
#pragma unroll
                for (int e = 0; e < 4; ++e) { p0[4 * j + e] += cq - c0[e]; p1[4 * j + e] += cq - c1[e]; } }
        }
        if (MODE == 2) {
#pragma unroll
            for (int r = 0; r < 16; ++r) { const int d0 = q - (kmin + crow(r, hi)), d1 = d0 - 32;
                p0[r] = ((unsigned)d0 <= (unsigned)u.span) ? p0[r] - u.alibi * (float)d0 : -INFINITY;
                p1[r] = ((unsigned)d1 <= (unsigned)u.span) ? p1[r] - u.alibi * (float)d1 : -INFINITY; }
        } else if (kmax > qmin) {
#pragma unroll
            for (int r = 0; r < 16; ++r) { const int kj = kmin + crow(r, hi); if (kj > q) p0[r] = -INFINITY; if (kj + 32 > q) p1[r] = -INFINITY; }
        }
        float rm = fmaxf(p0[0], p1[0]);
#pragma unroll
        for (int r = 1; r < 16; ++r) rm = fmaxf(rm, fmaxf(p0[r], p1[r]));
        rm = permswap_max(rm);
        const float mn = fmaxf(mrun, rm), alpha = __builtin_amdgcn_exp2f(mrun - mn);
        mrun = mn;
        float sum = 0.f;
#pragma unroll
        for (int r = 0; r < 16; ++r) { p0[r] = __builtin_amdgcn_exp2f(p0[r] - mn); p1[r] = __builtin_amdgcn_exp2f(p1[r] - mn); sum += p0[r] + p1[r]; }
        lrun = lrun * alpha + sum;
        if (!__all(alpha == 1.0f)) {
            if (hi == 0) wsf[r32] = alpha;
            LDS_WAIT();
#pragma unroll
            for (int j = 0; j < 4; ++j) { const f32x4 f = *(const LAS f32x4*)(wsf + 8 * j + 4 * hi);
#pragma unroll
                for (int e = 0; e < 4; ++e) { o0[4 * j + e] *= f[e]; o1[4 * j + e] *= f[e]; } }
        }
        u32x4 pw0, pw1, pw2, pw3;
        pw0 = (u32x4){cvtpk(p0[0], p0[1]), cvtpk(p0[2], p0[3]), cvtpk(p0[4], p0[5]), cvtpk(p0[6], p0[7])};
        pw1 = (u32x4){cvtpk(p0[8], p0[9]), cvtpk(p0[10], p0[11]), cvtpk(p0[12], p0[13]), cvtpk(p0[14], p0[15])};
        pw2 = (u32x4){cvtpk(p1[0], p1[1]), cvtpk(p1[2], p1[3]), cvtpk(p1[4], p1[5]), cvtpk(p1[6], p1[7])};
        pw3 = (u32x4){cvtpk(p1[8], p1[9]), cvtpk(p1[10], p1[11]), cvtpk(p1[12], p1[13]), cvtpk(p1[14], p1[15])};
        { const LAS unsigned char* vb = shm + LDS_V + s * VSLOT + ((lane >> 4) & 1) * 32 + (lane & 3) * 8 + (4 * hi + ((lane & 15) >> 2)) * 64;
#pragma unroll
          for (int d0 = 0; d0 < 2; ++d0) {
              bf16x8 vf[4];
#pragma unroll
              for (int ks = 0; ks < 4; ++ks) {
                  const s16x4 lo = __builtin_bit_cast(s16x4, __builtin_amdgcn_ds_read_tr16_b64_v4i16((LAS s16x4*)(vb + d0 * 4096 + ks * 1024)));
                  const s16x4 hh = __builtin_bit_cast(s16x4, __builtin_amdgcn_ds_read_tr16_b64_v4i16((LAS s16x4*)(vb + d0 * 4096 + ks * 1024 + 512)));
                  vf[ks] = (bf16x8){lo[0], lo[1], lo[2], lo[3], hh[0], hh[1], hh[2], hh[3]};
              }
              f32x16& od = d0 ? o1 : o0;
              od = __builtin_amdgcn_mfma_f32_32x32x16_bf16(__builtin_bit_cast(bf16x8, pw0), vf[0], od, 0, 0, 0);
              od = __builtin_amdgcn_mfma_f32_32x32x16_bf16(__builtin_bit_cast(bf16x8, pw1), vf[1], od, 0, 0, 0);
              od = __builtin_amdgcn_mfma_f32_32x32x16_bf16(__builtin_bit_cast(bf16x8, pw2), vf[2], od, 0, 0, 0);
              od = __builtin_amdgcn_mfma_f32_32x32x16_bf16(__builtin_bit_cast(bf16x8, pw3), vf[3], od, 0, 0, 0);
          } }
    }
    float ltot = permswap_sum(lrun);
    if (u.lse && hi == 0) u.lse[(size_t)q * u.lpitch] = mrun + __builtin_amdgcn_logf(ltot);
    if (MODE == 2) ltot += __builtin_amdgcn_exp2f(u.sink2 - mrun);
    if (hi == 0) wsf[32 + r32] = ltot;
    LDS_WAIT();
    float rli[16];
#pragma unroll
    for (int j = 0; j < 4; ++j) { const f32x4 f = *(const LAS f32x4*)(wsf + 32 + 8 * j + 4 * hi);
#pragma unroll
        for (int e = 0; e < 4; ++e) rli[4 * j + e] = __builtin_amdgcn_rcpf(f[e]); }
    { LAS bf16_t* stg = (LAS bf16_t*)(shm + LDS_OST) + wid * 2048;
#pragma unroll
      for (int r = 0; r < 16; ++r) { const int orow = crow(r, hi);
          stg[orow * 64 + r32] = (bf16_t)(cvtpk(o0[r] * rli[r], 0.f) & 0xffffu);
          stg[orow * 64 + 32 + r32] = (bf16_t)(cvtpk(o1[r] * rli[r], 0.f) & 0xffffu); }
      LDS_WAIT();
      bf16_t* Ow = u.O + (size_t)(u.q0 + wid * 32) * u.opitch;
#pragma unroll
      for (int i = 0; i < 4; ++i) { const int row = i * 8 + (lane >> 3), ch = lane & 7; const u32x4 v = *(const LAS u32x4*)(stg + row * 64 + ch * 8); *(u32x4*)(Ow + (size_t)row * u.opitch + ch * 8) = v; } }
    ATT_WAIT_BAR();
#undef ATT_ISSUE
}
}

#define XB_TMO      128
#define XB_XCNT(j)  (256  + 64 * (j))
#define XB_XSUB(j)  (1280 + 64 * (j))
#define XB_XGEN(j)  (2304 + 64 * (j))
#define XB_TOP      3328
#define XB_TOPGEN   3392
#define XCD_BAR_WORDS 3456
#define XB_SPIN_CAP (1u << 18)
__device__ __forceinline__ unsigned xb_ld(unsigned* p)              { return __hip_atomic_load(p, __ATOMIC_RELAXED, __HIP_MEMORY_SCOPE_AGENT); }
__device__ __forceinline__ unsigned xb_add(unsigned* p, unsigned v) { return __hip_atomic_fetch_add(p, v, __ATOMIC_RELAXED, __HIP_MEMORY_SCOPE_AGENT); }
__device__ __forceinline__ unsigned xb_xcc_id() { return (unsigned)__builtin_amdgcn_s_getreg((3 << 11) | 20) & 0xFu; }
#define XB_SPIN(cond, bar) do { unsigned _sp = 0; while (cond) { __builtin_amdgcn_s_sleep(1); \
    if ((++_sp & 255u) == 0u) { if (xb_ld(&(bar)[XB_TMO])) break; if (_sp > XB_SPIN_CAP) { atomicAdd(&(bar)[XB_TMO], 1u); break; } } } } while (0)
struct XcdBarrier { unsigned* bar; unsigned x; volatile LAS unsigned* st; };
__device__ __forceinline__ XcdBarrier xcd_barrier_post(unsigned* bar, volatile LAS unsigned* st) {
    XcdBarrier b; b.bar = bar; b.x = xb_xcc_id(); b.st = st;
    if (threadIdx.x == 0) (void)xb_add(&bar[XB_XCNT(b.x)], 1u);
    return b;
}
__device__ __forceinline__ void xcd_barrier_complete(unsigned* bar, unsigned x, unsigned& nloc, unsigned& nx) {
    const unsigned G = gridDim.x * gridDim.y * gridDim.z;
    unsigned sum, cnt, mine, sp = 0u;
    for (;;) {
        sum = 0u; cnt = 0u; mine = 0u;
#pragma unroll
        for (unsigned j = 0; j < 16; ++j) { const unsigned c = xb_ld(&bar[XB_XCNT(j)]); sum += c; cnt += (c > 0u) ? 1u : 0u; mine = (j == x) ? c : mine; }
        if (sum == G) break;
        __builtin_amdgcn_s_sleep(1);
        if ((++sp & 255u) == 0u) { if (xb_ld(&bar[XB_TMO])) break; if (sp > XB_SPIN_CAP) { atomicAdd(&bar[XB_TMO], 1u); break; } }
    }
    nloc = mine > 0u ? mine : 1u; nx = cnt > 0u ? cnt : 1u;
}
__device__ __forceinline__ void xcd_barrier(const XcdBarrier& b) {
    asm volatile("s_waitcnt vmcnt(0)" ::: "memory");
    __syncthreads();
    if (threadIdx.x == 0) {
        unsigned* bar = b.bar;
        __builtin_amdgcn_s_waitcnt(0);
        unsigned nloc = b.st[0], nx = b.st[1];
        if (nloc == 0u) { xcd_barrier_complete(bar, b.x, nloc, nx); b.st[0] = nloc; b.st[1] = nx; }
        const unsigned old = xb_add(&bar[XB_XSUB(b.x)], 1u);
        const unsigned gen = old / nloc;
        if (old + 1u == (gen + 1u) * nloc) {
            __builtin_amdgcn_fence(__ATOMIC_RELEASE, "agent");
            asm volatile("s_waitcnt vmcnt(0)" ::: "memory");
            const unsigned og = xb_add(&bar[XB_TOP], 1u);
            const unsigned tg = og / nx;
            if (og + 1u == (tg + 1u) * nx) xb_add(&bar[XB_TOPGEN], 1u);
            else XB_SPIN(xb_ld(&bar[XB_TOPGEN]) == tg, bar);
            __builtin_amdgcn_fence(__ATOMIC_ACQUIRE, "agent");
            xb_add(&bar[XB_XGEN(b.x)], 1u);
            asm volatile("s_waitcnt vmcnt(0)" ::: "memory");
        } else {
            XB_SPIN(xb_ld(&bar[XB_XGEN(b.x)]) == gen, bar);
            __builtin_amdgcn_fence(__ATOMIC_ACQUIRE, "agent");
            asm volatile("s_waitcnt vmcnt(0)" ::: "memory");
        }
    }
    __syncthreads();
}

struct Args {
    const float* x; const int* pos; const float* attn_norm; const float* w_in; const float* b_forget; const float* mla_q_norm; const float* w_q_up;
    const float* mla_kv_norm; const float* w_kv_up; const float* sinks; const float* w_out; const float* ffn_norm; const float* dense_w_gate; const float* dense_w_up;
    const float* dense_w_down; const float* router; const float* moe_w_gate; const float* moe_w_up; const float* moe_w_down; const float* final_norm;
    float* out; unsigned char* ws; int ph_lo, ph_hi;
};
struct Frame {
    LAS unsigned char* lds; int tid, lane, wave, G, c;
};

__device__ __forceinline__ int rope_perm(int j) { const int i = j & 15, t2 = j >> 4; return 8 * (i >> 2) + 4 * t2 + (i & 3); }
__device__ __forceinline__ int map_col(int kind, int n, float& sc) {
    sc = 1.0f;
    if (kind == 0) return n;
    if (kind == 1) {
        if (n < 256) { sc = C2_64; return Y_FQ + n; }
        if (n < 512) return Y_FK + (n - 256);
        if (n < 768) return Y_FV + (n - 512);
        if (n < 772) return Y_FF + (n - 768);
        if (n < 1028) { sc = C2_64; return Y_SQ + (n - 772); }
        if (n < 1156) return Y_SK + (n - 1028);
        if (n < 1284) return Y_SV + (n - 1156);
        if (n < 1540) return Y_CQ + (n - 1284);
        if (n < 1668) return Y_CKV + (n - 1540);
        if (n < 1700) return Y_KR + rope_perm(n - 1668);
        if (n < 1956) { sc = C2_64; return Y_DQ + (n - 1700); }
        if (n < 2212) return Y_DK + (n - 1956);
        if (n < 2468) return Y_DV + (n - 2212);
        return -1;
    }
    if (kind == 2) { sc = C2_96; const int h = n / 96, c = n % 96; return h * 96 + (c < 64 ? c : 64 + rope_perm(c - 64)); }
    if (kind == 3) return 256 * (n >> 7) + (n & 127);
    return 256 * (n >> 7) + 128 + (n & 127);
}
__device__ __forceinline__ void transpose_item(const float* W, int K, int N, bf16_t* WT, const float* gain, int kind, LAS float* scr, int item, int lane) {
    const int nblk = (N + 31) / 32, kb = item / nblk, nb = item % nblk, k0 = 64 * kb, n0 = 32 * nb;
    const int nn = n0 + (lane & 31);
#pragma unroll 8
    for (int i = 0; i < 32; ++i) { const int kk = 2 * i + (lane >> 5); scr[kk * 33 + (lane & 31)] = (nn < N) ? W[(size_t)(k0 + kk) * N + nn] : 0.f; }
    LDS_WAIT(); asm volatile("" ::: "memory");
    const int c = lane & 7;
    float gk[8];
#pragma unroll
    for (int e = 0; e < 8; ++e) gk[e] = gain ? gain[k0 + 8 * c + e] : 1.0f;
#pragma unroll
    for (int j = 0; j < 4; ++j) { const int n = (lane >> 3) + 8 * j; const LAS float* s = scr + (8 * c) * 33 + n;
        float sc; const int dr = (n0 + n < N) ? map_col(kind, n0 + n, sc) : -1;
        if (dr >= 0) {
            u32x4 o; o.x = cvtpk(s[0 * 33] * gk[0] * sc, s[1 * 33] * gk[1] * sc); o.y = cvtpk(s[2 * 33] * gk[2] * sc, s[3 * 33] * gk[3] * sc);
            o.z = cvtpk(s[4 * 33] * gk[4] * sc, s[5 * 33] * gk[5] * sc); o.w = cvtpk(s[6 * 33] * gk[6] * sc, s[7 * 33] * gk[7] * sc);
            *(u32x4*)(WT + (size_t)dr * K + k0 + 8 * c) = o; } }
    LDS_WAIT(); asm volatile("" ::: "memory");
}
__device__ __forceinline__ void sincos_acc(double a, float& s, float& c) {
    const double n = rint(a * 0.63661977236758134308);
    double r = fma(-n, 1.5707963267948966192, a); r = fma(-n, 6.123233995736766e-17, r);
    const int qd = (int)((long long)n & 3);
    const float x = (float)r, x2 = x * x;
    const float sp = x + x * x2 * (-1.6666667163e-1f + x2 * (8.3333337680e-3f + x2 * (-1.9841270114e-4f + x2 * 2.7557314297e-6f)));
    const float cp = 1.0f + x2 * (-0.5f + x2 * (4.1666667908e-2f + x2 * (-1.3888889225e-3f + x2 * 2.4801587642e-5f)));
    s = (qd == 0) ? sp : (qd == 1) ? cp : (qd == 2) ? -sp : -cp;
    c = (qd == 0) ? cp : (qd == 1) ? -sp : (qd == 2) ? -cp : sp;
}

constexpr int NPH = 17;
typedef __attribute__((address_space(4))) const Args* ArgsP;
__device__ __forceinline__ ArgsP get_args() { ArgsP p = (ArgsP)__builtin_amdgcn_kernarg_segment_ptr(); asm volatile("" : "+s"(p)); return p; }
#define WSP(T_, off) ((T_*)(ws + (off)))

__global__ void __launch_bounds__(NWAVES * 64, 2) mega_fwd(Args a_unused) {
    extern __shared__ __attribute__((aligned(16))) unsigned char lds_raw[];
    Frame F;
    F.lds = (LAS unsigned char*)lds_raw;
    F.tid = threadIdx.x; F.lane = F.tid & 63; F.wave = __builtin_amdgcn_readfirstlane(F.tid >> 6);
    F.G = gridDim.x; F.c = blockIdx.x;
    volatile LAS unsigned* MISC = (volatile LAS unsigned*)(F.lds + MISC_OFF);
    for (int u = F.tid; u < (LDS_BYTES - LDSCTL_OFF) / 4; u += NWAVES * 64) ((LAS unsigned*)(F.lds + LDSCTL_OFF))[u] = 0u;
    __syncthreads();
#if MK_ONE_LAUNCH
    XcdBarrier bar = xcd_barrier_post((unsigned*)(get_args()->ws + WS_CTL) + CW_BAR, MISC + 8);
#define GRID_BAR() do { bar.bar = (unsigned*)(get_args()->ws + WS_CTL) + CW_BAR; xcd_barrier(bar); } while (0)
#else
    (void)MISC;
#define GRID_BAR() do { } while (0)
#endif
    const int lo = get_args()->ph_lo, hi = get_args()->ph_hi;
#ifndef PHMASK
#define PHMASK 0x1ffff
#endif
#define IN(k) ((((PHMASK) >> (k)) & 1) && lo <= (k) && (k) < hi)
#define SEAM(k) do { if (IN(k) && IN((k) + 1)) GRID_BAR(); } while (0)
    const int gw = F.c * NWAVES + F.wave, NGW = F.G * NWAVES;

    if (IN(0)) {
        ArgsP a = get_args(); unsigned char* ws = a->ws;
        LAS float* scr = (LAS float*)(F.lds + F.wave * 16384);
        bf16_t* Win_t = WSP(bf16_t, WS_WIN); bf16_t* Wqup_t = WSP(bf16_t, WS_WQUP); bf16_t* Wkvup_t = WSP(bf16_t, WS_WKVUP); bf16_t* Wout_t = WSP(bf16_t, WS_WOUT);
        bf16_t* Wgu0_t = WSP(bf16_t, WS_WGU0); bf16_t* Wd0_t = WSP(bf16_t, WS_WD0); bf16_t* Wgu1_t = WSP(bf16_t, WS_WGU1);
        constexpr int I_IN = 16 * 78, I_QU = 4 * 12, I_KV = 2 * 16, I_WO = 16 * 32, I_GU = 16 * 112, I_DN = 56 * 32;
        constexpr int NIT = 2 * I_IN + 2 * I_QU + 2 * I_KV + 2 * I_WO + 2 * I_GU + I_DN + 16 * I_GU;
        for (int it = gw; it < NIT; it += NGW) {
            int r = it;
            if (r < 2 * I_IN) { const int l = r / I_IN; transpose_item(a->w_in + (size_t)l * D * NIN, D, NIN, Win_t + (size_t)l * NY * D, a->attn_norm + l * D, 1, scr, r % I_IN, F.lane); continue; } r -= 2 * I_IN;
            if (r < 2 * I_QU) { const int l = r / I_QU; transpose_item(a->w_q_up + (size_t)l * 256 * 384, 256, 384, Wqup_t + (size_t)l * 512 * 256, a->mla_q_norm + l * 256, 2, scr, r % I_QU, F.lane); continue; } r -= 2 * I_QU;
            if (r < 2 * I_KV) { const int l = r / I_KV; transpose_item(a->w_kv_up + (size_t)l * 128 * 512, 128, 512, Wkvup_t + (size_t)l * 512 * 128, a->mla_kv_norm + l * 128, 0, scr, r % I_KV, F.lane); continue; } r -= 2 * I_KV;
            if (r < 2 * I_WO) { const int l = r / I_WO; transpose_item(a->w_out + (size_t)l * D * D, D, D, Wout_t + (size_t)l * D * D, nullptr, 0, scr, r % I_WO, F.lane); continue; } r -= 2 * I_WO;
            if (r < I_GU) { transpose_item(a->dense_w_gate, D, FF, Wgu0_t, a->ffn_norm, 3, scr, r, F.lane); continue; } r -= I_GU;
            if (r < I_GU) { transpose_item(a->dense_w_up, D, FF, Wgu0_t, a->ffn_norm, 4, scr, r, F.lane); continue; } r -= I_GU;
            if (r < I_DN) { transpose_item(a->dense_w_down, FF, D, Wd0_t, nullptr, 0, scr, r, F.lane); continue; } r -= I_DN;
            if (r < 8 * I_GU) { const int e = r / I_GU; transpose_item(a->moe_w_gate + (size_t)e * D * FF, D, FF, Wgu1_t + (size_t)e * 2 * FF * D, a->ffn_norm + D, 3, scr, r % I_GU, F.lane); continue; } r -= 8 * I_GU;
            { const int e = r / I_GU; transpose_item(a->moe_w_up + (size_t)e * D * FF, D, FF, Wgu1_t + (size_t)e * 2 * FF * D, a->ffn_norm + D, 4, scr, r % I_GU, F.lane); }
        }
        const float* x = a->x; const int* pos = a->pos; bf16_t* XB = WSP(bf16_t, WS_XB); float* rstd0 = WSP(float, SM_RSTD0); float* rope = WSP(float, SM_ROPE);
        for (int m = gw; m < T; m += NGW) {
            const f32x4* xr = (const f32x4*)(x + (size_t)m * D) + F.lane;
            f32x4 v[4]; float s = 0.f;
#pragma unroll
            for (int j = 0; j < 4; ++j) { v[j] = xr[64 * j]; s += (v[j][0] * v[j][0] + v[j][1] * v[j][1]) + (v[j][2] * v[j][2] + v[j][3] * v[j][3]); }
            s = wave_sum(s);
            u32x2* o8 = (u32x2*)(XB + (size_t)m * D) + F.lane;
#pragma unroll
            for (int j = 0; j < 4; ++j) { u32x2 w; w.x = cvtpk(v[j][0], v[j][1]); w.y = cvtpk(v[j][2], v[j][3]); o8[64 * j] = w; }
            if (F.lane == 0) rstd0[m] = 1.0f / sqrtf(s * (1.0f / D) + EPS);
            if (F.lane < 16) {
                const float invf = powf(10000.0f, -(float)F.lane / 16.0f);
                const float ang = (float)pos[m] * invf;
                float sn, cs; sincos_acc((double)ang, sn, cs);
                *(f32x2*)(rope + (size_t)m * 32 + 2 * F.lane) = (f32x2){cs, sn};
            }
        }
    }
    SEAM(0);

    for (int l = 0; l < 2; ++l) {
        const int pb = 1 + 6 * l;
        if (IN(pb)) {
            unsigned char* ws = get_args()->ws;
            pg8::Gemm g{WSP(bf16_t, WS_XB), WSP(bf16_t, WS_WIN) + (size_t)l * NY * D, D, D, D};
            pg8::SchedStatic S; S.o.init(T, NY, F.G, F.c);
            pg8::EpiG1 E{WSP(bf16_t, WS_Y), l == 0 ? WSP(float, SM_RSTD0) : nullptr, WSP(float, SM_PART), WSP(float, SM_PARTQ), WSP(float, SM_PARTKV), WSP(float, SM_FF), WSP(bf16_t, WS_KM), WSP(float, SM_ROPE)};
            pg8::gemm_phase<pg8::EpiG1, pg8::SchedStatic, true>(F.lds, g, S, E);
        }
        SEAM(pb);
        if (IN(pb + 1)) {
#ifndef P2MASK
#define P2MASK 15
#endif
            if ((P2MASK & 1) && F.c < 128) {
                unsigned char* ws = get_args()->ws;
                pg8::Gemm g{WSP(bf16_t, WS_Y) + Y_CQ, WSP(bf16_t, WS_WQUP) + (size_t)l * 512 * 256, NY, 256, 256};
                pg8::SchedOne S; S.has = true; S.un.pm = F.c >> 1; S.un.pn = F.c & 1; S.un.e = 0;
                pg8::EpiQup E{WSP(bf16_t, WS_QM), WSP(float, SM_PARTQ), WSP(float, SM_ROPE)};
                pg8::gemm_phase<pg8::EpiQup, pg8::SchedOne, false>(F.lds, g, S, E);
            } else if (P2MASK & 2) {
                unsigned char* ws = get_args()->ws;
                pg8::Gemm g{WSP(bf16_t, WS_Y) + Y_CKV, WSP(bf16_t, WS_WKVUP) + (size_t)l * 512 * 128, NY, 128, 128};
                pg8::SchedOne S; S.has = F.c < 256; S.un.pm = (F.c - 128) >> 1; S.un.pn = F.c & 1; S.un.e = 0;
                pg8::EpiKVup E{WSP(bf16_t, WS_KM), WSP(bf16_t, WS_VM), WSP(float, SM_PARTKV)};
                pg8::gemm_phase<pg8::EpiKVup, pg8::SchedOne, false>(F.lds, g, S, E);
            }
            __syncthreads();
            if (P2MASK & 4) for (int sq = F.c; sq < 8; sq += F.G) {
                ArgsP a = get_args(); unsigned char* ws = a->ws; const float* ffb = WSP(float, SM_FF); float* csl = WSP(float, SM_CSL);
                const int b = sq >> 2, h = sq & 3; const float bfv = a->b_forget[l * 4 + h];
                LAS double* sd = (LAS double*)F.lds;
                double loc[16]; double run = 0.0;
#pragma unroll
                for (int i = 0; i < 16; ++i) { const float z = ffb[(size_t)(b * SEQ + F.tid * 16 + i) * 4 + h] + bfv;
                    const float ls = fminf(z, 0.f) - log1pf(expf(-fabsf(z))); run += (double)ls; loc[i] = run; }
                double incl = run;
#pragma unroll
                for (int o = 1; o < 64; o <<= 1) { const double t = __shfl_up(incl, o); if (F.lane >= o) incl += t; }
                if (F.lane == 63) sd[F.wave] = incl;
                __syncthreads();
                double base = 0.0;
                for (int w = 0; w < F.wave; ++w) base += sd[w];
                const double excl = base + incl - run;
#pragma unroll
                for (int i = 0; i < 16; ++i) csl[(size_t)sq * SEQ + F.tid * 16 + i] = (float)((excl + loc[i]) * (double)LOG2E);
                __syncthreads();
            }
            if (P2MASK & 8) for (int idx = F.c; idx < 1024; idx += F.G) {
                ArgsP a = get_args(); unsigned char* ws = a->ws; const bf16_t* Y = WSP(bf16_t, WS_Y);
                att::AU u;
                if (idx < 256) {
                    const int b = idx >> 7, hq = (idx >> 5) & 3, qb = idx & 31;
                    const bf16_t* yb = Y + (size_t)b * SEQ * NY;
                    u.Q = yb + Y_SQ + hq * 64; u.K = yb + Y_SK + (hq >> 1) * 64; u.V = yb + Y_SV + (hq >> 1) * 64; u.qpitch = u.kpitch = u.vpitch = NY;
                    u.O = WSP(bf16_t, WS_MIX) + (size_t)b * SEQ * D + 256 + hq * 64; u.opitch = D; u.lse = nullptr; u.lpitch = 0; u.colb = nullptr;
                    u.q0 = qb * 256; u.span = 127; u.alibi = exp2f(-(float)(hq + 1)) * LOG2E; u.sink2 = a->sinks[l * 4 + hq] * LOG2E;
                } else {
                    const int p = (idx - 256) >> 8, rem = (idx - 256) & 255, b = rem >> 7, h = (rem >> 5) & 3, j = rem & 31;
                    const int dil = (p == 0) ? 1 : (p == 1) ? 4 : 16, nqb = (SEQ / dil) / 256, r = j / nqb, qb = j % nqb;
                    const bf16_t* yb = Y + (size_t)(b * SEQ + r) * NY;
                    u.Q = yb + Y_DQ + h * 64; u.K = yb + Y_DK + h * 64; u.V = yb + Y_DV + h * 64; u.qpitch = u.kpitch = u.vpitch = dil * NY;
                    u.O = WSP(bf16_t, WS_DP) + (size_t)p * T * 256 + (size_t)(b * SEQ + r) * 256 + h * 64; u.opitch = dil * 256;
                    u.lse = WSP(float, WS_DL) + (size_t)p * T * 4 + (size_t)(b * SEQ + r) * 4 + h; u.lpitch = dil * 4; u.colb = nullptr;
                    u.q0 = qb * 256; u.span = 128; u.alibi = exp2f(-(float)(h + 5)) * (float)dil * LOG2E; u.sink2 = -INFINITY;
                }
                u.kt0 = u.q0 / 64 - 2; if (u.kt0 < 0) u.kt0 = 0; u.kt1 = u.q0 / 64 + 4;
                att::attn_unit<4, 2>(u, F.lds);
            }
        }
        SEAM(pb + 1);
        if (IN(pb + 2)) {
            LAS unsigned* qslot = (LAS unsigned*)(F.lds + LDSCTL_OFF + 64);
            for (;;) {
                unsigned char* ws = get_args()->ws;
                if (F.tid == 0) *qslot = __hip_atomic_fetch_add((gu32*)(ws + WS_CTL) + CW_QUEUE + 64 * l, 1u, RLX_AGENT);
                __syncthreads();
                const int idx = (int)*qslot;
                __syncthreads();
                if (idx >= 768) break;
                if (idx < 512) {
                    const int qb = 31 - (idx >> 4), sub = idx & 15, bh = sub & 7, b = bh >> 2, h = bh & 3;
                    att::AU u; u.lse = nullptr; u.lpitch = 0; u.q0 = qb * 256; u.kt0 = 0; u.kt1 = 4 * qb + 4; u.span = 1 << 30; u.alibi = 0.f; u.sink2 = -INFINITY; u.opitch = D;
                    if (sub < 8) {
                        u.Q = WSP(bf16_t, WS_QM) + (size_t)b * SEQ * 384 + h * 96; u.K = WSP(bf16_t, WS_KM) + (size_t)b * SEQ * 384 + h * 96; u.V = WSP(bf16_t, WS_VM) + (size_t)b * SEQ * 256 + h * 64;
                        u.qpitch = 384; u.kpitch = 384; u.vpitch = 256; u.O = WSP(bf16_t, WS_MIX) + (size_t)b * SEQ * D + 512 + h * 64; u.colb = nullptr;
                        att::attn_unit<6, 0>(u, F.lds);
                    } else {
                        const bf16_t* yb = WSP(bf16_t, WS_Y) + (size_t)b * SEQ * NY;
                        u.Q = yb + Y_FQ + h * 64; u.K = yb + Y_FK + h * 64; u.V = yb + Y_FV + h * 64; u.qpitch = u.kpitch = u.vpitch = NY;
                        u.O = WSP(bf16_t, WS_MIX) + (size_t)b * SEQ * D + h * 64; u.colb = WSP(float, SM_CSL) + (size_t)bh * SEQ;
                        att::attn_unit<4, 1>(u, F.lds);
                    }
                } else {
                    const bf16_t* Dp = WSP(bf16_t, WS_DP); const float* Dl = WSP(float, WS_DL); bf16_t* MIX = WSP(bf16_t, WS_MIX);
                    const int t = (idx - 512) * 64 + (F.tid >> 3), dc = F.tid & 7;
#pragma unroll
                    for (int h = 0; h < 4; ++h) {
                        const float l0 = Dl[(size_t)t * 4 + h], l1 = Dl[(size_t)(T + t) * 4 + h], l2 = Dl[(size_t)(2 * T + t) * 4 + h];
                        const float mx = fmaxf(l0, fmaxf(l1, l2));
                        float w0 = __builtin_amdgcn_exp2f(l0 - mx), w1 = __builtin_amdgcn_exp2f(l1 - mx), w2 = __builtin_amdgcn_exp2f(l2 - mx);
                        const float inv = 1.0f / (w0 + w1 + w2); w0 *= inv; w1 *= inv; w2 *= inv;
                        const u32x4 a0 = *(const u32x4*)(Dp + (size_t)t * 256 + h * 64 + dc * 8), a1 = *(const u32x4*)(Dp + (size_t)(T + t) * 256 + h * 64 + dc * 8),
                                    a2 = *(const u32x4*)(Dp + (size_t)(2 * T + t) * 256 + h * 64 + dc * 8);
                        u32x4 o;
#pragma unroll
                        for (int e = 0; e < 4; ++e) {
                            const float lo_ = w0 * __uint_as_float(a0[e] << 16) + w1 * __uint_as_float(a1[e] << 16) + w2 * __uint_as_float(a2[e] << 16);
                            const float hi_ = w0 * __uint_as_float(a0[e] & 0xffff0000u) + w1 * __uint_as_float(a1[e] & 0xffff0000u) + w2 * __uint_as_float(a2[e] & 0xffff0000u);
                            o[e] = cvtpk(lo_, hi_);
                        }
                        *(u32x4*)(MIX + (size_t)t * D + 768 + h * 64 + dc * 8) = o;
                    }
                }
            }
        }
        SEAM(pb + 2);
        if (IN(pb + 3)) {
            ArgsP a = get_args(); unsigned char* ws = a->ws;
            pg8::Gemm g{WSP(bf16_t, WS_MIX), WSP(bf16_t, WS_WOUT) + (size_t)l * D * D, D, D, D};
            pg8::SchedStatic S; S.o.init(T, D, F.G, F.c);
            pg8::EpiRes E{l == 0 ? a->x : a->out, a->out, l == 0 ? WSP(bf16_t, WS_XB) : nullptr, WSP(float, SM_PART)};
            pg8::gemm_phase<pg8::EpiRes, pg8::SchedStatic, true>(F.lds, g, S, E);
        }
        SEAM(pb + 3);
        if (l == 0) {
            if (IN(5)) {
                unsigned char* ws = get_args()->ws;
                pg8::Gemm g{WSP(bf16_t, WS_XB), WSP(bf16_t, WS_WGU0), D, D, D};
                pg8::SchedStatic S; S.o.init(T, 2 * FF, F.G, F.c);
                pg8::EpiSwiglu E{WSP(bf16_t, WS_HID), nullptr, WSP(float, SM_PART)};
                pg8::gemm_phase<pg8::EpiSwiglu, pg8::SchedStatic, true>(F.lds, g, S, E);
            }
            SEAM(5);
            if (IN(6)) {
                ArgsP a = get_args(); unsigned char* ws = a->ws;
                pg8::Gemm g{WSP(bf16_t, WS_HID), WSP(bf16_t, WS_WD0), FF, FF, FF};
                pg8::SchedStatic S; S.o.init(T, D, F.G, F.c);
                pg8::EpiRes E{a->out, a->out, WSP(bf16_t, WS_XB), WSP(float, SM_PART)};
                pg8::gemm_phase<pg8::EpiRes, pg8::SchedStatic, true>(F.lds, g, S, E);
            }
            SEAM(6);
        }
    }
    if (IN(11)) {
        ArgsP a = get_args(); unsigned char* ws = a->ws; const float* xres = a->out;
        int* tok_e = WSP(int, SM_TOKE); float* tok_g = WSP(float, SM_TOKG); float* rstd_tok = WSP(float, SM_RSTDT); int* histg = WSP(int, SM_HIST);
        LAS float* Rg = (LAS float*)F.lds;
        LAS int* hist = (LAS int*)(F.lds + 32768);
        for (int i = F.tid; i < D * 8; i += 512) Rg[i] = a->router[i] * a->ffn_norm[D + (i >> 3)];
        for (int ch = F.c; ch < 256; ch += F.G) {
            if (F.tid < 8) hist[F.tid] = 0;
            __syncthreads();
            for (int j = 0; j < 8; ++j) {
                const int t = ch * 64 + F.wave * 8 + j;
                const f32x4* xr = (const f32x4*)(xres + (size_t)t * D) + F.lane;
                float acc[8] = {0.f, 0.f, 0.f, 0.f, 0.f, 0.f, 0.f, 0.f}; float ss = 0.f;
#pragma unroll
                for (int jj = 0; jj < 4; ++jj) { const f32x4 v = xr[64 * jj];
#pragma unroll
                    for (int e4 = 0; e4 < 4; ++e4) { const int k = 4 * F.lane + 256 * jj + e4; const float xv = v[e4]; ss += xv * xv;
                        const f32x4 r0 = *(const LAS f32x4*)(Rg + k * 8), r1 = *(const LAS f32x4*)(Rg + k * 8 + 4);
#pragma unroll
                        for (int e = 0; e < 4; ++e) { acc[e] += xv * r0[e]; acc[4 + e] += xv * r1[e]; } } }
                ss = wave_sum(ss);
#pragma unroll
                for (int e = 0; e < 8; ++e) acc[e] = wave_sum(acc[e]);
                const float rs = 1.0f / sqrtf(ss * (1.0f / D) + EPS);
                float v1 = -INFINITY; int e1 = 0;
#pragma unroll
                for (int e = 0; e < 8; ++e) { const float lg = acc[e] * rs; if (lg > v1) { v1 = lg; e1 = e; } }
                float v2 = -INFINITY; int e2 = 0;
#pragma unroll
                for (int e = 0; e < 8; ++e) { const float lg = acc[e] * rs; if (e != e1 && lg > v2) { v2 = lg; e2 = e; } }
                const float g1 = 1.0f / (1.0f + expf(v2 - v1));
                if (F.lane == 0) { tok_e[2 * t] = e1; tok_e[2 * t + 1] = e2; tok_g[2 * t] = g1; tok_g[2 * t + 1] = 1.0f - g1; rstd_tok[t] = rs;
                    atomicAdd((int*)&hist[e1], 1); atomicAdd((int*)&hist[e2], 1); }
            }
            __syncthreads();
            if (F.tid < 8) histg[ch * 8 + F.tid] = hist[F.tid];
            __syncthreads();
        }
    }
    SEAM(11);
    if (IN(12)) {
        ArgsP a = get_args(); unsigned char* ws = a->ws; const float* xres = a->out;
        const int* tok_e = WSP(int, SM_TOKE); const float* rstd_tok = WSP(float, SM_RSTDT); const int* histg = WSP(int, SM_HIST);
        int* slot = WSP(int, SM_SLOT); float* rstdg = WSP(float, SM_RSTDG); int* moetab = WSP(int, SM_MOETAB); bf16_t* XG = WSP(bf16_t, WS_XG);
        LAS int* tot = (LAS int*)F.lds; LAS int* pre = tot + 8; LAS int* rows = tot + 16;
        for (int ch = F.c; ch < 256; ch += F.G) {
            if (F.tid < 16) tot[F.tid] = 0;
            __syncthreads();
            { const int cch = F.tid >> 1, e0 = (F.tid & 1) * 4;
#pragma unroll
              for (int e = 0; e < 4; ++e) { const int v = histg[cch * 8 + e0 + e]; atomicAdd((int*)&tot[e0 + e], v); if (cch < ch) atomicAdd((int*)&pre[e0 + e], v); } }
            __syncthreads();
            int tbase[9]; tbase[0] = 0;
#pragma unroll
            for (int e = 0; e < 8; ++e) tbase[e + 1] = tbase[e] + (tot[e] + 255) / 256;
            if (ch == 0 && F.tid == 0) {
#pragma unroll
                for (int e = 0; e < 9; ++e) moetab[e] = tbase[e];
            }
            if (F.wave == 0) {
                const int t = ch * 64 + F.lane; const int e1 = tok_e[2 * t], e2 = tok_e[2 * t + 1];
                int r1 = 0, r2 = 0;
#pragma unroll
                for (int e = 0; e < 8; ++e) {
                    const unsigned long long mk = __ballot(e1 == e || e2 == e);
                    const int rank = __popcll(mk & ((1ull << F.lane) - 1ull));
                    const int row = tbase[e] * 256 + pre[e] + rank;
                    if (e1 == e) r1 = row; if (e2 == e) r2 = row;
                }
                slot[2 * t] = r1; slot[2 * t + 1] = r2; rows[2 * F.lane] = r1; rows[2 * F.lane + 1] = r2;
                const float rs = rstd_tok[t]; rstdg[r1] = rs; rstdg[r2] = rs;
            }
            __syncthreads();
            for (int j = 0; j < 8; ++j) {
                const int tl = F.wave * 8 + j, t = ch * 64 + tl; const int r1 = rows[2 * tl], r2 = rows[2 * tl + 1];
                const f32x4* xr = (const f32x4*)(xres + (size_t)t * D) + F.lane;
                u32x2* o1 = (u32x2*)(XG + (size_t)r1 * D) + F.lane; u32x2* o2 = (u32x2*)(XG + (size_t)r2 * D) + F.lane;
#pragma unroll
                for (int jj = 0; jj < 4; ++jj) { const f32x4 v = xr[64 * jj]; u32x2 w; w.x = cvtpk(v[0], v[1]); w.y = cvtpk(v[2], v[3]); o1[64 * jj] = w; o2[64 * jj] = w; }
            }
            __syncthreads();
        }
    }
    SEAM(12);
    if (IN(13)) {
        unsigned char* ws = get_args()->ws; const int* moetab = WSP(int, SM_MOETAB);
        pg8::Gemm g{WSP(bf16_t, WS_XG), WSP(bf16_t, WS_WGU1), D, D, D};
        pg8::SchedMoe S;
#pragma unroll
        for (int e = 0; e < 9; ++e) S.tb[e] = __builtin_amdgcn_readfirstlane(moetab[e]);
        S.o.init(S.tb[8] * 256, 2 * FF, F.G, F.c); S.estride = (size_t)2 * FF * D * 2;
        pg8::EpiSwiglu E{WSP(bf16_t, WS_HG), WSP(float, SM_RSTDG), nullptr};
        pg8::gemm_phase<pg8::EpiSwiglu, pg8::SchedMoe, true>(F.lds, g, S, E);
    }
    SEAM(13);
    if (IN(14)) {
        ArgsP a = get_args(); unsigned char* ws = a->ws;
        LAS float* scr = (LAS float*)(F.lds + F.wave * 16384);
        constexpr int I_DN = 56 * 32;
        for (int it = gw; it < 8 * I_DN; it += NGW) { const int e = it / I_DN; transpose_item(a->moe_w_down + (size_t)e * FF * D, FF, D, WSP(bf16_t, WS_WD1) + (size_t)e * D * FF, nullptr, 0, scr, it % I_DN, F.lane); }
    }
    SEAM(14);
    if (IN(15)) {
        unsigned char* ws = get_args()->ws; const int* moetab = WSP(int, SM_MOETAB);
        pg8::Gemm g{WSP(bf16_t, WS_HG), WSP(bf16_t, WS_WD1), FF, FF, FF};
        pg8::SchedMoe S;
#pragma unroll
        for (int e = 0; e < 9; ++e) S.tb[e] = __builtin_amdgcn_readfirstlane(moetab[e]);
        S.o.init(S.tb[8] * 256, D, F.G, F.c); S.estride = (size_t)D * FF * 2;
        pg8::EpiY E{WSP(bf16_t, WS_XG)};
        pg8::gemm_phase<pg8::EpiY, pg8::SchedMoe, true>(F.lds, g, S, E);
    }
    SEAM(15);
    if (IN(16)) {
        ArgsP a = get_args(); unsigned char* ws = a->ws; float* out = a->out; const float* fn = a->final_norm;
        const int* slot = WSP(int, SM_SLOT); const float* tok_g = WSP(float, SM_TOKG); const bf16_t* YG = WSP(bf16_t, WS_XG);
        for (int t = gw; t < T; t += NGW) {
            const f32x4* xr = (const f32x4*)(out + (size_t)t * D) + F.lane;
            const int r1 = slot[2 * t], r2 = slot[2 * t + 1]; const float g1 = tok_g[2 * t], g2 = tok_g[2 * t + 1];
            const u32x2* y1 = (const u32x2*)(YG + (size_t)r1 * D) + F.lane; const u32x2* y2 = (const u32x2*)(YG + (size_t)r2 * D) + F.lane;
            f32x4 v[4]; float s = 0.f;
#pragma unroll
            for (int j = 0; j < 4; ++j) { v[j] = xr[64 * j]; const u32x2 p = y1[64 * j], q = y2[64 * j];
                v[j][0] += g1 * __uint_as_float(p.x << 16) + g2 * __uint_as_float(q.x << 16);
                v[j][1] += g1 * __uint_as_float(p.x & 0xffff0000u) + g2 * __uint_as_float(q.x & 0xffff0000u);
                v[j][2] += g1 * __uint_as_float(p.y << 16) + g2 * __uint_as_float(q.y << 16);
                v[j][3] += g1 * __uint_as_float(p.y & 0xffff0000u) + g2 * __uint_as_float(q.y & 0xffff0000u);
                s += (v[j][0] * v[j][0] + v[j][1] * v[j][1]) + (v[j][2] * v[j][2] + v[j][3] * v[j][3]); }
            s = wave_sum(s);
            const float rs = 1.0f / sqrtf(s * (1.0f / D) + EPS);
            f32x4* o = (f32x4*)(out + (size_t)t * D) + F.lane; const f32x4* gn = (const f32x4*)fn + F.lane;
#pragma unroll
            for (int j = 0; j < 4; ++j) o[64 * j] = v[j] * rs * gn[64 * j];
        }
    }
#undef IN
#undef SEAM
}

extern "C" void kernel_launch(void* const* d_in, const int* in_sizes, int n_in, void* d_out, int out_size, void* d_ws, size_t ws_size, hipStream_t stream) {
    static int grid = 0;
    if (grid == 0) {
        int dev = 0, cus = 0;
        if (n_in != 20 || ws_size < WS_END) { fprintf(stderr, "kernel_launch: unexpected inputs (n_in %d, ws %zu)\n", n_in, ws_size); grid = -1; return; }
        if (hipGetDevice(&dev) != hipSuccess || hipDeviceGetAttribute(&cus, hipDeviceAttributeMultiprocessorCount, dev) != hipSuccess) { grid = -1; return; }
        if (hipFuncSetAttribute((const void*)mega_fwd, hipFuncAttributeMaxDynamicSharedMemorySize, LDS_BYTES) != hipSuccess) { grid = -1; return; }
        int per_cu = 0;
        (void)hipOccupancyMaxActiveBlocksPerMultiprocessor(&per_cu, (const void*)mega_fwd, NWAVES * 64, LDS_BYTES);
        (void)hipGetLastError();
        grid = cus;
    }
    if (grid < 0) return;
    (void)hipMemsetAsync((char*)d_ws + WS_CTL, 0, CTL_ZERO_BYTES, stream);
    Args a{};
    a.x = (const float*)d_in[0]; a.pos = (const int*)d_in[1]; a.attn_norm = (const float*)d_in[2]; a.w_in = (const float*)d_in[3]; a.b_forget = (const float*)d_in[4];
    a.mla_q_norm = (const float*)d_in[5]; a.w_q_up = (const float*)d_in[6]; a.mla_kv_norm = (const float*)d_in[7]; a.w_kv_up = (const float*)d_in[8]; a.sinks = (const float*)d_in[9];
    a.w_out = (const float*)d_in[10]; a.ffn_norm = (const float*)d_in[11]; a.dense_w_gate = (const float*)d_in[12]; a.dense_w_up = (const float*)d_in[13]; a.dense_w_down = (const float*)d_in[14];
    a.router = (const float*)d_in[15]; a.moe_w_gate = (const float*)d_in[16]; a.moe_w_up = (const float*)d_in[17]; a.moe_w_down = (const float*)d_in[18]; a.final_norm = (const float*)d_in[19];
    a.out = (float*)d_out; a.ws = (unsigned char*)d_ws;
#if MK_ONE_LAUNCH
    a.ph_lo = 0; a.ph_hi = NPH;
    hipLaunchKernelGGL(mega_fwd, dim3(grid), dim3(NWAVES * 64), LDS_BYTES, stream, a);
#else
    for (int p = 0; p < NPH; ++p) { a.ph_lo = p; a.ph_hi = p + 1; hipLaunchKernelGGL(mega_fwd, dim3(grid), dim3(NWAVES * 64), LDS_BYTES, stream, a); }
#endif
}
```

```cpp
#include <hip/hip_runtime.h>
#include <cstdio>
#include <cstdint>

#ifndef PROBE_REP
#define PROBE_REP -1
#endif
#ifndef MK_ONE_LAUNCH
#define MK_ONE_LAUNCH 1
#endif

#define GAS __attribute__((address_space(1)))
#define LAS __attribute__((address_space(3)))
typedef unsigned short bf16_t;
typedef short bf16x8 __attribute__((ext_vector_type(8)));
typedef short s16x4 __attribute__((ext_vector_type(4)));
typedef float f32x2 __attribute__((ext_vector_type(2)));
typedef float f32x4 __attribute__((ext_vector_type(4)));
typedef float f32x16 __attribute__((ext_vector_type(16)));
typedef unsigned u32x2 __attribute__((ext_vector_type(2)));
typedef unsigned u32x4 __attribute__((ext_vector_type(4)));
typedef __bf16 bf16x2_t __attribute__((ext_vector_type(2)));
typedef GAS unsigned gu32;

constexpr int NB = 2, SEQ = 8192, T = NB * SEQ, D = 1024, NY = 2560, FF = 3584, NEXP = 8;
constexpr int NIN = 2468;
constexpr float EPS = 1e-6f;
constexpr float LOG2E = 1.4426950408889634f;
constexpr float C2_64 = 0.125f * LOG2E;
constexpr float C2_96 = 0.10206207261596575f * LOG2E;
constexpr int Y_FQ = 0, Y_FK = 256, Y_FV = 512, Y_SQ = 768, Y_SK = 1024, Y_SV = 1152, Y_CQ = 1280, Y_DQ = 1536, Y_DK = 1792, Y_DV = 2048,
              Y_CKV = 2304, Y_KR = 2432, Y_FF = 2464;
constexpr int MOE_MAX_TILES = 136, MOE_MAX_ROWS = MOE_MAX_TILES * 256;

constexpr size_t MiB = 1u << 20, KiB = 1u << 10;
constexpr size_t WS_CTL = 0, CTL_ZERO_BYTES = 1 * MiB;
constexpr size_t WS_SM = 1 * MiB;
constexpr size_t SM_RSTD0 = WS_SM, SM_PARTQ = WS_SM + 64 * KiB, SM_PARTKV = WS_SM + 320 * KiB, SM_FF = WS_SM + 576 * KiB, SM_CSL = WS_SM + 832 * KiB,
                 SM_PART = WS_SM + 1088 * KiB, SM_ROPE = WS_SM + 2112 * KiB, SM_TOKE = WS_SM + 4160 * KiB, SM_TOKG = WS_SM + 4288 * KiB,
                 SM_RSTDT = WS_SM + 4416 * KiB, SM_SLOT = WS_SM + 4480 * KiB, SM_RSTDG = WS_SM + 4608 * KiB, SM_HIST = WS_SM + 4800 * KiB, SM_MOETAB = WS_SM + 4808 * KiB;
constexpr size_t WS_WIN = 9 * MiB;
constexpr size_t WS_WQUP = 19 * MiB;
constexpr size_t WS_WKVUP = 19 * MiB + 512 * KiB;
constexpr size_t WS_WOUT = 20 * MiB;
constexpr size_t WS_WGU0 = 24 * MiB;
constexpr size_t WS_WD0 = 38 * MiB;
constexpr size_t WS_WGU1 = 45 * MiB;
constexpr size_t WS_WD1 = 45 * MiB;
constexpr size_t WS_XB = 157 * MiB;
constexpr size_t WS_Y = 189 * MiB;
constexpr size_t WS_QM = 269 * MiB, WS_KM = 281 * MiB, WS_VM = 293 * MiB;
constexpr size_t WS_MIX = 301 * MiB;
constexpr size_t WS_DP = 333 * MiB;
constexpr size_t WS_DL = 357 * MiB;
constexpr size_t WS_MP = 360 * MiB;
constexpr size_t WS_ML = 392 * MiB;
constexpr size_t WS_HID = 189 * MiB;
constexpr size_t WS_XG = 157 * MiB;
constexpr size_t WS_HG = 225 * MiB;
constexpr size_t WS_END = 463 * MiB;
constexpr int CW_BAR = 4096;
constexpr int CW_QUEUE = 16384;
constexpr int CW_FMAX = 20480;
constexpr float FOX_THRESH = 100.0f;

constexpr int RING_BYTES = 131072;
constexpr int LDSCTL_OFF = RING_BYTES, MISC_OFF = LDSCTL_OFF + 320;
constexpr int LDS_BYTES = 147456;
constexpr int NWAVES = 8;

#define LDS_WAIT() asm volatile("s_waitcnt lgkmcnt(0)" ::: "memory")
#define VM_WAIT() asm volatile("s_waitcnt vmcnt(0)" ::: "memory")
#define RLX_AGENT __ATOMIC_RELAXED, __HIP_MEMORY_SCOPE_AGENT

__device__ __forceinline__ unsigned cvtpk(float lo, float hi) { f32x2 v = {lo, hi}; bf16x2_t b = __builtin_convertvector(v, bf16x2_t); return __builtin_bit_cast(unsigned, b); }
__device__ __forceinline__ float bf2f(unsigned short h) { return __uint_as_float((unsigned)h << 16); }
__device__ __forceinline__ float wave_sum(float v) {
#pragma unroll
    for (int o = 1; o < 64; o <<= 1) v += __shfl_xor(v, o);
    return v;
}

namespace pg8 {
constexpr int BM = 256, BK = 64, HALF = 128, HTB = HALF * BK * 2, STAGE_BYTES = 8 * HTB, NXCD = 8, WGM = 8;
__host__ __device__ __forceinline__ int lds_byte(int r, int c) { const int st = (r >> 4) * 2 + (c >> 5), rr = r & 15, cc = c & 31, ob = rr * 64 + cc * 2; return st * 1024 + (ob ^ (((ob >> 9) & 1) << 5)); }
__host__ __device__ __forceinline__ void stage_rc(int b, int& R, int& C) { const int st = b / 1024, sb = b % 1024, swz = sb ^ (((sb >> 9) & 1) << 5); R = (st >> 1) * 16 + swz / 64; C = (st & 1) * 32 + (swz % 64) / 2; }
__host__ __device__ __forceinline__ int perm32(int rho) { const int n = rho >> 4, i = rho & 15; return 8 * (i >> 2) + 4 * n + (i & 3); }

struct Unit { int pm, pn, e; };
struct Gemm { const bf16_t* A; const bf16_t* Bt; int lda, ldb, K; };

struct StaticOrder {
    int nM, nN, nwg, G, c;
    __device__ void init(int M, int N, int G_, int c_) { nM = M / BM; nN = N / BM; nwg = nM * nN; G = G_; c = c_; }
    __device__ bool next(int i, Unit& u) const {
        const long L = (long)i * G + c; if (L >= nwg) return false;
        int wgid = (int)L; { const int q = nwg / NXCD, r = nwg % NXCD, xcd = wgid % NXCD, off = wgid / NXCD; wgid = (xcd < r ? xcd * (q + 1) : r * (q + 1) + (xcd - r) * q) + off; }
        const int nig = WGM * nN, gid = wgid / nig, fm = gid * WGM, gsz = (nM - fm) < WGM ? (nM - fm) : WGM;
        u.pm = fm + ((wgid % nig) % gsz); u.pn = (wgid % nig) / gsz; u.e = 0; return true;
    }
};
struct SchedStatic {
    StaticOrder o;
    __device__ __forceinline__ bool next(int i, Unit& u) const { return o.next(i, u); }
    __device__ __forceinline__ const char* abase(const Gemm& g, const Unit& u) const { return (const char*)g.A + (size_t)u.pm * BM * g.lda * 2; }
    __device__ __forceinline__ const char* bbase(const Gemm& g, const Unit& u) const { return (const char*)g.Bt + (size_t)u.pn * BM * g.ldb * 2; }
};
struct SchedMoe {
    StaticOrder o; int tb[9]; size_t estride;
    __device__ __forceinline__ bool next(int i, Unit& u) const {
        if (!o.next(i, u)) return false; int e = 0;
#pragma unroll
        for (int j = 1; j < 8; ++j) e += (u.pm >= tb[j]) ? 1 : 0;
        u.e = e; return true;
    }
    __device__ __forceinline__ const char* abase(const Gemm& g, const Unit& u) const { return (const char*)g.A + (size_t)u.pm * BM * g.lda * 2; }
    __device__ __forceinline__ const char* bbase(const Gemm& g, const Unit& u) const { return (const char*)g.Bt + (size_t)u.e * estride + (size_t)u.pn * BM * g.ldb * 2; }
};
struct SchedOne {
    bool has; Unit un;
    __device__ __forceinline__ bool next(int i, Unit& u) const { if (i > 0 || !has) return false; u = un; return true; }
    __device__ __forceinline__ const char* abase(const Gemm& g, const Unit& u) const { return (const char*)g.A + (size_t)u.pm * BM * g.lda * 2; }
    __device__ __forceinline__ const char* bbase(const Gemm& g, const Unit& u) const { return (const char*)g.Bt + (size_t)u.pn * BM * g.ldb * 2; }
};

template <class Epi, class Sched, bool ALIGN_EPI>
__device__ __forceinline__ void gemm_phase(LAS unsigned char* lds, const Gemm g_in, const Sched& S, const Epi& E) {
    Gemm g = g_in; asm volatile("" : "+s"(g.A), "+s"(g.Bt), "+s"(g.K));
    int tid_l = threadIdx.x; asm volatile("" : "+v"(tid_l));
    const int tid = tid_l, wid = __builtin_amdgcn_readfirstlane(tid >> 6), lane = tid & 63, wr = wid >> 2, wc = wid & 3, fr = lane & 15, fq = lane >> 4;
    const int K = g.K, nt = K / BK;
    unsigned voffA[2], voffB[2];
#pragma unroll
    for (int i = 0; i < 2; ++i) { int R, C; stage_rc(tid * 16 + i * 8192, R, C); const int Rb = Epi::PERM ? ((R & ~31) + perm32(R & 31)) : R;
        voffA[i] = (unsigned)(R * g.lda + C) * 2u; voffB[i] = (unsigned)(Rb * g.ldb + C) * 2u; }
    const size_t kstep = (size_t)(BK * 2);
    const size_t hstepA = (size_t)HALF * g.lda * 2, hstepB = (size_t)HALF * g.ldb * 2;
    const unsigned ldsw = (unsigned)wid * 1024u;
    const int aoff = lds_byte(wr * 64 + fr, fq * 8), boff = lds_byte(wc * 32 + fr, fq * 8);
#define PG8_SA(b, h) (((b) * 2 + (h)) * HTB)
#define PG8_SB(b, h) ((4 + (b) * 2 + (h)) * HTB)
#define PG8_STAGE(bufoff, gbase, voff) do { _Pragma("unroll") for (int _i = 0; _i < 2; ++_i) \
        __builtin_amdgcn_global_load_lds((const unsigned*)((const char*)(gbase) + (voff)[_i]), (LAS unsigned*)(lds + (bufoff) + ldsw + _i * 8192), 16, 0, 0); } while (0)
#define PG8_LDA(dst, b, h) do { _Pragma("unroll") for (int m = 0; m < 4; ++m) _Pragma("unroll") for (int k = 0; k < 2; ++k) dst[m][k] = *(const LAS bf16x8*)(lds + PG8_SA(b, h) + aoff + m * 2048 + k * 1024); } while (0)
#define PG8_LDB(dst, b, h) do { _Pragma("unroll") for (int n = 0; n < 2; ++n) _Pragma("unroll") for (int k = 0; k < 2; ++k) dst[n][k] = *(const LAS bf16x8*)(lds + PG8_SB(b, h) + boff + n * 2048 + k * 1024); } while (0)
#define PG8_MMA(ai, bj, At, Bt) do { __builtin_amdgcn_s_setprio(1); _Pragma("unroll") for (int m = 0; m < 4; ++m) _Pragma("unroll") for (int n = 0; n < 2; ++n) _Pragma("unroll") for (int k = 0; k < 2; ++k) \
        acc[ai][bj][m][n] = __builtin_amdgcn_mfma_f32_16x16x32_bf16(Bt[n][k], At[m][k], acc[ai][bj][m][n], 0, 0, 0); __builtin_amdgcn_s_setprio(0); } while (0)
#define PG8_WAIT_V(n) asm volatile("s_waitcnt vmcnt(" #n ")" ::: "memory")
#define PG8_WAIT_L(n) asm volatile("s_waitcnt lgkmcnt(" #n ")" ::: "memory")
#define PG8_BAR __builtin_amdgcn_s_barrier()
#define PG8_SCHED __builtin_amdgcn_sched_barrier(0)
    Unit cur, nxt; int ui = 0;
    if (!S.next(0, cur)) return;
    f32x4 acc[2][2][4][2];
#pragma unroll
    for (int a = 0; a < 2; ++a)
#pragma unroll
        for (int b = 0; b < 2; ++b)
#pragma unroll
            for (int m = 0; m < 4; ++m)
#pragma unroll
                for (int n = 0; n < 2; ++n) acc[a][b][m][n] = (f32x4){0.f, 0.f, 0.f, 0.f};
    bf16x8 At[4][2], B0[2][2], B1[2][2];
    const char* cA = S.abase(g, cur); const char* cB = S.bbase(g, cur);
    PG8_STAGE(PG8_SB(0, 0), cB, voffB); PG8_STAGE(PG8_SB(0, 1), cB + hstepB, voffB); PG8_STAGE(PG8_SA(0, 0), cA, voffA); PG8_STAGE(PG8_SA(0, 1), cA + hstepA, voffA);
    if (wr == 1) PG8_BAR;
    PG8_WAIT_V(2); PG8_BAR;
    PG8_STAGE(PG8_SB(1, 0), cB + kstep, voffB); PG8_STAGE(PG8_SA(1, 0), cA + kstep, voffA); PG8_STAGE(PG8_SB(1, 1), cB + hstepB + kstep, voffB);
    PG8_WAIT_V(6); PG8_BAR;
    for (;;) {
        const bool has_next = S.next(ui + 1, nxt);
        const char* nA = has_next ? S.abase(g, nxt) : cA; const char* nB = has_next ? S.bbase(g, nxt) : cB;
        for (int t = 0; t < nt; t += 2) {
            const bool last = (t == nt - 2);
            const char* a1 = cA + (size_t)(t + 1) * kstep;
            const char* a2 = last ? nA : cA + (size_t)(t + 2) * kstep; const char* b2 = last ? nB : cB + (size_t)(t + 2) * kstep;
            const char* a3 = a2 + kstep; const char* b3 = b2 + kstep;
            PG8_LDB(B0, 0, 0); PG8_LDB(B1, 0, 1); PG8_SCHED; PG8_LDA(At, 0, 0); PG8_STAGE(PG8_SA(1, 1), a1 + hstepA, voffA);
            PG8_WAIT_V(8); PG8_WAIT_L(0); PG8_BAR; PG8_MMA(0, 0, At, B0); PG8_MMA(0, 1, At, B1); PG8_BAR; PG8_SCHED;
            PG8_LDA(At, 0, 1); PG8_STAGE(PG8_SB(0, 0), b2, voffB); PG8_STAGE(PG8_SB(0, 1), b2 + hstepB, voffB); PG8_STAGE(PG8_SA(0, 0), a2, voffA);
            PG8_WAIT_V(8); PG8_WAIT_L(0); PG8_BAR; PG8_MMA(1, 0, At, B0); PG8_MMA(1, 1, At, B1); PG8_BAR; PG8_SCHED;
            PG8_LDB(B0, 1, 0); PG8_LDB(B1, 1, 1); PG8_SCHED; PG8_LDA(At, 1, 0); PG8_STAGE(PG8_SA(0, 1), a2 + hstepA, voffA);
            PG8_WAIT_V(8); PG8_WAIT_L(0); PG8_BAR; PG8_MMA(0, 0, At, B0); PG8_MMA(0, 1, At, B1); PG8_BAR; PG8_SCHED;
            PG8_LDA(At, 1, 1); PG8_STAGE(PG8_SB(1, 0), b3, voffB); PG8_STAGE(PG8_SB(1, 1), b3 + hstepB, voffB); PG8_STAGE(PG8_SA(1, 0), a3, voffA);
            PG8_WAIT_V(8); PG8_WAIT_L(0); PG8_BAR; PG8_MMA(1, 0, At, B0); PG8_MMA(1, 1, At, B1); PG8_BAR; PG8_SCHED;
        }
        if constexpr (ALIGN_EPI) { if (wr == 0) PG8_BAR; }
        E(acc, cur, wr, wc, fr, fq);
        if (!has_next) break;
#pragma unroll
        for (int a = 0; a < 2; ++a)
#pragma unroll
            for (int b = 0; b < 2; ++b)
#pragma unroll
                for (int m = 0; m < 4; ++m)
#pragma unroll
                    for (int n = 0; n < 2; ++n) acc[a][b][m][n] = (f32x4){0.f, 0.f, 0.f, 0.f};
        cur = nxt; cA = nA; cB = nB; ++ui;
        if constexpr (ALIGN_EPI) { if (wr == 1) PG8_BAR; }
    }
    PG8_WAIT_V(0);
    if constexpr (!ALIGN_EPI) { if (wr == 0) PG8_BAR; }
    PG8_BAR;
#undef PG8_SA
#undef PG8_SB
#undef PG8_STAGE
#undef PG8_LDA
#undef PG8_LDB
#undef PG8_MMA
#undef PG8_WAIT_V
#undef PG8_WAIT_L
#undef PG8_BAR
#undef PG8_SCHED
}

__device__ __forceinline__ float rstd_part(const float* part, int row) {
    const f32x4* p = (const f32x4*)(part + (size_t)row * 16);
    const f32x4 a = p[0], b = p[1], c = p[2], d = p[3];
    const float s = ((a[0] + a[1]) + (a[2] + a[3])) + ((b[0] + b[1]) + (b[2] + b[3])) + ((c[0] + c[1]) + (c[2] + c[3])) + ((d[0] + d[1]) + (d[2] + d[3]));
    return 1.0f / sqrtf(s * (1.0f / D) + EPS);
}
__device__ __forceinline__ u32x4 pack8(const f32x4 v0, const f32x4 v1) { u32x4 w; w.x = cvtpk(v0[0], v0[1]); w.y = cvtpk(v0[2], v0[3]); w.z = cvtpk(v1[0], v1[1]); w.w = cvtpk(v1[2], v1[3]); return w; }

struct EpiG1 {
    static constexpr bool PERM = true;
    bf16_t* Y; const float* rstd_direct; const float* part; float* partq; float* partkv; float* ff; bf16_t* Km; const float* rope;
    __device__ __forceinline__ void operator()(const f32x4 (&acc)[2][2][4][2], const Unit& u, int wr, int wc, int fr, int fq) const {
#pragma unroll
        for (int ai = 0; ai < 2; ++ai)
#pragma unroll
            for (int m = 0; m < 4; ++m) {
                asm volatile("" ::: "memory");
                const int row = u.pm * BM + ai * HALF + wr * 64 + m * 16 + fr;
                const float rs = rstd_direct ? rstd_direct[row] : rstd_part(part, row);
                f32x4 v[2][2];
#pragma unroll
                for (int bj = 0; bj < 2; ++bj) { v[bj][0] = acc[ai][bj][m][0] * rs; v[bj][1] = acc[ai][bj][m][1] * rs;
                    *(u32x4*)(Y + (size_t)row * NY + u.pn * BM + bj * HALF + wc * 32 + 8 * fq) = pack8(v[bj][0], v[bj][1]); }
                if (u.pn == Y_CQ / 256) {
                    float s = 0.f;
#pragma unroll
                    for (int bj = 0; bj < 2; ++bj)
#pragma unroll
                        for (int n = 0; n < 2; ++n) { const f32x4 x = v[bj][n]; s += (x[0] * x[0] + x[1] * x[1]) + (x[2] * x[2] + x[3] * x[3]); }
                    s += __shfl_xor(s, 16); s += __shfl_xor(s, 32);
                    if (fq == 0) partq[row * 4 + wc] = s;
                }
                if (u.pn == Y_CKV / 256) {
                    float s = 0.f;
#pragma unroll
                    for (int n = 0; n < 2; ++n) { const f32x4 x = v[0][n]; s += (x[0] * x[0] + x[1] * x[1]) + (x[2] * x[2] + x[3] * x[3]); }
                    s += __shfl_xor(s, 16); s += __shfl_xor(s, 32);
                    if (fq == 0) partkv[row * 4 + wc] = s;
                    if (wc == 0) {
                        const f32x4* rp = (const f32x4*)(rope + (size_t)row * 32 + 8 * fq);
                        const f32x4 cs0 = rp[0], cs1 = rp[1];
                        const f32x4 t1 = v[1][0], t2 = v[1][1];
                        f32x4 o1, o2;
                        o1[0] = t1[0] * cs0[0] - t2[0] * cs0[1]; o2[0] = t2[0] * cs0[0] + t1[0] * cs0[1];
                        o1[1] = t1[1] * cs0[2] - t2[1] * cs0[3]; o2[1] = t2[1] * cs0[2] + t1[1] * cs0[3];
                        o1[2] = t1[2] * cs1[0] - t2[2] * cs1[1]; o2[2] = t2[2] * cs1[0] + t1[2] * cs1[1];
                        o1[3] = t1[3] * cs1[2] - t2[3] * cs1[3]; o2[3] = t2[3] * cs1[2] + t1[3] * cs1[3];
                        const u32x4 w = pack8(o1, o2);
#pragma unroll
                        for (int h = 0; h < 4; ++h) *(u32x4*)(Km + (size_t)row * 384 + h * 96 + 64 + 8 * fq) = w;
                    }
                    if (wc == 1 && fq == 0) *(f32x4*)(ff + (size_t)row * 4) = v[1][0];
                }
            }
    }
};
struct EpiQup {
    static constexpr bool PERM = true;
    bf16_t* Qm; const float* partq; const float* rope;
    __device__ __forceinline__ void operator()(const f32x4 (&acc)[2][2][4][2], const Unit& u, int wr, int wc, int fr, int fq) const {
#pragma unroll
        for (int ai = 0; ai < 2; ++ai)
#pragma unroll
            for (int m = 0; m < 4; ++m) {
                asm volatile("" ::: "memory");
                const int row = u.pm * BM + ai * HALF + wr * 64 + m * 16 + fr;
                const f32x4 pq = *(const f32x4*)(partq + (size_t)row * 4);
                const float rs = 1.0f / sqrtf(((pq[0] + pq[1]) + (pq[2] + pq[3])) * (1.0f / 256.0f) + EPS);
#pragma unroll
                for (int bj = 0; bj < 2; ++bj) {
                    const int col = u.pn * BM + bj * HALF + wc * 32 + 8 * fq;
                    if (col < 384) {
                        f32x4 v0 = acc[ai][bj][m][0] * rs, v1 = acc[ai][bj][m][1] * rs;
                        const int cm = col % 96;
                        if (cm >= 64) {
                            const f32x4* rp = (const f32x4*)(rope + (size_t)row * 32 + (cm - 64));
                            const f32x4 cs0 = rp[0], cs1 = rp[1];
                            const f32x4 t1 = v0, t2 = v1;
                            v0[0] = t1[0] * cs0[0] - t2[0] * cs0[1]; v1[0] = t2[0] * cs0[0] + t1[0] * cs0[1];
                            v0[1] = t1[1] * cs0[2] - t2[1] * cs0[3]; v1[1] = t2[1] * cs0[2] + t1[1] * cs0[3];
                            v0[2] = t1[2] * cs1[0] - t2[2] * cs1[1]; v1[2] = t2[2] * cs1[0] + t1[2] * cs1[1];
                            v0[3] = t1[3] * cs1[2] - t2[3] * cs1[3]; v1[3] = t2[3] * cs1[2] + t1[3] * cs1[3];
                        }
                        *(u32x4*)(Qm + (size_t)row * 384 + col) = pack8(v0, v1);
                    }
                }
            }
    }
};
struct EpiKVup {
    static constexpr bool PERM = true;
    bf16_t* Km; bf16_t* Vm; const float* partkv;
    __device__ __forceinline__ void operator()(const f32x4 (&acc)[2][2][4][2], const Unit& u, int wr, int wc, int fr, int fq) const {
#pragma unroll
        for (int ai = 0; ai < 2; ++ai)
#pragma unroll
            for (int m = 0; m < 4; ++m) {
                asm volatile("" ::: "memory");
                const int row = u.pm * BM + ai * HALF + wr * 64 + m * 16 + fr;
                const f32x4 pq = *(const f32x4*)(partkv + (size_t)row * 4);
                const float rs = 1.0f / sqrtf(((pq[0] + pq[1]) + (pq[2] + pq[3])) * (1.0f / 128.0f) + EPS);
#pragma unroll
                for (int bj = 0; bj < 2; ++bj) {
                    const int col = u.pn * BM + bj * HALF + wc * 32 + 8 * fq;
                    const int h = col >> 7, c = col & 127;
                    const u32x4 w = pack8(acc[ai][bj][m][0] * rs, acc[ai][bj][m][1] * rs);
                    if (c < 64) *(u32x4*)(Km + (size_t)row * 384 + h * 96 + c) = w;
                    else *(u32x4*)(Vm + (size_t)row * 256 + h * 64 + (c - 64)) = w;
                }
            }
    }
};
struct EpiRes {
    static constexpr bool PERM = false;
    const float* base; float* out; bf16_t* xb; float* part;
    __device__ __forceinline__ void operator()(const f32x4 (&acc)[2][2][4][2], const Unit& u, int wr, int wc, int fr, int fq) const {
#pragma unroll
        for (int ai = 0; ai < 2; ++ai)
#pragma unroll
            for (int m = 0; m < 4; ++m) {
                asm volatile("" ::: "memory");
                const int row = u.pm * BM + ai * HALF + wr * 64 + m * 16 + fr;
                float s = 0.f;
#pragma unroll
                for (int bj = 0; bj < 2; ++bj)
#pragma unroll
                    for (int n = 0; n < 2; ++n) {
                        const size_t off = (size_t)row * D + u.pn * BM + bj * HALF + wc * 32 + n * 16 + 4 * fq;
                        const f32x4 x = *(const f32x4*)(base + off) + acc[ai][bj][m][n];
                        *(f32x4*)(out + off) = x;
                        s += (x[0] * x[0] + x[1] * x[1]) + (x[2] * x[2] + x[3] * x[3]);
                        if (xb) { u32x2 w; w.x = cvtpk(x[0], x[1]); w.y = cvtpk(x[2], x[3]); *(u32x2*)(xb + off) = w; }
                    }
                s += __shfl_xor(s, 16); s += __shfl_xor(s, 32);
                if (fq == 0) part[(size_t)row * 16 + u.pn * 4 + wc] = s;
            }
    }
};
struct EpiSwiglu {
    static constexpr bool PERM = true;
    bf16_t* H; const float* rstd_direct; const float* part;
    __device__ __forceinline__ void operator()(const f32x4 (&acc)[2][2][4][2], const Unit& u, int wr, int wc, int fr, int fq) const {
#pragma unroll
        for (int ai = 0; ai < 2; ++ai)
#pragma unroll
            for (int m = 0; m < 4; ++m) {
                asm volatile("" ::: "memory");
                const int row = u.pm * BM + ai * HALF + wr * 64 + m * 16 + fr;
                const float rs = rstd_direct ? rstd_direct[row] : rstd_part(part, row);
                f32x4 hv[2];
#pragma unroll
                for (int n = 0; n < 2; ++n) {
                    const f32x4 gt = acc[ai][0][m][n] * rs, up = acc[ai][1][m][n] * rs;
#pragma unroll
                    for (int e = 0; e < 4; ++e) { const float sg = __builtin_amdgcn_rcpf(1.0f + __builtin_amdgcn_exp2f(-gt[e] * LOG2E)); hv[n][e] = gt[e] * sg * up[e]; }
                }
                *(u32x4*)(H + (size_t)row * FF + u.pn * HALF + wc * 32 + 8 * fq) = pack8(hv[0], hv[1]);
            }
    }
};
struct EpiY {
    static constexpr bool PERM = true;
    bf16_t* O;
    __device__ __forceinline__ void operator()(const f32x4 (&acc)[2][2][4][2], const Unit& u, int wr, int wc, int fr, int fq) const {
#pragma unroll
        for (int ai = 0; ai < 2; ++ai)
#pragma unroll
            for (int m = 0; m < 4; ++m) {
                asm volatile("" ::: "memory");
                const int row = u.pm * BM + ai * HALF + wr * 64 + m * 16 + fr;
#pragma unroll
                for (int bj = 0; bj < 2; ++bj) *(u32x4*)(O + (size_t)row * D + u.pn * BM + bj * HALF + wc * 32 + 8 * fq) = pack8(acc[ai][bj][m][0], acc[ai][bj][m][1]);
            }
    }
};
}

namespace att {
constexpr int VSLOT = 8192;
template <int NDK, int MODE, int NSL> struct Lay {
    static constexpr int KSLOT = NDK * 2048, LDS_K = 0, LDS_V = NSL * KSLOT, LDS_WS = LDS_V + NSL * VSLOT, LDS_CB = LDS_WS + 8 * 256, LDS_OST = 0,
                         LDS_TOTAL = LDS_CB + (MODE == 1 ? 32768 : 0);
    static_assert(LDS_TOTAL <= RING_BYTES && 8 * 4096 <= LDS_WS, "attention LDS");
};
struct AU {
    const bf16_t* Q; const bf16_t* K; const bf16_t* V; bf16_t* O; float* lse; const float* colb;
    int qpitch, kpitch, vpitch, opitch, lpitch;
    int q0, kt0, kt1, span; float alibi, sink2, xthr;
};
__device__ __forceinline__ int crow(int r, int hi) { return (r & 3) + 8 * (r >> 2) + 4 * hi; }
__device__ __forceinline__ void glds16(const void* gsrc, unsigned lds_dst) { unsigned keep;
    asm volatile("s_mov_b32 %0, m0\n\ts_mov_b32 m0, %2\n\ts_nop 0\n\tglobal_load_lds_dwordx4 %1, off\n\ts_mov_b32 m0, %0" : "=&s"(keep) : "v"(gsrc), "s"(lds_dst) : "memory"); }
#define ATT_WAIT_BAR() asm volatile("s_waitcnt vmcnt(0) lgkmcnt(0)\n\ts_barrier" ::: "memory")
#define ATT_WAITV_BAR(N) asm volatile("s_waitcnt vmcnt(%0) lgkmcnt(0)\n\ts_barrier" :: "n"(N) : "memory")
__device__ __forceinline__ float permswap_max(float m) { auto rr = __builtin_amdgcn_permlane32_swap(__float_as_uint(m), __float_as_uint(m), false, false); return fmaxf(__uint_as_float(rr[0]), __uint_as_float(rr[1])); }
__device__ __forceinline__ float permswap_sum(float m) { auto rr = __builtin_amdgcn_permlane32_swap(__float_as_uint(m), __float_as_uint(m), false, false); return __uint_as_float(rr[0]) + __uint_as_float(rr[1]); }

#define ATT_LGKM0() do { asm volatile("s_waitcnt lgkmcnt(0)" ::: "memory"); __builtin_amdgcn_sched_barrier(0); } while (0)
template <int NDK>
__device__ __forceinline__ void k_issue(bf16x8 (&kf)[2 * NDK], unsigned kaddr) {
#pragma unroll
    for (int d0 = 0; d0 < NDK; ++d0) {
        asm volatile("ds_read_b128 %0, %1 offset:%2" : "=v"(kf[2 * d0]) : "v"(kaddr), "i"(d0 * 2048) : "memory");
        asm volatile("ds_read_b128 %0, %1 offset:%2" : "=v"(kf[2 * d0 + 1]) : "v"(kaddr), "i"(d0 * 2048 + 512) : "memory");
    }
}
template <int NDK>
__device__ __forceinline__ void qk_mma(f32x16& p0, f32x16& p1, const bf16x8 (&kf)[2 * NDK], const bf16x8 (&qr)[NDK]) {
    p0 = (f32x16){}; p1 = (f32x16){};
#pragma unroll
    for (int d0 = 0; d0 < NDK; ++d0) {
        p0 = __builtin_amdgcn_mfma_f32_32x32x16_bf16(kf[2 * d0], qr[d0], p0, 0, 0, 0);
        p1 = __builtin_amdgcn_mfma_f32_32x32x16_bf16(kf[2 * d0 + 1], qr[d0], p1, 0, 0, 0);
    }
}
__device__ __forceinline__ void v_issue(s16x4 (&vlo)[8], s16x4 (&vhi)[8], unsigned vaddr) {
#pragma unroll
    for (int i = 0; i < 8; ++i) {
        asm volatile("ds_read_b64_tr_b16 %0, %1 offset:%2" : "=v"(vlo[i]) : "v"(vaddr), "i"((i >> 2) * 4096 + (i & 3) * 1024) : "memory");
        asm volatile("ds_read_b64_tr_b16 %0, %1 offset:%2" : "=v"(vhi[i]) : "v"(vaddr), "i"((i >> 2) * 4096 + (i & 3) * 1024 + 512) : "memory");
    }
}
__device__ __forceinline__ void pv_mma(f32x16& o0, f32x16& o1, const s16x4 (&vlo)[8], const s16x4 (&vhi)[8], const u32x4 pw0, const u32x4 pw1, const u32x4 pw2, const u32x4 pw3) {
#define ATT_VF(i) (bf16x8){vlo[i][0], vlo[i][1], vlo[i][2], vlo[i][3], vhi[i][0], vhi[i][1], vhi[i][2], vhi[i][3]}
    o0 = __builtin_amdgcn_mfma_f32_32x32x16_bf16(__builtin_bit_cast(bf16x8, pw0), ATT_VF(0), o0, 0, 0, 0);
    o1 = __builtin_amdgcn_mfma_f32_32x32x16_bf16(__builtin_bit_cast(bf16x8, pw0), ATT_VF(4), o1, 0, 0, 0);
    o0 = __builtin_amdgcn_mfma_f32_32x32x16_bf16(__builtin_bit_cast(bf16x8, pw1), ATT_VF(1), o0, 0, 0, 0);
    o1 = __builtin_amdgcn_mfma_f32_32x32x16_bf16(__builtin_bit_cast(bf16x8, pw1), ATT_VF(5), o1, 0, 0, 0);
    o0 = __builtin_amdgcn_mfma_f32_32x32x16_bf16(__builtin_bit_cast(bf16x8, pw2), ATT_VF(2), o0, 0, 0, 0);
    o1 = __builtin_amdgcn_mfma_f32_32x32x16_bf16(__builtin_bit_cast(bf16x8, pw2), ATT_VF(6), o1, 0, 0, 0);
    o0 = __builtin_amdgcn_mfma_f32_32x32x16_bf16(__builtin_bit_cast(bf16x8, pw3), ATT_VF(3), o0, 0, 0, 0);
    o1 = __builtin_amdgcn_mfma_f32_32x32x16_bf16(__builtin_bit_cast(bf16x8, pw3), ATT_VF(7), o1, 0, 0, 0);
#undef ATT_VF
}
__device__ __forceinline__ float max3f(float a, float b, float c) { float r; asm("v_max3_f32 %0, %1, %2, %3" : "=v"(r) : "v"(a), "v"(b), "v"(c)); return r; }

template <int NDK, int MODE, int NSL>
__device__ __forceinline__ void attn_unit(const AU& u, LAS unsigned char* shm) {
    typedef Lay<NDK, MODE, NSL> L; constexpr int KSLOT = L::KSLOT, LDS_K = L::LDS_K, LDS_V = L::LDS_V, LDS_WS = L::LDS_WS, LDS_CB = L::LDS_CB, LDS_OST = L::LDS_OST, DF = NSL - 2;
    int tid_l = threadIdx.x; asm volatile("" : "+v"(tid_l));
    const int tid = tid_l, lane = tid & 63, r32 = lane & 31, hi = lane >> 5; const int wid = __builtin_amdgcn_readfirstlane(tid >> 6);
    const unsigned lds0 = (unsigned)(uintptr_t)shm;
    LAS float* wsf = (LAS float*)(shm + LDS_WS) + wid * 64;
    LAS float* cb = (LAS float*)(shm + LDS_CB);
    const int q = u.q0 + wid * 32 + r32;
    const int qmin = u.q0 + wid * 32, qmax = qmin + 31;
    float cq = 0.f;
    int ukt0 = u.kt0;
    if (MODE == 1) {
        LAS int* red = (LAS int*)cb;
        if (tid == 0) *red = u.kt1 - 1;
        ATT_WAIT_BAR();
        const float thr = u.colb[u.q0] + u.xthr;
        for (int j = tid; j < u.kt1; j += 512) if (u.colb[64 * j + 63] <= thr) atomicMin((int*)red, j);
        ATT_WAIT_BAR();
        ukt0 = __builtin_amdgcn_readfirstlane(*red);
        ATT_WAIT_BAR();
        const int nk = (u.kt1 - ukt0) * 64;
        for (int i = tid; i < nk; i += 512) cb[i] = u.colb[ukt0 * 64 + i];
        cq = u.colb[q];
    }
    bf16x8 qr[NDK];
    { const bf16_t* qp = u.Q + (size_t)q * u.qpitch + hi * 8;
#pragma unroll
      for (int d0 = 0; d0 < NDK; ++d0) qr[d0] = *(const bf16x8*)(qp + d0 * 16); }
#define ATT_ISSUE(kt_, s_) do { \
        const bf16_t* kp_ = u.K + (size_t)((kt_) * 64 + lane) * u.kpitch; \
        glds16(kp_ + wid * 8, (unsigned)__builtin_amdgcn_readfirstlane(lds0 + LDS_K + (s_) * KSLOT + wid * 1024)); \
        if (NDK == 6) { if (wid < 4) glds16(kp_ + (wid + 8) * 8, (unsigned)__builtin_amdgcn_readfirstlane(lds0 + LDS_K + (s_) * KSLOT + (wid + 8) * 1024)); } \
        const bf16_t* vp_ = u.V + (size_t)((kt_) * 64 + 16 * (wid & 3) + (lane >> 2)) * u.vpitch + (wid >> 2) * 32 + (lane & 3) * 8; \
        glds16(vp_, (unsigned)__builtin_amdgcn_readfirstlane(lds0 + LDS_V + (s_) * VSLOT + wid * 1024)); } while (0)
    float mrun = -3.0e38f, lrun = 0.f;
    f32x16 o0 = {}, o1 = {};
    const int nT = u.kt1 - ukt0;
    int whi = qmax >> 6; if (whi > u.kt1 - 1) whi = u.kt1 - 1;
    int wlo = ukt0; if (MODE == 2) { const int l_ = (qmin - u.span) >> 6; if (l_ > wlo) wlo = l_; }
    const int mask_from = qmin >> 6;
    u32x4 pw0, pw1, pw2, pw3;
#define ATT_SOFT(p0, p1, kt_) do { \
        const int kmin_ = (kt_) * 64; \
        if (MODE == 1) { \
            const LAS f32x4* cp_ = (const LAS f32x4*)(cb + ((kt_) - ukt0) * 64 + 4 * hi); \
            _Pragma("unroll") for (int j = 0; j < 4; ++j) { const f32x4 c0_ = cp_[2 * j], c1_ = cp_[2 * j + 8]; \
                _Pragma("unroll") for (int e = 0; e < 4; ++e) { p0[4 * j + e] += cq - c0_[e]; p1[4 * j + e] += cq - c1_[e]; } } \
        } \
        if (MODE == 2) { \
            _Pragma("unroll") for (int r = 0; r < 16; ++r) { const int d0_ = q - (kmin_ + crow(r, hi)), d1_ = d0_ - 32; \
                p0[r] = ((unsigned)d0_ <= (unsigned)u.span) ? p0[r] - u.alibi * (float)d0_ : -INFINITY; \
                p1[r] = ((unsigned)d1_ <= (unsigned)u.span) ? p1[r] - u.alibi * (float)d1_ : -INFINITY; } \
        } else if ((kt_) >= mask_from) { \
            _Pragma("unroll") for (int r = 0; r < 16; ++r) { const int kj_ = kmin_ + crow(r, hi); if (kj_ > q) p0[r] = -INFINITY; if (kj_ + 32 > q) p1[r] = -INFINITY; } \
        } \
        float ra_ = max3f(p0[0], p0[1], p1[0]), rb_ = max3f(p0[2], p0[3], p1[1]); ra_ = max3f(ra_, p1[2], p1[3]); \
        _Pragma("unroll") for (int r = 4; r < 16; r += 4) { ra_ = max3f(ra_, p0[r], p0[r + 1]); rb_ = max3f(rb_, p0[r + 2], p0[r + 3]); ra_ = max3f(ra_, p1[r], p1[r + 1]); rb_ = max3f(rb_, p1[r + 2], p1[r + 3]); } \
        float rm_ = max3f(ra_, rb_, mrun); \
        { auto rr_ = __builtin_amdgcn_permlane32_swap(__float_as_uint(rm_), __float_as_uint(rm_), false, false); rm_ = max3f(__uint_as_float(rr_[0]), __uint_as_float(rr_[1]), mrun); } \
        const float mn_ = rm_, alpha_ = __builtin_amdgcn_exp2f(mrun - mn_); \
        mrun = mn_; \
        float sum_ = 0.f; \
        _Pragma("unroll") for (int r = 0; r < 16; ++r) { p0[r] = __builtin_amdgcn_exp2f(p0[r] - mn_); p1[r] = __builtin_amdgcn_exp2f(p1[r] - mn_); sum_ += p0[r] + p1[r]; } \
        lrun = lrun * alpha_ + sum_; \
        if (!__all(alpha_ == 1.0f)) { \
            if (hi == 0) wsf[r32] = alpha_; \
            LDS_WAIT(); \
            _Pragma("unroll") for (int j = 0; j < 4; ++j) { const f32x4 f_ = *(const LAS f32x4*)(wsf + 8 * j + 4 * hi); \
                _Pragma("unroll") for (int e = 0; e < 4; ++e) { o0[4 * j + e] *= f_[e]; o1[4 * j + e] *= f_[e]; } } \
        } \
        pw0 = (u32x4){cvtpk(p0[0], p0[1]), cvtpk(p0[2], p0[3]), cvtpk(p0[4], p0[5]), cvtpk(p0[6], p0[7])}; \
        pw1 = (u32x4){cvtpk(p0[8], p0[9]), cvtpk(p0[10], p0[11]), cvtpk(p0[12], p0[13]), cvtpk(p0[14], p0[15])}; \
        pw2 = (u32x4){cvtpk(p1[0], p1[1]), cvtpk(p1[2], p1[3]), cvtpk(p1[4], p1[5]), cvtpk(p1[6], p1[7])}; \
        pw3 = (u32x4){cvtpk(p1[8], p1[9]), cvtpk(p1[10], p1[11]), cvtpk(p1[12], p1[13]), cvtpk(p1[14], p1[15])}; \
    } while (0)
#pragma unroll
    for (int j = 0; j <= DF; ++j) if (j < nT) ATT_ISSUE(ukt0 + j, j);
    const unsigned kaddr0 = lds0 + LDS_K + hi * 1024 + r32 * 16;
    const unsigned vaddr0 = lds0 + LDS_V + ((lane >> 4) & 1) * 32 + (lane & 3) * 8 + (4 * hi + ((lane & 15) >> 2)) * 64;
#define ATT_LOOP(HB) do { \
    constexpr int PER = (NDK == 6 && !(HB)) ? 3 : 2; \
    if (ukt0 + DF < u.kt1) ATT_WAITV_BAR((DF - 1) * PER); else ATT_WAIT_BAR(); \
    f32x16 p0 = {}, p1 = {}; bf16x8 kf[2 * NDK]; s16x4 vlo[8], vhi[8]; \
    if (wlo <= ukt0 && ukt0 <= whi) { k_issue<NDK>(kf, kaddr0); if (HB) { ATT_LGKM0(); qk_mma<NDK>(p0, p1, kf, qr); } } \
    int sc = 0; \
    for (int i = 0; i < nT; ++i) { \
        const int kt = ukt0 + i; \
        if (i > 0) { if (kt + DF < u.kt1) ATT_WAITV_BAR((DF - 1) * PER); else ATT_WAIT_BAR(); } \
        const int sn = (sc + 1 == NSL) ? 0 : sc + 1; \
        if (kt + DF + 1 < u.kt1) { const int sf_ = (sc == 0) ? NSL - 1 : sc - 1; ATT_ISSUE(kt + DF + 1, sf_); } \
        const bool actc = (wlo <= kt) && (kt <= whi), actn = (kt + 1 < u.kt1) && (wlo <= kt + 1) && (kt + 1 <= whi); \
        if (actc) { \
            if (!(HB)) { ATT_LGKM0(); qk_mma<NDK>(p0, p1, kf, qr); } \
            v_issue(vlo, vhi, vaddr0 + sc * VSLOT); __builtin_amdgcn_sched_barrier(0); \
            ATT_SOFT(p0, p1, kt); \
            __builtin_amdgcn_sched_barrier(0); \
            if (actn) k_issue<NDK>(kf, kaddr0 + sn * KSLOT); \
            if (HB) { ATT_LGKM0(); } else { if (actn) asm volatile("s_waitcnt lgkmcnt(%0)" :: "n"(2 * NDK) : "memory"); else asm volatile("s_waitcnt lgkmcnt(0)" ::: "memory"); __builtin_amdgcn_sched_barrier(0); } \
            pv_mma(o0, o1, vlo, vhi, pw0, pw1, pw2, pw3); \
            if ((HB) && actn) qk_mma<NDK>(p0, p1, kf, qr); \
        } else if (actn) { k_issue<NDK>(kf, kaddr0 + sn * KSLOT); if (HB) { ATT_LGKM0(); qk_mma<NDK>(p0, p1, kf, qr); } } \
        sc = sn; \
    } } while (0)
    if (wid < 4) ATT_LOOP(false); else ATT_LOOP(true);
#undef ATT_LOOP
    asm volatile("s_waitcnt lgkmcnt(0)\n\ts_barrier" ::: "memory");
    float ltot = permswap_sum(lrun);
    if (u.lse && hi == 0) u.lse[(size_t)q * u.lpitch] = mrun + __builtin_amdgcn_logf(ltot);
    if (MODE == 2) ltot += __builtin_amdgcn_exp2f(u.sink2 - mrun);
    if (hi == 0) wsf[32 + r32] = ltot;
    LDS_WAIT();
    float rli[16];
#pragma unroll
    for (int j = 0; j < 4; ++j) { const f32x4 f = *(const LAS f32x4*)(wsf + 32 + 8 * j + 4 * hi);
#pragma unroll
        for (int e = 0; e < 4; ++e) rli[4 * j + e] = __builtin_amdgcn_rcpf(f[e]); }
    { LAS bf16_t* stg = (LAS bf16_t*)(shm + LDS_OST) + wid * 2048;
#pragma unroll
      for (int r = 0; r < 16; ++r) { const int orow = crow(r, hi);
          stg[orow * 64 + r32] = (bf16_t)(cvtpk(o0[r] * rli[r], 0.f) & 0xffffu);
          stg[orow * 64 + 32 + r32] = (bf16_t)(cvtpk(o1[r] * rli[r], 0.f) & 0xffffu); }
      LDS_WAIT();
      bf16_t* Ow = u.O + (size_t)(u.q0 + wid * 32) * u.opitch;
#pragma unroll
      for (int i = 0; i < 4; ++i) { const int row = i * 8 + (lane >> 3), ch = lane & 7; const u32x4 v = *(const LAS u32x4*)(stg + row * 64 + ch * 8); *(u32x4*)(Ow + (size_t)row * u.opitch + ch * 8) = v; } }
    ATT_WAIT_BAR();
#undef ATT_ISSUE
#undef ATT_SOFT
}
}

#define XB_TMO      128
#define XB_XCNT(j)  (256  + 64 * (j))
#define XB_XSUB(j)  (1280 + 64 * (j))
#define XB_XGEN(j)  (2304 + 64 * (j))
#define XB_TOP      3328
#define XB_TOPGEN   3392
#define XCD_BAR_WORDS 3456
#define XB_SPIN_CAP (1u << 18)
__device__ __forceinline__ unsigned xb_ld(unsigned* p)              { return __hip_atomic_load(p, __ATOMIC_RELAXED, __HIP_MEMORY_SCOPE_AGENT); }
__device__ __forceinline__ unsigned xb_add(unsigned* p, unsigned v) { return __hip_atomic_fetch_add(p, v, __ATOMIC_RELAXED, __HIP_MEMORY_SCOPE_AGENT); }
__device__ __forceinline__ unsigned xb_xcc_id() { return (unsigned)__builtin_amdgcn_s_getreg((3 << 11) | 20) & 0xFu; }
#define XB_SPIN(cond, bar) do { unsigned _sp = 0; while (cond) { __builtin_amdgcn_s_sleep(1); \
    if ((++_sp & 255u) == 0u) { if (xb_ld(&(bar)[XB_TMO])) break; if (_sp > XB_SPIN_CAP) { atomicAdd(&(bar)[XB_TMO], 1u); break; } } } } while (0)
struct XcdBarrier { unsigned* bar; unsigned x; volatile LAS unsigned* st; };
__device__ __forceinline__ XcdBarrier xcd_barrier_post(unsigned* bar, volatile LAS unsigned* st) {
    XcdBarrier b; b.bar = bar; b.x = xb_xcc_id(); b.st = st;
    if (threadIdx.x == 0) (void)xb_add(&bar[XB_XCNT(b.x)], 1u);
    return b;
}
__device__ __forceinline__ void xcd_barrier_complete(unsigned* bar, unsigned x, unsigned& nloc, unsigned& nx) {
    const unsigned G = gridDim.x * gridDim.y * gridDim.z;
    unsigned sum, cnt, mine, sp = 0u;
    for (;;) {
        sum = 0u; cnt = 0u; mine = 0u;
#pragma unroll
        for (unsigned j = 0; j < 16; ++j) { const unsigned c = xb_ld(&bar[XB_XCNT(j)]); sum += c; cnt += (c > 0u) ? 1u : 0u; mine = (j == x) ? c : mine; }
        if (sum == G) break;
        __builtin_amdgcn_s_sleep(1);
        if ((++sp & 255u) == 0u) { if (xb_ld(&bar[XB_TMO])) break; if (sp > XB_SPIN_CAP) { atomicAdd(&bar[XB_TMO], 1u); break; } }
    }
    nloc = mine > 0u ? mine : 1u; nx = cnt > 0u ? cnt : 1u;
}
__device__ __forceinline__ void xcd_barrier(const XcdBarrier& b) {
    asm volatile("s_waitcnt vmcnt(0)" ::: "memory");
    __syncthreads();
    if (threadIdx.x == 0) {
        unsigned* bar = b.bar;
        __builtin_amdgcn_s_waitcnt(0);
        unsigned nloc = b.st[0], nx = b.st[1];
        if (nloc == 0u) { xcd_barrier_complete(bar, b.x, nloc, nx); b.st[0] = nloc; b.st[1] = nx; }
        const unsigned old = xb_add(&bar[XB_XSUB(b.x)], 1u);
        const unsigned gen = old / nloc;
        if (old + 1u == (gen + 1u) * nloc) {
            __builtin_amdgcn_fence(__ATOMIC_RELEASE, "agent");
            asm volatile("s_waitcnt vmcnt(0)" ::: "memory");
            const unsigned og = xb_add(&bar[XB_TOP], 1u);
            const unsigned tg = og / nx;
            if (og + 1u == (tg + 1u) * nx) xb_add(&bar[XB_TOPGEN], 1u);
            else XB_SPIN(xb_ld(&bar[XB_TOPGEN]) == tg, bar);
            __builtin_amdgcn_fence(__ATOMIC_ACQUIRE, "agent");
            xb_add(&bar[XB_XGEN(b.x)], 1u);
            asm volatile("s_waitcnt vmcnt(0)" ::: "memory");
        } else {
            XB_SPIN(xb_ld(&bar[XB_XGEN(b.x)]) == gen, bar);
            __builtin_amdgcn_fence(__ATOMIC_ACQUIRE, "agent");
            asm volatile("s_waitcnt vmcnt(0)" ::: "memory");
        }
    }
    __syncthreads();
}

struct Args {
    const float* x; const int* pos; const float* attn_norm; const float* w_in; const float* b_forget; const float* mla_q_norm; const float* w_q_up;
    const float* mla_kv_norm; const float* w_kv_up; const float* sinks; const float* w_out; const float* ffn_norm; const float* dense_w_gate; const float* dense_w_up;
    const float* dense_w_down; const float* router; const float* moe_w_gate; const float* moe_w_up; const float* moe_w_down; const float* final_norm;
    float* out; unsigned char* ws; int ph_lo, ph_hi;
};
struct Frame {
    LAS unsigned char* lds; int tid, lane, wave, G, c;
};

__device__ __forceinline__ int rope_perm(int j) { const int i = j & 15, t2 = j >> 4; return 8 * (i >> 2) + 4 * t2 + (i & 3); }
__device__ __forceinline__ int map_col(int kind, int n, float& sc) {
    sc = 1.0f;
    if (kind == 0) return n;
    if (kind == 1) {
        if (n < 256) { sc = C2_64; return Y_FQ + n; }
        if (n < 512) return Y_FK + (n - 256);
        if (n < 768) return Y_FV + (n - 512);
        if (n < 772) return Y_FF + (n - 768);
        if (n < 1028) { sc = C2_64; return Y_SQ + (n - 772); }
        if (n < 1156) return Y_SK + (n - 1028);
        if (n < 1284) return Y_SV + (n - 1156);
        if (n < 1540) return Y_CQ + (n - 1284);
        if (n < 1668) return Y_CKV + (n - 1540);
        if (n < 1700) return Y_KR + rope_perm(n - 1668);
        if (n < 1956) { sc = C2_64; return Y_DQ + (n - 1700); }
        if (n < 2212) return Y_DK + (n - 1956);
        if (n < 2468) return Y_DV + (n - 2212);
        return -1;
    }
    if (kind == 2) { sc = C2_96; const int h = n / 96, c = n % 96; return h * 96 + (c < 64 ? c : 64 + rope_perm(c - 64)); }
    if (kind == 3) return 256 * (n >> 7) + (n & 127);
    return 256 * (n >> 7) + 128 + (n & 127);
}
__device__ __forceinline__ void transpose_item(const float* W, int K, int N, bf16_t* WT, const float* gain, int kind, LAS float* scr, int item, int lane) {
    const int nblk = (N + 31) / 32, kb = item / nblk, nb = item % nblk, k0 = 64 * kb, n0 = 32 * nb;
    const int nn = n0 + (lane & 31);
#pragma unroll 8
    for (int i = 0; i < 32; ++i) { const int kk = 2 * i + (lane >> 5); scr[kk * 33 + (lane & 31)] = (nn < N) ? W[(size_t)(k0 + kk) * N + nn] : 0.f; }
    LDS_WAIT(); asm volatile("" ::: "memory");
    const int c = lane & 7;
    float gk[8];
#pragma unroll
    for (int e = 0; e < 8; ++e) gk[e] = gain ? gain[k0 + 8 * c + e] : 1.0f;
#pragma unroll
    for (int j = 0; j < 4; ++j) { const int n = (lane >> 3) + 8 * j; const LAS float* s = scr + (8 * c) * 33 + n;
        float sc; const int dr = (n0 + n < N) ? map_col(kind, n0 + n, sc) : -1;
        if (dr >= 0) {
            u32x4 o; o.x = cvtpk(s[0 * 33] * gk[0] * sc, s[1 * 33] * gk[1] * sc); o.y = cvtpk(s[2 * 33] * gk[2] * sc, s[3 * 33] * gk[3] * sc);
            o.z = cvtpk(s[4 * 33] * gk[4] * sc, s[5 * 33] * gk[5] * sc); o.w = cvtpk(s[6 * 33] * gk[6] * sc, s[7 * 33] * gk[7] * sc);
            *(u32x4*)(WT + (size_t)dr * K + k0 + 8 * c) = o; } }
    LDS_WAIT(); asm volatile("" ::: "memory");
}
__device__ __forceinline__ void sincos_acc(double a, float& s, float& c) {
    const double n = rint(a * 0.63661977236758134308);
    double r = fma(-n, 1.5707963267948966192, a); r = fma(-n, 6.123233995736766e-17, r);
    const int qd = (int)((long long)n & 3);
    const float x = (float)r, x2 = x * x;
    const float sp = x + x * x2 * (-1.6666667163e-1f + x2 * (8.3333337680e-3f + x2 * (-1.9841270114e-4f + x2 * 2.7557314297e-6f)));
    const float cp = 1.0f + x2 * (-0.5f + x2 * (4.1666667908e-2f + x2 * (-1.3888889225e-3f + x2 * 2.4801587642e-5f)));
    s = (qd == 0) ? sp : (qd == 1) ? cp : (qd == 2) ? -sp : -cp;
    c = (qd == 0) ? cp : (qd == 1) ? -sp : (qd == 2) ? -cp : sp;
}

constexpr int NPH = 19;
typedef __attribute__((address_space(4))) const Args* ArgsP;
__device__ __forceinline__ ArgsP get_args() { ArgsP p = (ArgsP)__builtin_amdgcn_kernarg_segment_ptr(); asm volatile("" : "+s"(p)); return p; }
#define WSP(T_, off) ((T_*)(ws + (off)))

#if MK_ONE_LAUNCH
#define GRID_BAR() do { bar.bar = (unsigned*)(get_args()->ws + WS_CTL) + CW_BAR; xcd_barrier(bar); } while (0)
#else
#define GRID_BAR() do { } while (0)
#endif
#ifndef PHMASK
#define PHMASK 0x7ffff
#endif
#define IN(k) ((((PHMASK) >> (k)) & 1) && lo <= (k) && (k) < hi)
#define SEAM(k) do { if (IN(k) && IN((k) + 1)) GRID_BAR(); } while (0)
#if PROBE_REP >= 0
#define PH_BEGIN(k) if (IN(k)) for (int rep_ = 0; rep_ < (((k) == PROBE_REP) ? 2 : 1); ++rep_) { if (rep_) GRID_BAR();
#define PH_END }
#else
#define PH_BEGIN(k) if (IN(k)) {
#define PH_END }
#endif
#ifndef P2MASK
#define P2MASK 15
#endif

template <int l>
__device__ __forceinline__ void layer_fwd(const Frame& F, const int lo, const int hi, XcdBarrier& bar) {
        constexpr int pb = 1 + 7 * l;
        PH_BEGIN(pb) {
            int cid = F.c, gsz = F.G; asm volatile("" : "+s"(cid), "+s"(gsz)); const int gw = cid * NWAVES + F.wave, NGW = gsz * NWAVES; (void)gw; (void)NGW;
            unsigned char* ws = get_args()->ws;
            pg8::Gemm g{WSP(bf16_t, WS_XB), WSP(bf16_t, WS_WIN) + (size_t)l * NY * D, D, D, D};
            pg8::SchedStatic S; S.o.init(T, NY, gsz, cid);
            pg8::EpiG1 E{WSP(bf16_t, WS_Y), l == 0 ? WSP(float, SM_RSTD0) : nullptr, WSP(float, SM_PART), WSP(float, SM_PARTQ), WSP(float, SM_PARTKV), WSP(float, SM_FF), WSP(bf16_t, WS_KM), WSP(float, SM_ROPE)};
            pg8::gemm_phase<pg8::EpiG1, pg8::SchedStatic, true>(F.lds, g, S, E);
        } PH_END
        SEAM(pb);
        PH_BEGIN(pb + 1) {
            int cid = F.c, gsz = F.G; asm volatile("" : "+s"(cid), "+s"(gsz)); const int gw = cid * NWAVES + F.wave, NGW = gsz * NWAVES; (void)gw; (void)NGW;
            if ((P2MASK & 1) && cid < 128) {
                unsigned char* ws = get_args()->ws;
                pg8::Gemm g{WSP(bf16_t, WS_Y) + Y_CQ, WSP(bf16_t, WS_WQUP) + (size_t)l * 512 * 256, NY, 256, 256};
                pg8::SchedOne S; S.has = true; S.un.pm = cid >> 1; S.un.pn = cid & 1; S.un.e = 0;
                pg8::EpiQup E{WSP(bf16_t, WS_QM), WSP(float, SM_PARTQ), WSP(float, SM_ROPE)};
                pg8::gemm_phase<pg8::EpiQup, pg8::SchedOne, false>(F.lds, g, S, E);
            } else if (P2MASK & 2) {
                unsigned char* ws = get_args()->ws;
                pg8::Gemm g{WSP(bf16_t, WS_Y) + Y_CKV, WSP(bf16_t, WS_WKVUP) + (size_t)l * 512 * 128, NY, 128, 128};
                pg8::SchedOne S; S.has = cid < 256; S.un.pm = (cid - 128) >> 1; S.un.pn = cid & 1; S.un.e = 0;
                pg8::EpiKVup E{WSP(bf16_t, WS_KM), WSP(bf16_t, WS_VM), WSP(float, SM_PARTKV)};
                pg8::gemm_phase<pg8::EpiKVup, pg8::SchedOne, false>(F.lds, g, S, E);
            }
            __syncthreads();
            if (P2MASK & 4) for (int sq = cid; sq < 8; sq += gsz) {
                ArgsP a = get_args(); unsigned char* ws = a->ws; const float* ffb = WSP(float, SM_FF); float* csl = WSP(float, SM_CSL);
                const int b = sq >> 2, h = sq & 3; const float bfv = a->b_forget[l * 4 + h];
                LAS double* sd = (LAS double*)F.lds;
                double loc[16]; double run = 0.0;
#pragma unroll
                for (int i = 0; i < 16; ++i) { const float z = ffb[(size_t)(b * SEQ + F.tid * 16 + i) * 4 + h] + bfv;
                    const float ls = fminf(z, 0.f) - log1pf(expf(-fabsf(z))); run += (double)ls; loc[i] = run; }
                double incl = run;
#pragma unroll
                for (int o = 1; o < 64; o <<= 1) { const double t = __shfl_up(incl, o); if (F.lane >= o) incl += t; }
                if (F.lane == 63) sd[F.wave] = incl;
                __syncthreads();
                double base = 0.0;
                for (int w = 0; w < F.wave; ++w) base += sd[w];
                const double excl = base + incl - run;
#pragma unroll
                for (int i = 0; i < 16; ++i) csl[(size_t)sq * SEQ + F.tid * 16 + i] = (float)((excl + loc[i]) * (double)LOG2E);
                __syncthreads();
            }
            {
                unsigned char* ws = get_args()->ws; const bf16_t* Y = WSP(bf16_t, WS_Y);
                float mq[2] = {0.f, 0.f}, mk[2] = {0.f, 0.f};
                for (int m = gw; m < T; m += NGW) {
                    const u32x2 qv = *(const u32x2*)(Y + (size_t)m * NY + Y_FQ + 4 * F.lane), kv = *(const u32x2*)(Y + (size_t)m * NY + Y_FK + 4 * F.lane);
                    float a0 = __uint_as_float(qv.x << 16), a1 = __uint_as_float(qv.x & 0xffff0000u), a2 = __uint_as_float(qv.y << 16), a3 = __uint_as_float(qv.y & 0xffff0000u);
                    float b0 = __uint_as_float(kv.x << 16), b1 = __uint_as_float(kv.x & 0xffff0000u), b2 = __uint_as_float(kv.y << 16), b3 = __uint_as_float(kv.y & 0xffff0000u);
                    float sq = (a0 * a0 + a1 * a1) + (a2 * a2 + a3 * a3), sk = (b0 * b0 + b1 * b1) + (b2 * b2 + b3 * b3);
#pragma unroll
                    for (int o = 1; o < 16; o <<= 1) { sq += __shfl_xor(sq, o); sk += __shfl_xor(sk, o); }
                    const int bb = m >= SEQ ? 1 : 0;
                    mq[0] = fmaxf(mq[0], bb ? 0.f : sq); mq[1] = fmaxf(mq[1], bb ? sq : 0.f); mk[0] = fmaxf(mk[0], bb ? 0.f : sk); mk[1] = fmaxf(mk[1], bb ? sk : 0.f);
                }
                LAS float* red = (LAS float*)F.lds;
                if ((F.lane & 15) == 0) { const int h = F.lane >> 4; LAS float* r = red + (F.wave * 4 + h) * 4; r[0] = mq[0]; r[1] = mk[0]; r[2] = mq[1]; r[3] = mk[1]; }
                __syncthreads();
                if (F.tid < 16) { const int h = F.tid >> 2, j = F.tid & 3; float v = 0.f;
                    for (int w = 0; w < 8; ++w) v = fmaxf(v, red[(w * 4 + h) * 4 + j]);
                    const int b = j >> 1, qk = j & 1;
                    atomicMax((unsigned*)((gu32*)(ws + WS_CTL) + CW_FMAX + ((l * 8 + b * 4 + h) * 2 + qk)), __float_as_uint(v)); }
                __syncthreads();
            }
            if (P2MASK & 8) for (int idx = cid; idx < 1024; idx += gsz) {
                ArgsP a = get_args(); unsigned char* ws = a->ws; const bf16_t* Y = WSP(bf16_t, WS_Y);
                att::AU u;
                if (idx < 256) {
                    const int b = idx >> 7, hq = (idx >> 5) & 3, qb = idx & 31;
                    const bf16_t* yb = Y + (size_t)b * SEQ * NY;
                    u.Q = yb + Y_SQ + hq * 64; u.K = yb + Y_SK + (hq >> 1) * 64; u.V = yb + Y_SV + (hq >> 1) * 64; u.qpitch = u.kpitch = u.vpitch = NY;
                    u.O = WSP(bf16_t, WS_MIX) + (size_t)b * SEQ * D + 256 + hq * 64; u.opitch = D; u.lse = nullptr; u.lpitch = 0; u.colb = nullptr;
                    u.q0 = qb * 256; u.span = 127; u.alibi = exp2f(-(float)(hq + 1)) * LOG2E; u.sink2 = a->sinks[l * 4 + hq] * LOG2E;
                } else {
                    const int p = (idx - 256) >> 8, rem = (idx - 256) & 255, b = rem >> 7, h = (rem >> 5) & 3, j = rem & 31;
                    const int dil = (p == 0) ? 1 : (p == 1) ? 4 : 16, nqb = (SEQ / dil) / 256, r = j / nqb, qb = j % nqb;
                    const bf16_t* yb = Y + (size_t)(b * SEQ + r) * NY;
                    u.Q = yb + Y_DQ + h * 64; u.K = yb + Y_DK + h * 64; u.V = yb + Y_DV + h * 64; u.qpitch = u.kpitch = u.vpitch = dil * NY;
                    u.O = WSP(bf16_t, WS_DP) + (size_t)p * T * 256 + (size_t)(b * SEQ + r) * 256 + h * 64; u.opitch = dil * 256;
                    u.lse = WSP(float, WS_DL) + (size_t)p * T * 4 + (size_t)(b * SEQ + r) * 4 + h; u.lpitch = dil * 4; u.colb = nullptr;
                    u.q0 = qb * 256; u.span = 128; u.alibi = exp2f(-(float)(h + 5)) * (float)dil * LOG2E; u.sink2 = -INFINITY;
                }
                u.kt0 = u.q0 / 64 - 2; if (u.kt0 < 0) u.kt0 = 0; u.kt1 = u.q0 / 64 + 4;
                att::attn_unit<4, 2, 6>(u, F.lds);
            }
        } PH_END
        SEAM(pb + 1);
        PH_BEGIN(pb + 2) {
            int cid = F.c, gsz = F.G; asm volatile("" : "+s"(cid), "+s"(gsz)); const int gw = cid * NWAVES + F.wave, NGW = gsz * NWAVES; (void)gw; (void)NGW;
            LAS unsigned* qslot = (LAS unsigned*)(F.lds + LDSCTL_OFF + 64);
            for (;;) {
                unsigned char* ws = get_args()->ws;
#if PROBE_REP >= 0
                const int qrep = rep_;
#else
                const int qrep = 0;
#endif
                if (F.tid == 0) *qslot = __hip_atomic_fetch_add((gu32*)(ws + WS_CTL) + CW_QUEUE + 64 * (l + 2 * qrep), 1u, RLX_AGENT);
                __syncthreads();
                const int idx = (int)*qslot;
                __syncthreads();
                if (idx >= 896) break;
                att::AU u; u.span = 1 << 30; u.alibi = 0.f; u.sink2 = -INFINITY; u.xthr = 0.f;
                if (idx < 640) {
                    int bh, qb, c;
                    if (idx < 192) { bh = idx & 7; const int r = idx >> 3; c = r % 3; qb = 24 + r / 3; }
                    else if (idx < 320) { const int n = idx - 192; bh = n & 7; const int r = n >> 3; c = r & 1; qb = 16 + (r >> 1); }
                    else if (idx < 384) { const int n = idx - 320; bh = n & 7; qb = 8 + (n >> 3); c = 0; }
                    else { const int n = idx - 384, sz = n >> 5, m = n & 31; bh = m & 7; c = m >> 3; qb = 8 * c + (7 - sz); }
                    const int b = bh >> 2, h = bh & 3;
                    u.q0 = qb * 256; u.kt0 = 32 * c; u.kt1 = 4 * qb + 4 < 32 * c + 32 ? 4 * qb + 4 : 32 * c + 32;
                    u.Q = WSP(bf16_t, WS_QM) + (size_t)b * SEQ * 384 + h * 96; u.K = WSP(bf16_t, WS_KM) + (size_t)b * SEQ * 384 + h * 96; u.V = WSP(bf16_t, WS_VM) + (size_t)b * SEQ * 256 + h * 64;
                    u.qpitch = 384; u.kpitch = 384; u.vpitch = 256; u.colb = nullptr;
                    u.O = WSP(bf16_t, WS_MP) + (size_t)c * T * 256 + (size_t)b * SEQ * 256 + h * 64; u.opitch = 256;
                    u.lse = WSP(float, WS_ML) + (size_t)c * T * 4 + (size_t)b * SEQ * 4 + h; u.lpitch = 4;
                    att::attn_unit<6, 0, 6>(u, F.lds);
                } else {
                    const int n = idx - 640, qb = 31 - (n >> 3), bh = n & 7, b = bh >> 2, h = bh & 3;
                    const bf16_t* yb = WSP(bf16_t, WS_Y) + (size_t)b * SEQ * NY;
                    u.lse = nullptr; u.lpitch = 0; u.q0 = qb * 256; u.kt0 = 0; u.kt1 = 4 * qb + 4; u.opitch = D;
                    u.Q = yb + Y_FQ + h * 64; u.K = yb + Y_FK + h * 64; u.V = yb + Y_FV + h * 64; u.qpitch = u.kpitch = u.vpitch = NY;
                    u.O = WSP(bf16_t, WS_MIX) + (size_t)b * SEQ * D + h * 64; u.colb = WSP(float, SM_CSL) + (size_t)bh * SEQ;
                    const gu32* fm = (const gu32*)(ws + WS_CTL) + CW_FMAX + (l * 8 + bh) * 2;
                    u.xthr = FOX_THRESH + 2.0f * sqrtf(__uint_as_float(fm[0]) * __uint_as_float(fm[1])) * 1.0001f + 1.0f;
                    att::attn_unit<4, 1, 5>(u, F.lds);
                }
            }
        } PH_END
        SEAM(pb + 2);
        PH_BEGIN(pb + 3) {
            int cid = F.c, gsz = F.G; asm volatile("" : "+s"(cid), "+s"(gsz)); const int gw = cid * NWAVES + F.wave, NGW = gsz * NWAVES; (void)gw; (void)NGW;
            unsigned char* ws = get_args()->ws;
            const bf16_t* Dp = WSP(bf16_t, WS_DP); const float* Dl = WSP(float, WS_DL); const bf16_t* Mp = WSP(bf16_t, WS_MP); const float* Ml = WSP(float, WS_ML); bf16_t* MIX = WSP(bf16_t, WS_MIX);
            for (int blk = cid; blk < T / 64; blk += gsz) {
                const int t = blk * 64 + (F.tid >> 3), dc = F.tid & 7;
                const int np = (((t & (SEQ - 1)) >> 8) >> 3) + 1;
#pragma unroll
                for (int h = 0; h < 4; ++h) {
                    {
                        const float l0 = Dl[(size_t)t * 4 + h], l1 = Dl[(size_t)(T + t) * 4 + h], l2 = Dl[(size_t)(2 * T + t) * 4 + h];
                        const float mx = fmaxf(l0, fmaxf(l1, l2));
                        float w0 = __builtin_amdgcn_exp2f(l0 - mx), w1 = __builtin_amdgcn_exp2f(l1 - mx), w2 = __builtin_amdgcn_exp2f(l2 - mx);
                        const float inv = 1.0f / (w0 + w1 + w2); w0 *= inv; w1 *= inv; w2 *= inv;
                        const u32x4 a0 = *(const u32x4*)(Dp + (size_t)t * 256 + h * 64 + dc * 8), a1 = *(const u32x4*)(Dp + (size_t)(T + t) * 256 + h * 64 + dc * 8),
                                    a2 = *(const u32x4*)(Dp + (size_t)(2 * T + t) * 256 + h * 64 + dc * 8);
                        u32x4 o;
#pragma unroll
                        for (int e = 0; e < 4; ++e) {
                            const float lo_ = w0 * __uint_as_float(a0[e] << 16) + w1 * __uint_as_float(a1[e] << 16) + w2 * __uint_as_float(a2[e] << 16);
                            const float hi_ = w0 * __uint_as_float(a0[e] & 0xffff0000u) + w1 * __uint_as_float(a1[e] & 0xffff0000u) + w2 * __uint_as_float(a2[e] & 0xffff0000u);
                            o[e] = cvtpk(lo_, hi_);
                        }
                        *(u32x4*)(MIX + (size_t)t * D + 768 + h * 64 + dc * 8) = o;
                    }
                    {
                        float lw[4]; float mx = -INFINITY;
#pragma unroll
                        for (int p = 0; p < 4; ++p) { lw[p] = (p < np) ? Ml[(size_t)(p * T + t) * 4 + h] : -INFINITY; mx = fmaxf(mx, lw[p]); }
                        float sw = 0.f;
#pragma unroll
                        for (int p = 0; p < 4; ++p) { lw[p] = __builtin_amdgcn_exp2f(lw[p] - mx); sw += lw[p]; }
                        const float inv = 1.0f / sw;
                        float acc[8] = {0.f, 0.f, 0.f, 0.f, 0.f, 0.f, 0.f, 0.f};
#pragma unroll
                        for (int p = 0; p < 4; ++p) if (p < np) {
                            const u32x4 av = *(const u32x4*)(Mp + (size_t)(p * T + t) * 256 + h * 64 + dc * 8); const float w = lw[p] * inv;
#pragma unroll
                            for (int e = 0; e < 4; ++e) { acc[2 * e] += w * __uint_as_float(av[e] << 16); acc[2 * e + 1] += w * __uint_as_float(av[e] & 0xffff0000u); }
                        }
                        u32x4 o; o.x = cvtpk(acc[0], acc[1]); o.y = cvtpk(acc[2], acc[3]); o.z = cvtpk(acc[4], acc[5]); o.w = cvtpk(acc[6], acc[7]);
                        *(u32x4*)(MIX + (size_t)t * D + 512 + h * 64 + dc * 8) = o;
                    }
                }
            }
        } PH_END
        SEAM(pb + 3);
        PH_BEGIN(pb + 4) {
            int cid = F.c, gsz = F.G; asm volatile("" : "+s"(cid), "+s"(gsz)); const int gw = cid * NWAVES + F.wave, NGW = gsz * NWAVES; (void)gw; (void)NGW;
            ArgsP a = get_args(); unsigned char* ws = a->ws;
            pg8::Gemm g{WSP(bf16_t, WS_MIX), WSP(bf16_t, WS_WOUT) + (size_t)l * D * D, D, D, D};
            pg8::SchedStatic S; S.o.init(T, D, gsz, cid);
            pg8::EpiRes E{l == 0 ? a->x : a->out, a->out, l == 0 ? WSP(bf16_t, WS_XB) : nullptr, WSP(float, SM_PART)};
            pg8::gemm_phase<pg8::EpiRes, pg8::SchedStatic, true>(F.lds, g, S, E);
        } PH_END
        SEAM(pb + 4);
        if (l == 0) {
            PH_BEGIN(6) {
            int cid = F.c, gsz = F.G; asm volatile("" : "+s"(cid), "+s"(gsz)); const int gw = cid * NWAVES + F.wave, NGW = gsz * NWAVES; (void)gw; (void)NGW;
                unsigned char* ws = get_args()->ws;
                pg8::Gemm g{WSP(bf16_t, WS_XB), WSP(bf16_t, WS_WGU0), D, D, D};
                pg8::SchedStatic S; S.o.init(T, 2 * FF, gsz, cid);
                pg8::EpiSwiglu E{WSP(bf16_t, WS_HID), nullptr, WSP(float, SM_PART)};
                pg8::gemm_phase<pg8::EpiSwiglu, pg8::SchedStatic, true>(F.lds, g, S, E);
            } PH_END
            SEAM(6);
            PH_BEGIN(7) {
            int cid = F.c, gsz = F.G; asm volatile("" : "+s"(cid), "+s"(gsz)); const int gw = cid * NWAVES + F.wave, NGW = gsz * NWAVES; (void)gw; (void)NGW;
                ArgsP a = get_args(); unsigned char* ws = a->ws;
                pg8::Gemm g{WSP(bf16_t, WS_HID), WSP(bf16_t, WS_WD0), FF, FF, FF};
                pg8::SchedStatic S; S.o.init(T, D, gsz, cid);
                pg8::EpiRes E{a->out, a->out, WSP(bf16_t, WS_XB), WSP(float, SM_PART)};
                pg8::gemm_phase<pg8::EpiRes, pg8::SchedStatic, true>(F.lds, g, S, E);
            } PH_END
            SEAM(7);
        }
}

__global__ void __launch_bounds__(NWAVES * 64, 2) mega_fwd(Args a_unused) {
    extern __shared__ __attribute__((aligned(16))) unsigned char lds_raw[];
    Frame F;
    F.lds = (LAS unsigned char*)lds_raw;
    F.tid = threadIdx.x; F.lane = F.tid & 63; F.wave = __builtin_amdgcn_readfirstlane(F.tid >> 6);
    F.G = gridDim.x; F.c = blockIdx.x;
    volatile LAS unsigned* MISC = (volatile LAS unsigned*)(F.lds + MISC_OFF);
    for (int u = F.tid; u < (LDS_BYTES - LDSCTL_OFF) / 4; u += NWAVES * 64) ((LAS unsigned*)(F.lds + LDSCTL_OFF))[u] = 0u;
    __syncthreads();
#if MK_ONE_LAUNCH
    XcdBarrier bar = xcd_barrier_post((unsigned*)(get_args()->ws + WS_CTL) + CW_BAR, MISC + 8);
#else
    XcdBarrier bar; bar.bar = nullptr; bar.x = 0; bar.st = MISC + 8;
#endif
    const int lo = get_args()->ph_lo, hi = get_args()->ph_hi;

    PH_BEGIN(0) {
            int cid = F.c, gsz = F.G; asm volatile("" : "+s"(cid), "+s"(gsz)); const int gw = cid * NWAVES + F.wave, NGW = gsz * NWAVES; (void)gw; (void)NGW;
        ArgsP a = get_args(); unsigned char* ws = a->ws;
        LAS float* scr = (LAS float*)(F.lds + F.wave * 16384);
        bf16_t* Win_t = WSP(bf16_t, WS_WIN); bf16_t* Wqup_t = WSP(bf16_t, WS_WQUP); bf16_t* Wkvup_t = WSP(bf16_t, WS_WKVUP); bf16_t* Wout_t = WSP(bf16_t, WS_WOUT);
        bf16_t* Wgu0_t = WSP(bf16_t, WS_WGU0); bf16_t* Wd0_t = WSP(bf16_t, WS_WD0); bf16_t* Wgu1_t = WSP(bf16_t, WS_WGU1);
        constexpr int I_IN = 16 * 78, I_QU = 4 * 12, I_KV = 2 * 16, I_WO = 16 * 32, I_GU = 16 * 112, I_DN = 56 * 32;
        constexpr int NIT = 2 * I_IN + 2 * I_QU + 2 * I_KV + 2 * I_WO + 2 * I_GU + I_DN + 16 * I_GU;
        for (int it = gw; it < NIT; it += NGW) {
            int r = it;
            if (r < 2 * I_IN) { const int l = r / I_IN; transpose_item(a->w_in + (size_t)l * D * NIN, D, NIN, Win_t + (size_t)l * NY * D, a->attn_norm + l * D, 1, scr, r % I_IN, F.lane); continue; } r -= 2 * I_IN;
            if (r < 2 * I_QU) { const int l = r / I_QU; transpose_item(a->w_q_up + (size_t)l * 256 * 384, 256, 384, Wqup_t + (size_t)l * 512 * 256, a->mla_q_norm + l * 256, 2, scr, r % I_QU, F.lane); continue; } r -= 2 * I_QU;
            if (r < 2 * I_KV) { const int l = r / I_KV; transpose_item(a->w_kv_up + (size_t)l * 128 * 512, 128, 512, Wkvup_t + (size_t)l * 512 * 128, a->mla_kv_norm + l * 128, 0, scr, r % I_KV, F.lane); continue; } r -= 2 * I_KV;
            if (r < 2 * I_WO) { const int l = r / I_WO; transpose_item(a->w_out + (size_t)l * D * D, D, D, Wout_t + (size_t)l * D * D, nullptr, 0, scr, r % I_WO, F.lane); continue; } r -= 2 * I_WO;
            if (r < I_GU) { transpose_item(a->dense_w_gate, D, FF, Wgu0_t, a->ffn_norm, 3, scr, r, F.lane); continue; } r -= I_GU;
            if (r < I_GU) { transpose_item(a->dense_w_up, D, FF, Wgu0_t, a->ffn_norm, 4, scr, r, F.lane); continue; } r -= I_GU;
            if (r < I_DN) { transpose_item(a->dense_w_down, FF, D, Wd0_t, nullptr, 0, scr, r, F.lane); continue; } r -= I_DN;
            if (r < 8 * I_GU) { const int e = r / I_GU; transpose_item(a->moe_w_gate + (size_t)e * D * FF, D, FF, Wgu1_t + (size_t)e * 2 * FF * D, a->ffn_norm + D, 3, scr, r % I_GU, F.lane); continue; } r -= 8 * I_GU;
            { const int e = r / I_GU; transpose_item(a->moe_w_up + (size_t)e * D * FF, D, FF, Wgu1_t + (size_t)e * 2 * FF * D, a->ffn_norm + D, 4, scr, r % I_GU, F.lane); }
        }
        const float* x = a->x; const int* pos = a->pos; bf16_t* XB = WSP(bf16_t, WS_XB); float* rstd0 = WSP(float, SM_RSTD0); float* rope = WSP(float, SM_ROPE);
        for (int m = gw; m < T; m += NGW) {
            const f32x4* xr = (const f32x4*)(x + (size_t)m * D) + F.lane;
            f32x4 v[4]; float s = 0.f;
#pragma unroll
            for (int j = 0; j < 4; ++j) { v[j] = xr[64 * j]; s += (v[j][0] * v[j][0] + v[j][1] * v[j][1]) + (v[j][2] * v[j][2] + v[j][3] * v[j][3]); }
            s = wave_sum(s);
            u32x2* o8 = (u32x2*)(XB + (size_t)m * D) + F.lane;
#pragma unroll
            for (int j = 0; j < 4; ++j) { u32x2 w; w.x = cvtpk(v[j][0], v[j][1]); w.y = cvtpk(v[j][2], v[j][3]); o8[64 * j] = w; }
            if (F.lane == 0) rstd0[m] = 1.0f / sqrtf(s * (1.0f / D) + EPS);
            if (F.lane < 16) {
                const float invf = powf(10000.0f, -(float)F.lane / 16.0f);
                const float ang = (float)pos[m] * invf;
                float sn, cs; sincos_acc((double)ang, sn, cs);
                *(f32x2*)(rope + (size_t)m * 32 + 2 * F.lane) = (f32x2){cs, sn};
            }
        }
    } PH_END
    SEAM(0);

    layer_fwd<0>(F, lo, hi, bar);
    layer_fwd<1>(F, lo, hi, bar);
    PH_BEGIN(13) {
            int cid = F.c, gsz = F.G; asm volatile("" : "+s"(cid), "+s"(gsz)); const int gw = cid * NWAVES + F.wave, NGW = gsz * NWAVES; (void)gw; (void)NGW;
        ArgsP a = get_args(); unsigned char* ws = a->ws; const float* xres = a->out;
        int* tok_e = WSP(int, SM_TOKE); float* tok_g = WSP(float, SM_TOKG); float* rstd_tok = WSP(float, SM_RSTDT); int* histg = WSP(int, SM_HIST);
        LAS float* Rg = (LAS float*)F.lds;
        LAS int* hist = (LAS int*)(F.lds + 32768);
        for (int i = F.tid; i < D * 8; i += 512) Rg[i] = a->router[i] * a->ffn_norm[D + (i >> 3)];
        for (int ch = cid; ch < 256; ch += gsz) {
            if (F.tid < 8) hist[F.tid] = 0;
            __syncthreads();
            for (int j = 0; j < 8; ++j) {
                const int t = ch * 64 + F.wave * 8 + j;
                const f32x4* xr = (const f32x4*)(xres + (size_t)t * D) + F.lane;
                float acc[8] = {0.f, 0.f, 0.f, 0.f, 0.f, 0.f, 0.f, 0.f}; float ss = 0.f;
#pragma unroll
                for (int jj = 0; jj < 4; ++jj) { const f32x4 v = xr[64 * jj];
#pragma unroll
                    for (int e4 = 0; e4 < 4; ++e4) { const int k = 4 * F.lane + 256 * jj + e4; const float xv = v[e4]; ss += xv * xv;
                        const f32x4 r0 = *(const LAS f32x4*)(Rg + k * 8), r1 = *(const LAS f32x4*)(Rg + k * 8 + 4);
#pragma unroll
                        for (int e = 0; e < 4; ++e) { acc[e] += xv * r0[e]; acc[4 + e] += xv * r1[e]; } } }
                ss = wave_sum(ss);
#pragma unroll
                for (int e = 0; e < 8; ++e) acc[e] = wave_sum(acc[e]);
                const float rs = 1.0f / sqrtf(ss * (1.0f / D) + EPS);
                float v1 = -INFINITY; int e1 = 0;
#pragma unroll
                for (int e = 0; e < 8; ++e) { const float lg = acc[e] * rs; if (lg > v1) { v1 = lg; e1 = e; } }
                float v2 = -INFINITY; int e2 = 0;
#pragma unroll
                for (int e = 0; e < 8; ++e) { const float lg = acc[e] * rs; if (e != e1 && lg > v2) { v2 = lg; e2 = e; } }
                const float g1 = 1.0f / (1.0f + expf(v2 - v1));
                if (F.lane == 0) { tok_e[2 * t] = e1; tok_e[2 * t + 1] = e2; tok_g[2 * t] = g1; tok_g[2 * t + 1] = 1.0f - g1; rstd_tok[t] = rs;
                    atomicAdd((int*)&hist[e1], 1); atomicAdd((int*)&hist[e2], 1); }
            }
            __syncthreads();
            if (F.tid < 8) histg[ch * 8 + F.tid] = hist[F.tid];
            __syncthreads();
        }
    } PH_END
    SEAM(13);
    PH_BEGIN(14) {
            int cid = F.c, gsz = F.G; asm volatile("" : "+s"(cid), "+s"(gsz)); const int gw = cid * NWAVES + F.wave, NGW = gsz * NWAVES; (void)gw; (void)NGW;
        ArgsP a = get_args(); unsigned char* ws = a->ws; const float* xres = a->out;
        const int* tok_e = WSP(int, SM_TOKE); const float* rstd_tok = WSP(float, SM_RSTDT); const int* histg = WSP(int, SM_HIST);
        int* slot = WSP(int, SM_SLOT); float* rstdg = WSP(float, SM_RSTDG); int* moetab = WSP(int, SM_MOETAB); bf16_t* XG = WSP(bf16_t, WS_XG);
        LAS int* tot = (LAS int*)F.lds; LAS int* pre = tot + 8; LAS int* rows = tot + 16;
        for (int ch = cid; ch < 256; ch += gsz) {
            if (F.tid < 16) tot[F.tid] = 0;
            __syncthreads();
            { const int cch = F.tid >> 1, e0 = (F.tid & 1) * 4;
#pragma unroll
              for (int e = 0; e < 4; ++e) { const int v = histg[cch * 8 + e0 + e]; atomicAdd((int*)&tot[e0 + e], v); if (cch < ch) atomicAdd((int*)&pre[e0 + e], v); } }
            __syncthreads();
            int tbase[9]; tbase[0] = 0;
#pragma unroll
            for (int e = 0; e < 8; ++e) tbase[e + 1] = tbase[e] + (tot[e] + 255) / 256;
            if (ch == 0 && F.tid == 0) {
#pragma unroll
                for (int e = 0; e < 9; ++e) moetab[e] = tbase[e];
            }
            if (F.wave == 0) {
                const int t = ch * 64 + F.lane; const int e1 = tok_e[2 * t], e2 = tok_e[2 * t + 1];
                int r1 = 0, r2 = 0;
#pragma unroll
                for (int e = 0; e < 8; ++e) {
                    const unsigned long long mk = __ballot(e1 == e || e2 == e);
                    const int rank = __popcll(mk & ((1ull << F.lane) - 1ull));
                    const int row = tbase[e] * 256 + pre[e] + rank;
                    if (e1 == e) r1 = row; if (e2 == e) r2 = row;
                }
                slot[2 * t] = r1; slot[2 * t + 1] = r2; rows[2 * F.lane] = r1; rows[2 * F.lane + 1] = r2;
                const float rs = rstd_tok[t]; rstdg[r1] = rs; rstdg[r2] = rs;
            }
            __syncthreads();
            for (int j = 0; j < 8; ++j) {
                const int tl = F.wave * 8 + j, t = ch * 64 + tl; const int r1 = rows[2 * tl], r2 = rows[2 * tl + 1];
                const f32x4* xr = (const f32x4*)(xres + (size_t)t * D) + F.lane;
                u32x2* o1 = (u32x2*)(XG + (size_t)r1 * D) + F.lane; u32x2* o2 = (u32x2*)(XG + (size_t)r2 * D) + F.lane;
#pragma unroll
                for (int jj = 0; jj < 4; ++jj) { const f32x4 v = xr[64 * jj]; u32x2 w; w.x = cvtpk(v[0], v[1]); w.y = cvtpk(v[2], v[3]); o1[64 * jj] = w; o2[64 * jj] = w; }
            }
            __syncthreads();
        }
    } PH_END
    SEAM(14);
    PH_BEGIN(15) {
            int cid = F.c, gsz = F.G; asm volatile("" : "+s"(cid), "+s"(gsz)); const int gw = cid * NWAVES + F.wave, NGW = gsz * NWAVES; (void)gw; (void)NGW;
        unsigned char* ws = get_args()->ws; const int* moetab = WSP(int, SM_MOETAB);
        pg8::Gemm g{WSP(bf16_t, WS_XG), WSP(bf16_t, WS_WGU1), D, D, D};
        pg8::SchedMoe S;
#pragma unroll
        for (int e = 0; e < 9; ++e) S.tb[e] = __builtin_amdgcn_readfirstlane(moetab[e]);
        S.o.init(S.tb[8] * 256, 2 * FF, gsz, cid); S.estride = (size_t)2 * FF * D * 2;
        pg8::EpiSwiglu E{WSP(bf16_t, WS_HG), WSP(float, SM_RSTDG), nullptr};
        pg8::gemm_phase<pg8::EpiSwiglu, pg8::SchedMoe, true>(F.lds, g, S, E);
    } PH_END
    SEAM(15);
    PH_BEGIN(16) {
            int cid = F.c, gsz = F.G; asm volatile("" : "+s"(cid), "+s"(gsz)); const int gw = cid * NWAVES + F.wave, NGW = gsz * NWAVES; (void)gw; (void)NGW;
        ArgsP a = get_args(); unsigned char* ws = a->ws;
        LAS float* scr = (LAS float*)(F.lds + F.wave * 16384);
        constexpr int I_DN = 56 * 32;
        for (int it = gw; it < 8 * I_DN; it += NGW) { const int e = it / I_DN; transpose_item(a->moe_w_down + (size_t)e * FF * D, FF, D, WSP(bf16_t, WS_WD1) + (size_t)e * D * FF, nullptr, 0, scr, it % I_DN, F.lane); }
    } PH_END
    SEAM(16);
    PH_BEGIN(17) {
            int cid = F.c, gsz = F.G; asm volatile("" : "+s"(cid), "+s"(gsz)); const int gw = cid * NWAVES + F.wave, NGW = gsz * NWAVES; (void)gw; (void)NGW;
        unsigned char* ws = get_args()->ws; const int* moetab = WSP(int, SM_MOETAB);
        pg8::Gemm g{WSP(bf16_t, WS_HG), WSP(bf16_t, WS_WD1), FF, FF, FF};
        pg8::SchedMoe S;
#pragma unroll
        for (int e = 0; e < 9; ++e) S.tb[e] = __builtin_amdgcn_readfirstlane(moetab[e]);
        S.o.init(S.tb[8] * 256, D, gsz, cid); S.estride = (size_t)D * FF * 2;
        pg8::EpiY E{WSP(bf16_t, WS_XG)};
        pg8::gemm_phase<pg8::EpiY, pg8::SchedMoe, true>(F.lds, g, S, E);
    } PH_END
    SEAM(17);
    PH_BEGIN(18) {
            int cid = F.c, gsz = F.G; asm volatile("" : "+s"(cid), "+s"(gsz)); const int gw = cid * NWAVES + F.wave, NGW = gsz * NWAVES; (void)gw; (void)NGW;
        ArgsP a = get_args(); unsigned char* ws = a->ws; float* out = a->out; const float* fn = a->final_norm;
        const int* slot = WSP(int, SM_SLOT); const float* tok_g = WSP(float, SM_TOKG); const bf16_t* YG = WSP(bf16_t, WS_XG);
        for (int t = gw; t < T; t += NGW) {
            const f32x4* xr = (const f32x4*)(out + (size_t)t * D) + F.lane;
            const int r1 = slot[2 * t], r2 = slot[2 * t + 1]; const float g1 = tok_g[2 * t], g2 = tok_g[2 * t + 1];
            const u32x2* y1 = (const u32x2*)(YG + (size_t)r1 * D) + F.lane; const u32x2* y2 = (const u32x2*)(YG + (size_t)r2 * D) + F.lane;
            f32x4 v[4]; float s = 0.f;
#pragma unroll
            for (int j = 0; j < 4; ++j) { v[j] = xr[64 * j]; const u32x2 p = y1[64 * j], q = y2[64 * j];
                v[j][0] += g1 * __uint_as_float(p.x << 16) + g2 * __uint_as_float(q.x << 16);
                v[j][1] += g1 * __uint_as_float(p.x & 0xffff0000u) + g2 * __uint_as_float(q.x & 0xffff0000u);
                v[j][2] += g1 * __uint_as_float(p.y << 16) + g2 * __uint_as_float(q.y << 16);
                v[j][3] += g1 * __uint_as_float(p.y & 0xffff0000u) + g2 * __uint_as_float(q.y & 0xffff0000u);
                s += (v[j][0] * v[j][0] + v[j][1] * v[j][1]) + (v[j][2] * v[j][2] + v[j][3] * v[j][3]); }
            s = wave_sum(s);
            const float rs = 1.0f / sqrtf(s * (1.0f / D) + EPS);
            f32x4* o = (f32x4*)(out + (size_t)t * D) + F.lane; const f32x4* gn = (const f32x4*)fn + F.lane;
#pragma unroll
            for (int j = 0; j < 4; ++j) o[64 * j] = v[j] * rs * gn[64 * j];
        }
    } PH_END
#undef IN
#undef SEAM
}

extern "C" void kernel_launch(void* const* d_in, const int* in_sizes, int n_in, void* d_out, int out_size, void* d_ws, size_t ws_size, hipStream_t stream) {
    static int grid = 0;
    if (grid == 0) {
        int dev = 0, cus = 0;
        if (n_in != 20 || ws_size < WS_END) { fprintf(stderr, "kernel_launch: unexpected inputs (n_in %d, ws %zu)\n", n_in, ws_size); grid = -1; return; }
        if (hipGetDevice(&dev) != hipSuccess || hipDeviceGetAttribute(&cus, hipDeviceAttributeMultiprocessorCount, dev) != hipSuccess) { grid = -1; return; }
        if (hipFuncSetAttribute((const void*)mega_fwd, hipFuncAttributeMaxDynamicSharedMemorySize, LDS_BYTES) != hipSuccess) { grid = -1; return; }
        int per_cu = 0;
        (void)hipOccupancyMaxActiveBlocksPerMultiprocessor(&per_cu, (const void*)mega_fwd, NWAVES * 64, LDS_BYTES);
        (void)hipGetLastError();
        grid = cus;
    }
    if (grid < 0) return;
    (void)hipMemsetAsync((char*)d_ws + WS_CTL, 0, CTL_ZERO_BYTES, stream);
    Args a{};
    a.x = (const float*)d_in[0]; a.pos = (const int*)d_in[1]; a.attn_norm = (const float*)d_in[2]; a.w_in = (const float*)d_in[3]; a.b_forget = (const float*)d_in[4];
    a.mla_q_norm = (const float*)d_in[5]; a.w_q_up = (const float*)d_in[6]; a.mla_kv_norm = (const float*)d_in[7]; a.w_kv_up = (const float*)d_in[8]; a.sinks = (const float*)d_in[9];
    a.w_out = (const float*)d_in[10]; a.ffn_norm = (const float*)d_in[11]; a.dense_w_gate = (const float*)d_in[12]; a.dense_w_up = (const float*)d_in[13]; a.dense_w_down = (const float*)d_in[14];
    a.router = (const float*)d_in[15]; a.moe_w_gate = (const float*)d_in[16]; a.moe_w_up = (const float*)d_in[17]; a.moe_w_down = (const float*)d_in[18]; a.final_norm = (const float*)d_in[19];
    a.out = (float*)d_out; a.ws = (unsigned char*)d_ws;
#if MK_ONE_LAUNCH
    a.ph_lo = 0; a.ph_hi = NPH;
    hipLaunchKernelGGL(mega_fwd, dim3(grid), dim3(NWAVES * 64), LDS_BYTES, stream, a);
#else
    for (int p = 0; p < NPH; ++p) { a.ph_lo = p; a.ph_hi = p + 1; hipLaunchKernelGGL(mega_fwd, dim3(grid), dim3(NWAVES * 64), LDS_BYTES, stream, a); }
#endif
}
```

```cpp
#include <hip/hip_runtime.h>
#include <cstdio>
#include <cstdint>

#ifndef PROBE_REP
#define PROBE_REP -1
#endif
#ifndef MK_ONE_LAUNCH
#define MK_ONE_LAUNCH 1
#endif

#define GAS __attribute__((address_space(1)))
#define LAS __attribute__((address_space(3)))
typedef unsigned short bf16_t;
typedef short bf16x8 __attribute__((ext_vector_type(8)));
typedef short s16x4 __attribute__((ext_vector_type(4)));
typedef float f32x2 __attribute__((ext_vector_type(2)));
typedef float f32x4 __attribute__((ext_vector_type(4)));
typedef float f32x16 __attribute__((ext_vector_type(16)));
typedef unsigned u32x2 __attribute__((ext_vector_type(2)));
typedef unsigned u32x4 __attribute__((ext_vector_type(4)));
typedef __bf16 bf16x2_t __attribute__((ext_vector_type(2)));
typedef GAS unsigned gu32;

constexpr int NB = 2, SEQ = 8192, T = NB * SEQ, D = 1024, NY = 2560, FF = 3584, NEXP = 8;
constexpr int NIN = 2468;
constexpr float EPS = 1e-6f;
constexpr float LOG2E = 1.4426950408889634f;
constexpr float C2_64 = 0.125f * LOG2E;
constexpr float C2_96 = 0.10206207261596575f * LOG2E;
constexpr int Y_FQ = 0, Y_FK = 256, Y_FV = 512, Y_SQ = 768, Y_SK = 1024, Y_SV = 1152, Y_CQ = 1280, Y_DQ = 1536, Y_DK = 1792, Y_DV = 2048,
              Y_CKV = 2304, Y_KR = 2432, Y_FF = 2464;
constexpr int MOE_MAX_TILES = 136, MOE_MAX_ROWS = MOE_MAX_TILES * 256;

constexpr size_t MiB = 1u << 20, KiB = 1u << 10;
constexpr size_t WS_CTL = 0, CTL_ZERO_BYTES = 1 * MiB;
constexpr size_t WS_SM = 1 * MiB;
constexpr size_t SM_RSTD0 = WS_SM, SM_PARTQ = WS_SM + 64 * KiB, SM_PARTKV = WS_SM + 320 * KiB, SM_FF = WS_SM + 576 * KiB, SM_CSL = WS_SM + 832 * KiB,
                 SM_PART = WS_SM + 1088 * KiB, SM_ROPE = WS_SM + 2112 * KiB, SM_TOKE = WS_SM + 4160 * KiB, SM_TOKG = WS_SM + 4288 * KiB,
                 SM_RSTDT = WS_SM + 4416 * KiB, SM_SLOT = WS_SM + 4480 * KiB, SM_RSTDG = WS_SM + 4608 * KiB, SM_HIST = WS_SM + 4800 * KiB, SM_MOETAB = WS_SM + 4808 * KiB;
constexpr size_t WS_WIN = 9 * MiB;
constexpr size_t WS_WQUP = 19 * MiB;
constexpr size_t WS_WKVUP = 19 * MiB + 512 * KiB;
constexpr size_t WS_WOUT = 20 * MiB;
constexpr size_t WS_WGU0 = 24 * MiB;
constexpr size_t WS_WD0 = 38 * MiB;
constexpr size_t WS_WGU1 = 45 * MiB;
constexpr size_t WS_WD1 = 45 * MiB;
constexpr size_t WS_XB = 157 * MiB;
constexpr size_t WS_Y = 189 * MiB;
constexpr size_t WS_QM = 269 * MiB, WS_KM = 281 * MiB, WS_VM = 293 * MiB;
constexpr size_t WS_MIX = 301 * MiB;
constexpr size_t WS_DP = 333 * MiB;
constexpr size_t WS_DL = 357 * MiB;
constexpr size_t WS_MP = 360 * MiB;
constexpr size_t WS_ML = 392 * MiB;
constexpr size_t WS_HID = 189 * MiB;
constexpr size_t WS_XG = 157 * MiB;
constexpr size_t WS_HG = 225 * MiB;
constexpr size_t WS_END = 463 * MiB;
constexpr int CW_BAR = 4096;
constexpr int CW_QUEUE = 16384;
constexpr int CW_FMAX = 20480;
constexpr float FOX_THRESH = 100.0f;

constexpr int RING_BYTES = 131072;
constexpr int LDSCTL_OFF = RING_BYTES, MISC_OFF = LDSCTL_OFF + 320;
constexpr int LDS_BYTES = 147456;
constexpr int NWAVES = 8;

#define LDS_WAIT() asm volatile("s_waitcnt lgkmcnt(0)" ::: "memory")
#define VM_WAIT() asm volatile("s_waitcnt vmcnt(0)" ::: "memory")
#define RLX_AGENT __ATOMIC_RELAXED, __HIP_MEMORY_SCOPE_AGENT

__device__ __forceinline__ unsigned cvtpk(float lo, float hi) { f32x2 v = {lo, hi}; bf16x2_t b = __builtin_convertvector(v, bf16x2_t); return __builtin_bit_cast(unsigned, b); }
__device__ __forceinline__ float bf2f(unsigned short h) { return __uint_as_float((unsigned)h << 16); }
__device__ __forceinline__ float wave_sum(float v) {
#pragma unroll
    for (int o = 1; o < 64; o <<= 1) v += __shfl_xor(v, o);
    return v;
}

namespace pg8 {
constexpr int BM = 256, BK = 64, HALF = 128, HTB = HALF * BK * 2, STAGE_BYTES = 8 * HTB, NXCD = 8, WGM = 8;
__host__ __device__ __forceinline__ int lds_byte(int r, int c) { const int st = (r >> 4) * 2 + (c >> 5), rr = r & 15, cc = c & 31, ob = rr * 64 + cc * 2; return st * 1024 + (ob ^ (((ob >> 9) & 1) << 5)); }
__host__ __device__ __forceinline__ void stage_rc(int b, int& R, int& C) { const int st = b / 1024, sb = b % 1024, swz = sb ^ (((sb >> 9) & 1) << 5); R = (st >> 1) * 16 + swz / 64; C = (st & 1) * 32 + (swz % 64) / 2; }
__host__ __device__ __forceinline__ int perm32(int rho) { const int n = rho >> 4, i = rho & 15; return 8 * (i >> 2) + 4 * n + (i & 3); }

struct Unit { int pm, pn, e; };
struct Gemm { const bf16_t* A; const bf16_t* Bt; int lda, ldb, K; };

struct StaticOrder {
    int nM, nN, nwg, G, c;
    __device__ void init(int M, int N, int G_, int c_) { nM = M / BM; nN = N / BM; nwg = nM * nN; G = G_; c = c_; }
    __device__ bool next(int i, Unit& u) const {
        const long L = (long)i * G + c; if (L >= nwg) return false;
        int wgid = (int)L; { const int q = nwg / NXCD, r = nwg % NXCD, xcd = wgid % NXCD, off = wgid / NXCD; wgid = (xcd < r ? xcd * (q + 1) : r * (q + 1) + (xcd - r) * q) + off; }
        const int nig = WGM * nN, gid = wgid / nig, fm = gid * WGM, gsz = (nM - fm) < WGM ? (nM - fm) : WGM;
        u.pm = fm + ((wgid % nig) % gsz); u.pn = (wgid % nig) / gsz; u.e = 0; return true;
    }
};
struct SchedStatic {
    StaticOrder o;
    __device__ __forceinline__ bool next(int i, Unit& u) const { return o.next(i, u); }
    __device__ __forceinline__ const char* abase(const Gemm& g, const Unit& u) const { return (const char*)g.A + (size_t)u.pm * BM * g.lda * 2; }
    __device__ __forceinline__ const char* bbase(const Gemm& g, const Unit& u) const { return (const char*)g.Bt + (size_t)u.pn * BM * g.ldb * 2; }
};
struct SchedMoe {
    StaticOrder o; int tb[9]; size_t estride;
    __device__ __forceinline__ bool next(int i, Unit& u) const {
        if (!o.next(i, u)) return false; int e = 0;
#pragma unroll
        for (int j = 1; j < 8; ++j) e += (u.pm >= tb[j]) ? 1 : 0;
        u.e = e; return true;
    }
    __device__ __forceinline__ const char* abase(const Gemm& g, const Unit& u) const { return (const char*)g.A + (size_t)u.pm * BM * g.lda * 2; }
    __device__ __forceinline__ const char* bbase(const Gemm& g, const Unit& u) const { return (const char*)g.Bt + (size_t)u.e * estride + (size_t)u.pn * BM * g.ldb * 2; }
};
struct SchedOne {
    bool has; Unit un;
    __device__ __forceinline__ bool next(int i, Unit& u) const { if (i > 0 || !has) return false; u = un; return true; }
    __device__ __forceinline__ const char* abase(const Gemm& g, const Unit& u) const { return (const char*)g.A + (size_t)u.pm * BM * g.lda * 2; }
    __device__ __forceinline__ const char* bbase(const Gemm& g, const Unit& u) const { return (const char*)g.Bt + (size_t)u.pn * BM * g.ldb * 2; }
};

template <class Epi, class Sched, bool ALIGN_EPI>
__device__ __forceinline__ void gemm_phase(LAS unsigned char* lds, const Gemm g_in, const Sched& S, const Epi& E) {
    Gemm g = g_in; asm volatile("" : "+s"(g.A), "+s"(g.Bt), "+s"(g.K));
    int tid_l = threadIdx.x; asm volatile("" : "+v"(tid_l));
    const int tid = tid_l, wid = __builtin_amdgcn_readfirstlane(tid >> 6), lane = tid & 63, wr = wid >> 2, wc = wid & 3, fr = lane & 15, fq = lane >> 4;
    const int K = g.K, nt = K / BK;
    unsigned voffA[2], voffB[2];
#pragma unroll
    for (int i = 0; i < 2; ++i) { int R, C; stage_rc(tid * 16 + i * 8192, R, C); const int Rb = Epi::PERM ? ((R & ~31) + perm32(R & 31)) : R;
        voffA[i] = (unsigned)(R * g.lda + C) * 2u; voffB[i] = (unsigned)(Rb * g.ldb + C) * 2u; }
    const size_t kstep = (size_t)(BK * 2);
    const size_t hstepA = (size_t)HALF * g.lda * 2, hstepB = (size_t)HALF * g.ldb * 2;
    const unsigned ldsw = (unsigned)wid * 1024u;
    const int aoff = lds_byte(wr * 64 + fr, fq * 8), boff = lds_byte(wc * 32 + fr, fq * 8);
#define PG8_SA(b, h) (((b) * 2 + (h)) * HTB)
#define PG8_SB(b, h) ((4 + (b) * 2 + (h)) * HTB)
#define PG8_STAGE(bufoff, gbase, voff) do { _Pragma("unroll") for (int _i = 0; _i < 2; ++_i) \
        __builtin_amdgcn_global_load_lds((const unsigned*)((const char*)(gbase) + (voff)[_i]), (LAS unsigned*)(lds + (bufoff) + ldsw + _i * 8192), 16, 0, 0); } while (0)
#define PG8_LDA(dst, b, h) do { _Pragma("unroll") for (int m = 0; m < 4; ++m) _Pragma("unroll") for (int k = 0; k < 2; ++k) dst[m][k] = *(const LAS bf16x8*)(lds + PG8_SA(b, h) + aoff + m * 2048 + k * 1024); } while (0)
#define PG8_LDB(dst, b, h) do { _Pragma("unroll") for (int n = 0; n < 2; ++n) _Pragma("unroll") for (int k = 0; k < 2; ++k) dst[n][k] = *(const LAS bf16x8*)(lds + PG8_SB(b, h) + boff + n * 2048 + k * 1024); } while (0)
#define PG8_MMA(ai, bj, At, Bt) do { __builtin_amdgcn_s_setprio(1); _Pragma("unroll") for (int m = 0; m < 4; ++m) _Pragma("unroll") for (int n = 0; n < 2; ++n) _Pragma("unroll") for (int k = 0; k < 2; ++k) \
        acc[ai][bj][m][n] = __builtin_amdgcn_mfma_f32_16x16x32_bf16(Bt[n][k], At[m][k], acc[ai][bj][m][n], 0, 0, 0); __builtin_amdgcn_s_setprio(0); } while (0)
#define PG8_WAIT_V(n) asm volatile("s_waitcnt vmcnt(" #n ")" ::: "memory")
#define PG8_WAIT_L(n) asm volatile("s_waitcnt lgkmcnt(" #n ")" ::: "memory")
#define PG8_BAR __builtin_amdgcn_s_barrier()
#define PG8_SCHED __builtin_amdgcn_sched_barrier(0)
    Unit cur, nxt; int ui = 0;
    if (!S.next(0, cur)) return;
    f32x4 acc[2][2][4][2];
#pragma unroll
    for (int a = 0; a < 2; ++a)
#pragma unroll
        for (int b = 0; b < 2; ++b)
#pragma unroll
            for (int m = 0; m < 4; ++m)
#pragma unroll
                for (int n = 0; n < 2; ++n) acc[a][b][m][n] = (f32x4){0.f, 0.f, 0.f, 0.f};
    bf16x8 At[4][2], B0[2][2], B1[2][2];
    const char* cA = S.abase(g, cur); const char* cB = S.bbase(g, cur);
    PG8_STAGE(PG8_SB(0, 0), cB, voffB); PG8_STAGE(PG8_SB(0, 1), cB + hstepB, voffB); PG8_STAGE(PG8_SA(0, 0), cA, voffA); PG8_STAGE(PG8_SA(0, 1), cA + hstepA, voffA);
    if (wr == 1) PG8_BAR;
    PG8_WAIT_V(2); PG8_BAR;
    PG8_STAGE(PG8_SB(1, 0), cB + kstep, voffB); PG8_STAGE(PG8_SA(1, 0), cA + kstep, voffA); PG8_STAGE(PG8_SB(1, 1), cB + hstepB + kstep, voffB);
    PG8_WAIT_V(6); PG8_BAR;
    for (;;) {
        const bool has_next = S.next(ui + 1, nxt);
        const char* nA = has_next ? S.abase(g, nxt) : cA; const char* nB = has_next ? S.bbase(g, nxt) : cB;
        for (int t = 0; t < nt; t += 2) {
            const bool last = (t == nt - 2);
            const char* a1 = cA + (size_t)(t + 1) * kstep;
            const char* a2 = last ? nA : cA + (size_t)(t + 2) * kstep; const char* b2 = last ? nB : cB + (size_t)(t + 2) * kstep;
            const char* a3 = a2 + kstep; const char* b3 = b2 + kstep;
            PG8_LDB(B0, 0, 0); PG8_LDB(B1, 0, 1); PG8_SCHED; PG8_LDA(At, 0, 0); PG8_STAGE(PG8_SA(1, 1), a1 + hstepA, voffA);
            PG8_WAIT_V(8); PG8_WAIT_L(0); PG8_BAR; PG8_MMA(0, 0, At, B0); PG8_MMA(0, 1, At, B1); PG8_BAR; PG8_SCHED;
            PG8_LDA(At, 0, 1); PG8_STAGE(PG8_SB(0, 0), b2, voffB); PG8_STAGE(PG8_SB(0, 1), b2 + hstepB, voffB); PG8_STAGE(PG8_SA(0, 0), a2, voffA);
            PG8_WAIT_V(8); PG8_WAIT_L(0); PG8_BAR; PG8_MMA(1, 0, At, B0); PG8_MMA(1, 1, At, B1); PG8_BAR; PG8_SCHED;
            PG8_LDB(B0, 1, 0); PG8_LDB(B1, 1, 1); PG8_SCHED; PG8_LDA(At, 1, 0); PG8_STAGE(PG8_SA(0, 1), a2 + hstepA, voffA);
            PG8_WAIT_V(8); PG8_WAIT_L(0); PG8_BAR; PG8_MMA(0, 0, At, B0); PG8_MMA(0, 1, At, B1); PG8_BAR; PG8_SCHED;
            PG8_LDA(At, 1, 1); PG8_STAGE(PG8_SB(1, 0), b3, voffB); PG8_STAGE(PG8_SB(1, 1), b3 + hstepB, voffB); PG8_STAGE(PG8_SA(1, 0), a3, voffA);
            PG8_WAIT_V(8); PG8_WAIT_L(0); PG8_BAR; PG8_MMA(1, 0, At, B0); PG8_MMA(1, 1, At, B1); PG8_BAR; PG8_SCHED;
        }
        if constexpr (ALIGN_EPI) { if (wr == 0) PG8_BAR; }
        E(acc, cur, wr, wc, fr, fq);
        if (!has_next) break;
#pragma unroll
        for (int a = 0; a < 2; ++a)
#pragma unroll
            for (int b = 0; b < 2; ++b)
#pragma unroll
                for (int m = 0; m < 4; ++m)
#pragma unroll
                    for (int n = 0; n < 2; ++n) acc[a][b][m][n] = (f32x4){0.f, 0.f, 0.f, 0.f};
        cur = nxt; cA = nA; cB = nB; ++ui;
        if constexpr (ALIGN_EPI) { if (wr == 1) PG8_BAR; }
    }
    PG8_WAIT_V(0);
    if constexpr (!ALIGN_EPI) { if (wr == 0) PG8_BAR; }
    PG8_BAR;
#undef PG8_SA
#undef PG8_SB
#undef PG8_STAGE
#undef PG8_LDA
#undef PG8_LDB
#undef PG8_MMA
#undef PG8_WAIT_V
#undef PG8_WAIT_L
#undef PG8_BAR
#undef PG8_SCHED
}

__device__ __forceinline__ float rstd_part(const float* part, int row) {
    const f32x4* p = (const f32x4*)(part + (size_t)row * 16);
    const f32x4 a = p[0], b = p[1], c = p[2], d = p[3];
    const float s = ((a[0] + a[1]) + (a[2] + a[3])) + ((b[0] + b[1]) + (b[2] + b[3])) + ((c[0] + c[1]) + (c[2] + c[3])) + ((d[0] + d[1]) + (d[2] + d[3]));
    return __builtin_amdgcn_rsqf(s * (1.0f / D) + EPS);
}
__device__ __forceinline__ void rstd_rows(float (&rs)[8], const float* rstd_direct, const float* part, int row0) {
#pragma unroll
    for (int ai = 0; ai < 2; ++ai) {
        asm volatile("" ::: "memory");
#pragma unroll
        for (int m = 0; m < 4; ++m) { const int row = row0 + ai * HALF + m * 16; rs[ai * 4 + m] = rstd_direct ? rstd_direct[row] : rstd_part(part, row); }
        asm volatile("" : "+v"(rs[ai * 4 + 0]), "+v"(rs[ai * 4 + 1]), "+v"(rs[ai * 4 + 2]), "+v"(rs[ai * 4 + 3]));
    }
    asm volatile("" ::: "memory");
}
__device__ __forceinline__ u32x4 pack8(const f32x4 v0, const f32x4 v1) { u32x4 w; w.x = cvtpk(v0[0], v0[1]); w.y = cvtpk(v0[2], v0[3]); w.z = cvtpk(v1[0], v1[1]); w.w = cvtpk(v1[2], v1[3]); return w; }

struct EpiG1 {
    static constexpr bool PERM = true;
    bf16_t* Y; const float* rstd_direct; const float* part; float* partq; float* partkv; float* ff; bf16_t* Km; const float* rope;
    __device__ __forceinline__ void operator()(const f32x4 (&acc)[2][2][4][2], const Unit& u, int wr, int wc, int fr, int fq) const {
        float rsv[8]; rstd_rows(rsv, rstd_direct, part, u.pm * BM + wr * 64 + fr);
#pragma unroll
        for (int ai = 0; ai < 2; ++ai)
#pragma unroll
            for (int m = 0; m < 4; ++m) {
                asm volatile("" ::: "memory");
                const int row = u.pm * BM + ai * HALF + wr * 64 + m * 16 + fr;
                const float rs = rsv[ai * 4 + m];
                f32x4 v[2][2];
#pragma unroll
                for (int bj = 0; bj < 2; ++bj) { v[bj][0] = acc[ai][bj][m][0] * rs; v[bj][1] = acc[ai][bj][m][1] * rs;
                    *(u32x4*)(Y + (size_t)row * NY + u.pn * BM + bj * HALF + wc * 32 + 8 * fq) = pack8(v[bj][0], v[bj][1]); }
                if (u.pn == Y_CQ / 256) {
                    float s = 0.f;
#pragma unroll
                    for (int bj = 0; bj < 2; ++bj)
#pragma unroll
                        for (int n = 0; n < 2; ++n) { const f32x4 x = v[bj][n]; s += (x[0] * x[0] + x[1] * x[1]) + (x[2] * x[2] + x[3] * x[3]); }
                    s += __shfl_xor(s, 16); s += __shfl_xor(s, 32);
                    if (fq == 0) partq[row * 4 + wc] = s;
                }
                if (u.pn == Y_CKV / 256) {
                    float s = 0.f;
#pragma unroll
                    for (int n = 0; n < 2; ++n) { const f32x4 x = v[0][n]; s += (x[0] * x[0] + x[1] * x[1]) + (x[2] * x[2] + x[3] * x[3]); }
                    s += __shfl_xor(s, 16); s += __shfl_xor(s, 32);
                    if (fq == 0) partkv[row * 4 + wc] = s;
                    if (wc == 0) {
                        const f32x4* rp = (const f32x4*)(rope + (size_t)row * 32 + 8 * fq);
                        const f32x4 cs0 = rp[0], cs1 = rp[1];
                        const f32x4 t1 = v[1][0], t2 = v[1][1];
                        f32x4 o1, o2;
                        o1[0] = t1[0] * cs0[0] - t2[0] * cs0[1]; o2[0] = t2[0] * cs0[0] + t1[0] * cs0[1];
                        o1[1] = t1[1] * cs0[2] - t2[1] * cs0[3]; o2[1] = t2[1] * cs0[2] + t1[1] * cs0[3];
                        o1[2] = t1[2] * cs1[0] - t2[2] * cs1[1]; o2[2] = t2[2] * cs1[0] + t1[2] * cs1[1];
                        o1[3] = t1[3] * cs1[2] - t2[3] * cs1[3]; o2[3] = t2[3] * cs1[2] + t1[3] * cs1[3];
                        const u32x4 w = pack8(o1, o2);
#pragma unroll
                        for (int h = 0; h < 4; ++h) *(u32x4*)(Km + (size_t)row * 384 + h * 96 + 64 + 8 * fq) = w;
                    }
                    if (wc == 1 && fq == 0) *(f32x4*)(ff + (size_t)row * 4) = v[1][0];
                }
            }
    }
};
struct EpiQup {
    static constexpr bool PERM = true;
    bf16_t* Qm; const float* partq; const float* rope;
    __device__ __forceinline__ void operator()(const f32x4 (&acc)[2][2][4][2], const Unit& u, int wr, int wc, int fr, int fq) const {
#pragma unroll
        for (int ai = 0; ai < 2; ++ai)
#pragma unroll
            for (int m = 0; m < 4; ++m) {
                asm volatile("" ::: "memory");
                const int row = u.pm * BM + ai * HALF + wr * 64 + m * 16 + fr;
                const f32x4 pq = *(const f32x4*)(partq + (size_t)row * 4);
                const float rs = __builtin_amdgcn_rsqf(((pq[0] + pq[1]) + (pq[2] + pq[3])) * (1.0f / 256.0f) + EPS);
#pragma unroll
                for (int bj = 0; bj < 2; ++bj) {
                    const int col = u.pn * BM + bj * HALF + wc * 32 + 8 * fq;
                    if (col < 384) {
                        f32x4 v0 = acc[ai][bj][m][0] * rs, v1 = acc[ai][bj][m][1] * rs;
                        const int cm = col % 96;
                        if (cm >= 64) {
                            const f32x4* rp = (const f32x4*)(rope + (size_t)row * 32 + (cm - 64));
                            const f32x4 cs0 = rp[0], cs1 = rp[1];
                            const f32x4 t1 = v0, t2 = v1;
                            v0[0] = t1[0] * cs0[0] - t2[0] * cs0[1]; v1[0] = t2[0] * cs0[0] + t1[0] * cs0[1];
                            v0[1] = t1[1] * cs0[2] - t2[1] * cs0[3]; v1[1] = t2[1] * cs0[2] + t1[1] * cs0[3];
                            v0[2] = t1[2] * cs1[0] - t2[2] * cs1[1]; v1[2] = t2[2] * cs1[0] + t1[2] * cs1[1];
                            v0[3] = t1[3] * cs1[2] - t2[3] * cs1[3]; v1[3] = t2[3] * cs1[2] + t1[3] * cs1[3];
                        }
                        *(u32x4*)(Qm + (size_t)row * 384 + col) = pack8(v0, v1);
                    }
                }
            }
    }
};
struct EpiKVup {
    static constexpr bool PERM = true;
    bf16_t* Km; bf16_t* Vm; const float* partkv;
    __device__ __forceinline__ void operator()(const f32x4 (&acc)[2][2][4][2], const Unit& u, int wr, int wc, int fr, int fq) const {
#pragma unroll
        for (int ai = 0; ai < 2; ++ai)
#pragma unroll
            for (int m = 0; m < 4; ++m) {
                asm volatile("" ::: "memory");
                const int row = u.pm * BM + ai * HALF + wr * 64 + m * 16 + fr;
                const f32x4 pq = *(const f32x4*)(partkv + (size_t)row * 4);
                const float rs = __builtin_amdgcn_rsqf(((pq[0] + pq[1]) + (pq[2] + pq[3])) * (1.0f / 128.0f) + EPS);
#pragma unroll
                for (int bj = 0; bj < 2; ++bj) {
                    const int col = u.pn * BM + bj * HALF + wc * 32 + 8 * fq;
                    const int h = col >> 7, c = col & 127;
                    const u32x4 w = pack8(acc[ai][bj][m][0] * rs, acc[ai][bj][m][1] * rs);
                    if (c < 64) *(u32x4*)(Km + (size_t)row * 384 + h * 96 + c) = w;
                    else *(u32x4*)(Vm + (size_t)row * 256 + h * 64 + (c - 64)) = w;
                }
            }
    }
};
struct EpiRes {
    static constexpr bool PERM = false;
    const float* base; float* out; bf16_t* xb; float* part;
    __device__ __forceinline__ void operator()(const f32x4 (&acc)[2][2][4][2], const Unit& u, int wr, int wc, int fr, int fq) const {
#pragma unroll
        for (int ai = 0; ai < 2; ++ai) {
            asm volatile("" ::: "memory");
            f32x4 pre[4][2][2];
#pragma unroll
            for (int m = 0; m < 4; ++m) { const size_t roff = (size_t)(u.pm * BM + ai * HALF + wr * 64 + m * 16 + fr) * D + u.pn * BM + wc * 32 + 4 * fq;
#pragma unroll
                for (int bj = 0; bj < 2; ++bj)
#pragma unroll
                    for (int n = 0; n < 2; ++n) pre[m][bj][n] = *(const f32x4*)(base + roff + bj * HALF + n * 16); }
#pragma unroll
            for (int m = 0; m < 4; ++m) {
                const int row = u.pm * BM + ai * HALF + wr * 64 + m * 16 + fr;
                float s = 0.f;
#pragma unroll
                for (int bj = 0; bj < 2; ++bj)
#pragma unroll
                    for (int n = 0; n < 2; ++n) {
                        const size_t off = (size_t)row * D + u.pn * BM + bj * HALF + wc * 32 + n * 16 + 4 * fq;
                        const f32x4 x = pre[m][bj][n] + acc[ai][bj][m][n];
                        *(f32x4*)(out + off) = x;
                        s += (x[0] * x[0] + x[1] * x[1]) + (x[2] * x[2] + x[3] * x[3]);
                        if (xb) { u32x2 w; w.x = cvtpk(x[0], x[1]); w.y = cvtpk(x[2], x[3]); *(u32x2*)(xb + off) = w; }
                    }
                s += __shfl_xor(s, 16); s += __shfl_xor(s, 32);
                if (fq == 0) part[(size_t)row * 16 + u.pn * 4 + wc] = s;
            }
        }
    }
};
struct EpiSwiglu {
    static constexpr bool PERM = true;
    bf16_t* H; const float* rstd_direct; const float* part;
    __device__ __forceinline__ void operator()(const f32x4 (&acc)[2][2][4][2], const Unit& u, int wr, int wc, int fr, int fq) const {
        float rsv[8]; rstd_rows(rsv, rstd_direct, part, u.pm * BM + wr * 64 + fr);
#pragma unroll
        for (int ai = 0; ai < 2; ++ai)
#pragma unroll
            for (int m = 0; m < 4; ++m) {
                asm volatile("" ::: "memory");
                const int row = u.pm * BM + ai * HALF + wr * 64 + m * 16 + fr;
                const float rs = rsv[ai * 4 + m];
                f32x4 hv[2];
#pragma unroll
                for (int n = 0; n < 2; ++n) {
                    const f32x4 gt = acc[ai][0][m][n] * rs, up = acc[ai][1][m][n] * rs;
#pragma unroll
                    for (int e = 0; e < 4; ++e) { const float sg = __builtin_amdgcn_rcpf(1.0f + __builtin_amdgcn_exp2f(-gt[e] * LOG2E)); hv[n][e] = gt[e] * sg * up[e]; }
                }
                *(u32x4*)(H + (size_t)row * FF + u.pn * HALF + wc * 32 + 8 * fq) = pack8(hv[0], hv[1]);
            }
    }
};
struct EpiY {
    static constexpr bool PERM = true;
    bf16_t* O;
    __device__ __forceinline__ void operator()(const f32x4 (&acc)[2][2][4][2], const Unit& u, int wr, int wc, int fr, int fq) const {
#pragma unroll
        for (int ai = 0; ai < 2; ++ai)
#pragma unroll
            for (int m = 0; m < 4; ++m) {
                asm volatile("" ::: "memory");
                const int row = u.pm * BM + ai * HALF + wr * 64 + m * 16 + fr;
#pragma unroll
                for (int bj = 0; bj < 2; ++bj) *(u32x4*)(O + (size_t)row * D + u.pn * BM + bj * HALF + wc * 32 + 8 * fq) = pack8(acc[ai][bj][m][0], acc[ai][bj][m][1]);
            }
    }
};
}

namespace att {
constexpr int VSLOT = 8192;
template <int NDK, int MODE, int NSL> struct Lay {
    static constexpr int KSLOT = NDK * 2048, LDS_K = 0, LDS_V = NSL * KSLOT, LDS_WS = LDS_V + NSL * VSLOT, LDS_CB = LDS_WS + 8 * 256, LDS_OST = 0,
                         LDS_TOTAL = LDS_CB + (MODE == 1 ? 32768 : 0);
    static_assert(LDS_TOTAL <= RING_BYTES && 8 * 4096 <= LDS_WS, "attention LDS");
};
struct AU {
    const bf16_t* Q; const bf16_t* K; const bf16_t* V; bf16_t* O; float* lse; const float* colb;
    int qpitch, kpitch, vpitch, opitch, lpitch;
    int q0, kt0, kt1, span; float alibi, sink2, xthr;
};
__device__ __forceinline__ int crow(int r, int hi) { return (r & 3) + 8 * (r >> 2) + 4 * hi; }
__device__ __forceinline__ void glds16(const void* gsrc, unsigned lds_dst) { unsigned keep;
    asm volatile("s_mov_b32 %0, m0\n\ts_mov_b32 m0, %2\n\ts_nop 0\n\tglobal_load_lds_dwordx4 %1, off\n\ts_mov_b32 m0, %0" : "=&s"(keep) : "v"(gsrc), "s"(lds_dst) : "memory"); }
#define ATT_WAIT_BAR() asm volatile("s_waitcnt vmcnt(0) lgkmcnt(0)\n\ts_barrier" ::: "memory")
#define ATT_WAITV_BAR(N) asm volatile("s_waitcnt vmcnt(%0) lgkmcnt(0)\n\ts_barrier" :: "n"(N) : "memory")
__device__ __forceinline__ float permswap_max(float m) { auto rr = __builtin_amdgcn_permlane32_swap(__float_as_uint(m), __float_as_uint(m), false, false); return fmaxf(__uint_as_float(rr[0]), __uint_as_float(rr[1])); }
__device__ __forceinline__ float permswap_sum(float m) { auto rr = __builtin_amdgcn_permlane32_swap(__float_as_uint(m), __float_as_uint(m), false, false); return __uint_as_float(rr[0]) + __uint_as_float(rr[1]); }

#define ATT_LGKM0() do { asm volatile("s_waitcnt lgkmcnt(0)" ::: "memory"); __builtin_amdgcn_sched_barrier(0); } while (0)
template <int NDK>
__device__ __forceinline__ void k_issue(bf16x8 (&kf)[2 * NDK], unsigned kaddr) {
#pragma unroll
    for (int d0 = 0; d0 < NDK; ++d0) {
        asm volatile("ds_read_b128 %0, %1 offset:%2" : "=v"(kf[2 * d0]) : "v"(kaddr), "i"(d0 * 2048) : "memory");
        asm volatile("ds_read_b128 %0, %1 offset:%2" : "=v"(kf[2 * d0 + 1]) : "v"(kaddr), "i"(d0 * 2048 + 512) : "memory");
    }
}
template <int NDK>
__device__ __forceinline__ void qk_mma(f32x16& p0, f32x16& p1, const bf16x8 (&kf)[2 * NDK], const bf16x8 (&qr)[NDK]) {
    p0 = (f32x16){}; p1 = (f32x16){};
#pragma unroll
    for (int d0 = 0; d0 < NDK; ++d0) {
        p0 = __builtin_amdgcn_mfma_f32_32x32x16_bf16(kf[2 * d0], qr[d0], p0, 0, 0, 0);
        p1 = __builtin_amdgcn_mfma_f32_32x32x16_bf16(kf[2 * d0 + 1], qr[d0], p1, 0, 0, 0);
    }
}
__device__ __forceinline__ void v_issue(s16x4 (&vlo)[8], s16x4 (&vhi)[8], unsigned vaddr) {
#pragma unroll
    for (int i = 0; i < 8; ++i) {
        asm volatile("ds_read_b64_tr_b16 %0, %1 offset:%2" : "=v"(vlo[i]) : "v"(vaddr), "i"((i >> 2) * 4096 + (i & 3) * 1024) : "memory");
        asm volatile("ds_read_b64_tr_b16 %0, %1 offset:%2" : "=v"(vhi[i]) : "v"(vaddr), "i"((i >> 2) * 4096 + (i & 3) * 1024 + 512) : "memory");
    }
}
__device__ __forceinline__ void pv_mma(f32x16& o0, f32x16& o1, const s16x4 (&vlo)[8], const s16x4 (&vhi)[8], const u32x4 pw0, const u32x4 pw1, const u32x4 pw2, const u32x4 pw3) {
#define ATT_VF(i) (bf16x8){vlo[i][0], vlo[i][1], vlo[i][2], vlo[i][3], vhi[i][0], vhi[i][1], vhi[i][2], vhi[i][3]}
    o0 = __builtin_amdgcn_mfma_f32_32x32x16_bf16(__builtin_bit_cast(bf16x8, pw0), ATT_VF(0), o0, 0, 0, 0);
    o1 = __builtin_amdgcn_mfma_f32_32x32x16_bf16(__builtin_bit_cast(bf16x8, pw0), ATT_VF(4), o1, 0, 0, 0);
    o0 = __builtin_amdgcn_mfma_f32_32x32x16_bf16(__builtin_bit_cast(bf16x8, pw1), ATT_VF(1), o0, 0, 0, 0);
    o1 = __builtin_amdgcn_mfma_f32_32x32x16_bf16(__builtin_bit_cast(bf16x8, pw1), ATT_VF(5), o1, 0, 0, 0);
    o0 = __builtin_amdgcn_mfma_f32_32x32x16_bf16(__builtin_bit_cast(bf16x8, pw2), ATT_VF(2), o0, 0, 0, 0);
    o1 = __builtin_amdgcn_mfma_f32_32x32x16_bf16(__builtin_bit_cast(bf16x8, pw2), ATT_VF(6), o1, 0, 0, 0);
    o0 = __builtin_amdgcn_mfma_f32_32x32x16_bf16(__builtin_bit_cast(bf16x8, pw3), ATT_VF(3), o0, 0, 0, 0);
    o1 = __builtin_amdgcn_mfma_f32_32x32x16_bf16(__builtin_bit_cast(bf16x8, pw3), ATT_VF(7), o1, 0, 0, 0);
#undef ATT_VF
}
__device__ __forceinline__ float max3f(float a, float b, float c) { float r; asm("v_max3_f32 %0, %1, %2, %3" : "=v"(r) : "v"(a), "v"(b), "v"(c)); return r; }

template <int NDK, int MODE, int NSL>
__device__ __forceinline__ void attn_unit(const AU& u, LAS unsigned char* shm) {
    typedef Lay<NDK, MODE, NSL> L; constexpr int KSLOT = L::KSLOT, LDS_K = L::LDS_K, LDS_V = L::LDS_V, LDS_WS = L::LDS_WS, LDS_CB = L::LDS_CB, LDS_OST = L::LDS_OST, DF = NSL - 2;
    int tid_l = threadIdx.x; asm volatile("" : "+v"(tid_l));
    const int tid = tid_l, lane = tid & 63, r32 = lane & 31, hi = lane >> 5; const int wid = __builtin_amdgcn_readfirstlane(tid >> 6);
    const unsigned lds0 = (unsigned)(uintptr_t)shm;
    LAS float* wsf = (LAS float*)(shm + LDS_WS) + wid * 64;
    LAS float* cb = (LAS float*)(shm + LDS_CB);
    const int q = u.q0 + wid * 32 + r32;
    const int qmin = u.q0 + wid * 32, qmax = qmin + 31;
    float cq = 0.f;
    int ukt0 = u.kt0;
    if (MODE == 1) {
        LAS int* red = (LAS int*)cb;
        if (tid == 0) *red = u.kt1 - 1;
        ATT_WAIT_BAR();
        const float thr = u.colb[u.q0] + u.xthr;
        for (int j = tid; j < u.kt1; j += 512) if (u.colb[64 * j + 63] <= thr) atomicMin((int*)red, j);
        ATT_WAIT_BAR();
        ukt0 = __builtin_amdgcn_readfirstlane(*red);
        ATT_WAIT_BAR();
        const int nk = (u.kt1 - ukt0) * 64;
        for (int i = tid; i < nk; i += 512) cb[i] = u.colb[ukt0 * 64 + i];
        cq = u.colb[q];
    }
    bf16x8 qr[NDK];
    { const bf16_t* qp = u.Q + (size_t)q * u.qpitch + hi * 8;
#pragma unroll
      for (int d0 = 0; d0 < NDK; ++d0) qr[d0] = *(const bf16x8*)(qp + d0 * 16); }
#define ATT_ISSUE(kt_, s_) do { \
        const bf16_t* kp_ = u.K + (size_t)((kt_) * 64 + lane) * u.kpitch; \
        glds16(kp_ + wid * 8, (unsigned)__builtin_amdgcn_readfirstlane(lds0 + LDS_K + (s_) * KSLOT + wid * 1024)); \
        if (NDK == 6) { if (wid < 4) glds16(kp_ + (wid + 8) * 8, (unsigned)__builtin_amdgcn_readfirstlane(lds0 + LDS_K + (s_) * KSLOT + (wid + 8) * 1024)); } \
        const bf16_t* vp_ = u.V + (size_t)((kt_) * 64 + 16 * (wid & 3) + (lane >> 2)) * u.vpitch + (wid >> 2) * 32 + (lane & 3) * 8; \
        glds16(vp_, (unsigned)__builtin_amdgcn_readfirstlane(lds0 + LDS_V + (s_) * VSLOT + wid * 1024)); } while (0)
    float mrun = -3.0e38f, lrun = 0.f;
    f32x16 o0 = {}, o1 = {};
    const int nT = u.kt1 - ukt0;
    int whi = qmax >> 6; if (whi > u.kt1 - 1) whi = u.kt1 - 1;
    int wlo = ukt0; if (MODE == 2) { const int l_ = (qmin - u.span) >> 6; if (l_ > wlo) wlo = l_; }
    const int mask_from = qmin >> 6;
    u32x4 pw0, pw1, pw2, pw3;
#define ATT_SOFT(p0, p1, kt_) do { \
        const int kmin_ = (kt_) * 64; \
        if (MODE == 1) { \
            const LAS f32x4* cp_ = (const LAS f32x4*)(cb + ((kt_) - ukt0) * 64 + 4 * hi); \
            _Pragma("unroll") for (int j = 0; j < 4; ++j) { const f32x4 c0_ = cp_[2 * j], c1_ = cp_[2 * j + 8]; \
                _Pragma("unroll") for (int e = 0; e < 4; ++e) { p0[4 * j + e] += cq - c0_[e]; p1[4 * j + e] += cq - c1_[e]; } } \
        } \
        if (MODE == 2) { \
            _Pragma("unroll") for (int r = 0; r < 16; ++r) { const int d0_ = q - (kmin_ + crow(r, hi)), d1_ = d0_ - 32; \
                p0[r] = ((unsigned)d0_ <= (unsigned)u.span) ? p0[r] - u.alibi * (float)d0_ : -INFINITY; \
                p1[r] = ((unsigned)d1_ <= (unsigned)u.span) ? p1[r] - u.alibi * (float)d1_ : -INFINITY; } \
        } else if ((kt_) >= mask_from) { \
            _Pragma("unroll") for (int r = 0; r < 16; ++r) { const int kj_ = kmin_ + crow(r, hi); if (kj_ > q) p0[r] = -INFINITY; if (kj_ + 32 > q) p1[r] = -INFINITY; } \
        } \
        float ra_ = max3f(p0[0], p0[1], p1[0]), rb_ = max3f(p0[2], p0[3], p1[1]); ra_ = max3f(ra_, p1[2], p1[3]); \
        _Pragma("unroll") for (int r = 4; r < 16; r += 4) { ra_ = max3f(ra_, p0[r], p0[r + 1]); rb_ = max3f(rb_, p0[r + 2], p0[r + 3]); ra_ = max3f(ra_, p1[r], p1[r + 1]); rb_ = max3f(rb_, p1[r + 2], p1[r + 3]); } \
        float rm_ = max3f(ra_, rb_, mrun); \
        { auto rr_ = __builtin_amdgcn_permlane32_swap(__float_as_uint(rm_), __float_as_uint(rm_), false, false); rm_ = max3f(__uint_as_float(rr_[0]), __uint_as_float(rr_[1]), mrun); } \
        const float mn_ = rm_, alpha_ = __builtin_amdgcn_exp2f(mrun - mn_); \
        mrun = mn_; \
        float sum_ = 0.f; \
        _Pragma("unroll") for (int r = 0; r < 16; ++r) { p0[r] = __builtin_amdgcn_exp2f(p0[r] - mn_); p1[r] = __builtin_amdgcn_exp2f(p1[r] - mn_); sum_ += p0[r] + p1[r]; } \
        lrun = lrun * alpha_ + sum_; \
        if (!__all(alpha_ == 1.0f)) { \
            if (hi == 0) wsf[r32] = alpha_; \
            LDS_WAIT(); \
            _Pragma("unroll") for (int j = 0; j < 4; ++j) { const f32x4 f_ = *(const LAS f32x4*)(wsf + 8 * j + 4 * hi); \
                _Pragma("unroll") for (int e = 0; e < 4; ++e) { o0[4 * j + e] *= f_[e]; o1[4 * j + e] *= f_[e]; } } \
        } \
        pw0 = (u32x4){cvtpk(p0[0], p0[1]), cvtpk(p0[2], p0[3]), cvtpk(p0[4], p0[5]), cvtpk(p0[6], p0[7])}; \
        pw1 = (u32x4){cvtpk(p0[8], p0[9]), cvtpk(p0[10], p0[11]), cvtpk(p0[12], p0[13]), cvtpk(p0[14], p0[15])}; \
        pw2 = (u32x4){cvtpk(p1[0], p1[1]), cvtpk(p1[2], p1[3]), cvtpk(p1[4], p1[5]), cvtpk(p1[6], p1[7])}; \
        pw3 = (u32x4){cvtpk(p1[8], p1[9]), cvtpk(p1[10], p1[11]), cvtpk(p1[12], p1[13]), cvtpk(p1[14], p1[15])}; \
    } while (0)
#pragma unroll
    for (int j = 0; j <= DF; ++j) if (j < nT) ATT_ISSUE(ukt0 + j, j);
    const unsigned kaddr0 = lds0 + LDS_K + hi * 1024 + r32 * 16;
    const unsigned vaddr0 = lds0 + LDS_V + ((lane >> 4) & 1) * 32 + (lane & 3) * 8 + (4 * hi + ((lane & 15) >> 2)) * 64;
#define ATT_LOOP(HB) do { \
    constexpr int PER = (NDK == 6 && !(HB)) ? 3 : 2; \
    if (ukt0 + DF < u.kt1) ATT_WAITV_BAR((DF - 1) * PER); else ATT_WAIT_BAR(); \
    f32x16 p0 = {}, p1 = {}; bf16x8 kf[2 * NDK]; s16x4 vlo[8], vhi[8]; \
    if (wlo <= ukt0 && ukt0 <= whi) { k_issue<NDK>(kf, kaddr0); if (HB) { ATT_LGKM0(); qk_mma<NDK>(p0, p1, kf, qr); } } \
    int sc = 0; \
    for (int i = 0; i < nT; ++i) { \
        const int kt = ukt0 + i; \
        if (i > 0) { if (kt + DF < u.kt1) ATT_WAITV_BAR((DF - 1) * PER); else ATT_WAIT_BAR(); } \
        const int sn = (sc + 1 == NSL) ? 0 : sc + 1; \
        if (kt + DF + 1 < u.kt1) { const int sf_ = (sc == 0) ? NSL - 1 : sc - 1; ATT_ISSUE(kt + DF + 1, sf_); } \
        const bool actc = (wlo <= kt) && (kt <= whi), actn = (kt + 1 < u.kt1) && (wlo <= kt + 1) && (kt + 1 <= whi); \
        if (actc) { \
            if (!(HB)) { ATT_LGKM0(); qk_mma<NDK>(p0, p1, kf, qr); } \
            v_issue(vlo, vhi, vaddr0 + sc * VSLOT); __builtin_amdgcn_sched_barrier(0); \
            ATT_SOFT(p0, p1, kt); \
            __builtin_amdgcn_sched_barrier(0); \
            if (actn) k_issue<NDK>(kf, kaddr0 + sn * KSLOT); \
            if (HB) { ATT_LGKM0(); } else { if (actn) asm volatile("s_waitcnt lgkmcnt(%0)" :: "n"(2 * NDK) : "memory"); else asm volatile("s_waitcnt lgkmcnt(0)" ::: "memory"); __builtin_amdgcn_sched_barrier(0); } \
            pv_mma(o0, o1, vlo, vhi, pw0, pw1, pw2, pw3); \
            if ((HB) && actn) qk_mma<NDK>(p0, p1, kf, qr); \
        } else if (actn) { k_issue<NDK>(kf, kaddr0 + sn * KSLOT); if (HB) { ATT_LGKM0(); qk_mma<NDK>(p0, p1, kf, qr); } } \
        sc = sn; \
    } } while (0)
    if (wid < 4) ATT_LOOP(false); else ATT_LOOP(true);
#undef ATT_LOOP
    asm volatile("s_waitcnt lgkmcnt(0)\n\ts_barrier" ::: "memory");
    float ltot = permswap_sum(lrun);
    if (u.lse && hi == 0) u.lse[(size_t)q * u.lpitch] = mrun + __builtin_amdgcn_logf(ltot);
    if (MODE == 2) ltot += __builtin_amdgcn_exp2f(u.sink2 - mrun);
    if (hi == 0) wsf[32 + r32] = ltot;
    LDS_WAIT();
    float rli[16];
#pragma unroll
    for (int j = 0; j < 4; ++j) { const f32x4 f = *(const LAS f32x4*)(wsf + 32 + 8 * j + 4 * hi);
#pragma unroll
        for (int e = 0; e < 4; ++e) rli[4 * j + e] = __builtin_amdgcn_rcpf(f[e]); }
    { LAS bf16_t* stg = (LAS bf16_t*)(shm + LDS_OST) + wid * 2048;
#pragma unroll
      for (int r = 0; r < 16; ++r) { const int orow = crow(r, hi);
          stg[orow * 64 + r32] = (bf16_t)(cvtpk(o0[r] * rli[r], 0.f) & 0xffffu);
          stg[orow * 64 + 32 + r32] = (bf16_t)(cvtpk(o1[r] * rli[r], 0.f) & 0xffffu); }
      LDS_WAIT();
      bf16_t* Ow = u.O + (size_t)(u.q0 + wid * 32) * u.opitch;
#pragma unroll
      for (int i = 0; i < 4; ++i) { const int row = i * 8 + (lane >> 3), ch = lane & 7; const u32x4 v = *(const LAS u32x4*)(stg + row * 64 + ch * 8); *(u32x4*)(Ow + (size_t)row * u.opitch + ch * 8) = v; } }
    ATT_WAIT_BAR();
#undef ATT_ISSUE
#undef ATT_SOFT
}
}

#define XB_TMO      128
#define XB_XCNT(j)  (256  + 64 * (j))
#define XB_XSUB(j)  (1280 + 64 * (j))
#define XB_XGEN(j)  (2304 + 64 * (j))
#define XB_TOP      3328
#define XB_TOPGEN   3392
#define XCD_BAR_WORDS 3456
#define XB_SPIN_CAP (1u << 18)
__device__ __forceinline__ unsigned xb_ld(unsigned* p)              { return __hip_atomic_load(p, __ATOMIC_RELAXED, __HIP_MEMORY_SCOPE_AGENT); }
__device__ __forceinline__ unsigned xb_add(unsigned* p, unsigned v) { return __hip_atomic_fetch_add(p, v, __ATOMIC_RELAXED, __HIP_MEMORY_SCOPE_AGENT); }
__device__ __forceinline__ unsigned xb_xcc_id() { return (unsigned)__builtin_amdgcn_s_getreg((3 << 11) | 20) & 0xFu; }
#define XB_SPIN(cond, bar) do { unsigned _sp = 0; while (cond) { __builtin_amdgcn_s_sleep(1); \
    if ((++_sp & 255u) == 0u) { if (xb_ld(&(bar)[XB_TMO])) break; if (_sp > XB_SPIN_CAP) { atomicAdd(&(bar)[XB_TMO], 1u); break; } } } } while (0)
struct XcdBarrier { unsigned* bar; unsigned x; volatile LAS unsigned* st; };
__device__ __forceinline__ XcdBarrier xcd_barrier_post(unsigned* bar, volatile LAS unsigned* st) {
    XcdBarrier b; b.bar = bar; b.x = xb_xcc_id(); b.st = st;
    if (threadIdx.x == 0) (void)xb_add(&bar[XB_XCNT(b.x)], 1u);
    return b;
}
__device__ __forceinline__ void xcd_barrier_complete(unsigned* bar, unsigned x, unsigned& nloc, unsigned& nx) {
    const unsigned G = gridDim.x * gridDim.y * gridDim.z;
    unsigned sum, cnt, mine, sp = 0u;
    for (;;) {
        sum = 0u; cnt = 0u; mine = 0u;
#pragma unroll
        for (unsigned j = 0; j < 16; ++j) { const unsigned c = xb_ld(&bar[XB_XCNT(j)]); sum += c; cnt += (c > 0u) ? 1u : 0u; mine = (j == x) ? c : mine; }
        if (sum == G) break;
        __builtin_amdgcn_s_sleep(1);
        if ((++sp & 255u) == 0u) { if (xb_ld(&bar[XB_TMO])) break; if (sp > XB_SPIN_CAP) { atomicAdd(&bar[XB_TMO], 1u); break; } }
    }
    nloc = mine > 0u ? mine : 1u; nx = cnt > 0u ? cnt : 1u;
}
__device__ __forceinline__ void xcd_barrier(const XcdBarrier& b) {
    asm volatile("s_waitcnt vmcnt(0)" ::: "memory");
    __syncthreads();
    if (threadIdx.x == 0) {
        unsigned* bar = b.bar;
        __builtin_amdgcn_s_waitcnt(0);
        unsigned nloc = b.st[0], nx = b.st[1];
        if (nloc == 0u) { xcd_barrier_complete(bar, b.x, nloc, nx); b.st[0] = nloc; b.st[1] = nx; }
        const unsigned old = xb_add(&bar[XB_XSUB(b.x)], 1u);
        const unsigned gen = old / nloc;
        if (old + 1u == (gen + 1u) * nloc) {
            __builtin_amdgcn_fence(__ATOMIC_RELEASE, "agent");
            asm volatile("s_waitcnt vmcnt(0)" ::: "memory");
            const unsigned og = xb_add(&bar[XB_TOP], 1u);
            const unsigned tg = og / nx;
            if (og + 1u == (tg + 1u) * nx) xb_add(&bar[XB_TOPGEN], 1u);
            else XB_SPIN(xb_ld(&bar[XB_TOPGEN]) == tg, bar);
            __builtin_amdgcn_fence(__ATOMIC_ACQUIRE, "agent");
            xb_add(&bar[XB_XGEN(b.x)], 1u);
            asm volatile("s_waitcnt vmcnt(0)" ::: "memory");
        } else {
            XB_SPIN(xb_ld(&bar[XB_XGEN(b.x)]) == gen, bar);
            __builtin_amdgcn_fence(__ATOMIC_ACQUIRE, "agent");
            asm volatile("s_waitcnt vmcnt(0)" ::: "memory");
        }
    }
    __syncthreads();
}

struct Args {
    const float* x; const int* pos; const float* attn_norm; const float* w_in; const float* b_forget; const float* mla_q_norm; const float* w_q_up;
    const float* mla_kv_norm; const float* w_kv_up; const float* sinks; const float* w_out; const float* ffn_norm; const float* dense_w_gate; const float* dense_w_up;
    const float* dense_w_down; const float* router; const float* moe_w_gate; const float* moe_w_up; const float* moe_w_down; const float* final_norm;
    float* out; unsigned char* ws; int ph_lo, ph_hi;
};
struct Frame {
    LAS unsigned char* lds; int tid, lane, wave, G, c;
};

__device__ __forceinline__ int rope_perm(int j) { const int i = j & 15, t2 = j >> 4; return 8 * (i >> 2) + 4 * t2 + (i & 3); }
__device__ __forceinline__ int map_col(int kind, int n, float& sc) {
    sc = 1.0f;
    if (kind == 0) return n;
    if (kind == 1) {
        if (n < 256) { sc = C2_64; return Y_FQ + n; }
        if (n < 512) return Y_FK + (n - 256);
        if (n < 768) return Y_FV + (n - 512);
        if (n < 772) return Y_FF + (n - 768);
        if (n < 1028) { sc = C2_64; return Y_SQ + (n - 772); }
        if (n < 1156) return Y_SK + (n - 1028);
        if (n < 1284) return Y_SV + (n - 1156);
        if (n < 1540) return Y_CQ + (n - 1284);
        if (n < 1668) return Y_CKV + (n - 1540);
        if (n < 1700) return Y_KR + rope_perm(n - 1668);
        if (n < 1956) { sc = C2_64; return Y_DQ + (n - 1700); }
        if (n < 2212) return Y_DK + (n - 1956);
        if (n < 2468) return Y_DV + (n - 2212);
        return -1;
    }
    if (kind == 2) { sc = C2_96; const int h = n / 96, c = n % 96; return h * 96 + (c < 64 ? c : 64 + rope_perm(c - 64)); }
    if (kind == 3) return 256 * (n >> 7) + (n & 127);
    return 256 * (n >> 7) + 128 + (n & 127);
}
__device__ __forceinline__ void transpose_item(const float* W, int K, int N, bf16_t* WT, const float* gain, int kind, LAS float* scr, int item, int lane) {
    (void)scr;
    const int nblk = (N + 31) / 32, kblk = item / nblk, nb = item % nblk, kb = lane >> 3, ng = lane & 7;
    const int k0 = 64 * kblk + 8 * kb, n0 = 32 * nb + 4 * ng;
    if (n0 >= N) return;
    const float* src = W + (size_t)k0 * N + n0;
    f32x4 v[8];
#pragma unroll
    for (int e = 0; e < 8; ++e) v[e] = __builtin_nontemporal_load((const f32x4*)(src + (size_t)e * N));
    f32x4 g0 = {1.f, 1.f, 1.f, 1.f}, g1 = {1.f, 1.f, 1.f, 1.f};
    if (gain) { g0 = *(const f32x4*)(gain + k0); g1 = *(const f32x4*)(gain + k0 + 4); }
#pragma unroll
    for (int j = 0; j < 4; ++j) {
        float sc; const int dr = map_col(kind, n0 + j, sc);
        if (dr >= 0) {
            u32x4 o;
            o.x = cvtpk(v[0][j] * g0[0] * sc, v[1][j] * g0[1] * sc); o.y = cvtpk(v[2][j] * g0[2] * sc, v[3][j] * g0[3] * sc);
            o.z = cvtpk(v[4][j] * g1[0] * sc, v[5][j] * g1[1] * sc); o.w = cvtpk(v[6][j] * g1[2] * sc, v[7][j] * g1[3] * sc);
            *(u32x4*)(WT + (size_t)dr * K + k0) = o;
        }
    }
}
__device__ __forceinline__ void sincos_acc(double a, float& s, float& c) {
    const double n = rint(a * 0.63661977236758134308);
    double r = fma(-n, 1.5707963267948966192, a); r = fma(-n, 6.123233995736766e-17, r);
    const int qd = (int)((long long)n & 3);
    const float x = (float)r, x2 = x * x;
    const float sp = x + x * x2 * (-1.6666667163e-1f + x2 * (8.3333337680e-3f + x2 * (-1.9841270114e-4f + x2 * 2.7557314297e-6f)));
    const float cp = 1.0f + x2 * (-0.5f + x2 * (4.1666667908e-2f + x2 * (-1.3888889225e-3f + x2 * 2.4801587642e-5f)));
    s = (qd == 0) ? sp : (qd == 1) ? cp : (qd == 2) ? -sp : -cp;
    c = (qd == 0) ? cp : (qd == 1) ? -sp : (qd == 2) ? -cp : sp;
}

constexpr int NPH = 19;
typedef __attribute__((address_space(4))) const Args* ArgsP;
__device__ __forceinline__ ArgsP get_args() { ArgsP p = (ArgsP)__builtin_amdgcn_kernarg_segment_ptr(); asm volatile("" : "+s"(p)); return p; }
#define WSP(T_, off) ((T_*)(ws + (off)))

#if MK_ONE_LAUNCH
#define GRID_BAR() do { bar.bar = (unsigned*)(get_args()->ws + WS_CTL) + CW_BAR; xcd_barrier(bar); } while (0)
#else
#define GRID_BAR() do { } while (0)
#endif
#ifndef PHMASK
#define PHMASK 0x7ffff
#endif
#define IN(k) ((((PHMASK) >> (k)) & 1) && lo <= (k) && (k) < hi)
#define SEAM(k) do { if (IN(k) && IN((k) + 1)) GRID_BAR(); } while (0)
#if PROBE_REP >= 0
#define PH_BEGIN(k) if (IN(k)) for (int rep_ = 0; rep_ < (((k) == PROBE_REP) ? 2 : 1); ++rep_) { if (rep_) GRID_BAR();
#define PH_END }
#else
#define PH_BEGIN(k) if (IN(k)) {
#define PH_END }
#endif
#ifndef P2MASK
#define P2MASK 15
#endif

template <int l>
__device__ __forceinline__ void layer_fwd(const Frame& F0, const int lo, const int hi, XcdBarrier& bar) {
        constexpr int pb = 1 + 7 * l;
        PH_BEGIN(pb) {
            Frame F = F0; asm volatile("" : "+v"(F.tid)); F.lane = F.tid & 63; F.wave = __builtin_amdgcn_readfirstlane(F.tid >> 6);
            int cid = F.c, gsz = F.G; asm volatile("" : "+s"(cid), "+s"(gsz)); const int gw = cid * NWAVES + F.wave, NGW = gsz * NWAVES; (void)gw; (void)NGW;
            unsigned char* ws = get_args()->ws;
            pg8::Gemm g{WSP(bf16_t, WS_XB), WSP(bf16_t, WS_WIN) + (size_t)l * NY * D, D, D, D};
            pg8::SchedStatic S; S.o.init(T, NY, gsz, cid);
            pg8::EpiG1 E{WSP(bf16_t, WS_Y), l == 0 ? WSP(float, SM_RSTD0) : nullptr, WSP(float, SM_PART), WSP(float, SM_PARTQ), WSP(float, SM_PARTKV), WSP(float, SM_FF), WSP(bf16_t, WS_KM), WSP(float, SM_ROPE)};
            pg8::gemm_phase<pg8::EpiG1, pg8::SchedStatic, true>(F.lds, g, S, E);
        } PH_END
        SEAM(pb);
        PH_BEGIN(pb + 1) {
            Frame F = F0; asm volatile("" : "+v"(F.tid)); F.lane = F.tid & 63; F.wave = __builtin_amdgcn_readfirstlane(F.tid >> 6);
            int cid = F.c, gsz = F.G; asm volatile("" : "+s"(cid), "+s"(gsz)); const int gw = cid * NWAVES + F.wave, NGW = gsz * NWAVES; (void)gw; (void)NGW;
            if ((P2MASK & 1) && cid < 128) {
                unsigned char* ws = get_args()->ws;
                pg8::Gemm g{WSP(bf16_t, WS_Y) + Y_CQ, WSP(bf16_t, WS_WQUP) + (size_t)l * 512 * 256, NY, 256, 256};
                pg8::SchedOne S; S.has = true; S.un.pm = cid >> 1; S.un.pn = cid & 1; S.un.e = 0;
                pg8::EpiQup E{WSP(bf16_t, WS_QM), WSP(float, SM_PARTQ), WSP(float, SM_ROPE)};
                pg8::gemm_phase<pg8::EpiQup, pg8::SchedOne, false>(F.lds, g, S, E);
            } else if (P2MASK & 2) {
                unsigned char* ws = get_args()->ws;
                pg8::Gemm g{WSP(bf16_t, WS_Y) + Y_CKV, WSP(bf16_t, WS_WKVUP) + (size_t)l * 512 * 128, NY, 128, 128};
                pg8::SchedOne S; S.has = cid < 256; S.un.pm = (cid - 128) >> 1; S.un.pn = cid & 1; S.un.e = 0;
                pg8::EpiKVup E{WSP(bf16_t, WS_KM), WSP(bf16_t, WS_VM), WSP(float, SM_PARTKV)};
                pg8::gemm_phase<pg8::EpiKVup, pg8::SchedOne, false>(F.lds, g, S, E);
            }
            __syncthreads();
            if (P2MASK & 4) for (int sq = cid; sq < 8; sq += gsz) {
                ArgsP a = get_args(); unsigned char* ws = a->ws; const float* ffb = WSP(float, SM_FF); float* csl = WSP(float, SM_CSL);
                const int b = sq >> 2, h = sq & 3; const float bfv = a->b_forget[l * 4 + h];
                LAS double* sd = (LAS double*)F.lds;
                double loc[16]; double run = 0.0;
#pragma unroll
                for (int i = 0; i < 16; ++i) { const float z = ffb[(size_t)(b * SEQ + F.tid * 16 + i) * 4 + h] + bfv;
                    const float ls = fminf(z, 0.f) - log1pf(expf(-fabsf(z))); run += (double)ls; loc[i] = run; }
                double incl = run;
#pragma unroll
                for (int o = 1; o < 64; o <<= 1) { const double t = __shfl_up(incl, o); if (F.lane >= o) incl += t; }
                if (F.lane == 63) sd[F.wave] = incl;
                __syncthreads();
                double base = 0.0;
                for (int w = 0; w < F.wave; ++w) base += sd[w];
                const double excl = base + incl - run;
#pragma unroll
                for (int i = 0; i < 16; ++i) csl[(size_t)sq * SEQ + F.tid * 16 + i] = (float)((excl + loc[i]) * (double)LOG2E);
                __syncthreads();
            }
            {
                unsigned char* ws = get_args()->ws; const bf16_t* Y = WSP(bf16_t, WS_Y);
                float mq[2] = {0.f, 0.f}, mk[2] = {0.f, 0.f};
                for (int m = gw; m < T; m += NGW) {
                    const u32x2 qv = *(const u32x2*)(Y + (size_t)m * NY + Y_FQ + 4 * F.lane), kv = *(const u32x2*)(Y + (size_t)m * NY + Y_FK + 4 * F.lane);
                    float a0 = __uint_as_float(qv.x << 16), a1 = __uint_as_float(qv.x & 0xffff0000u), a2 = __uint_as_float(qv.y << 16), a3 = __uint_as_float(qv.y & 0xffff0000u);
                    float b0 = __uint_as_float(kv.x << 16), b1 = __uint_as_float(kv.x & 0xffff0000u), b2 = __uint_as_float(kv.y << 16), b3 = __uint_as_float(kv.y & 0xffff0000u);
                    float sq = (a0 * a0 + a1 * a1) + (a2 * a2 + a3 * a3), sk = (b0 * b0 + b1 * b1) + (b2 * b2 + b3 * b3);
#pragma unroll
                    for (int o = 1; o < 16; o <<= 1) { sq += __shfl_xor(sq, o); sk += __shfl_xor(sk, o); }
                    const int bb = m >= SEQ ? 1 : 0;
                    mq[0] = fmaxf(mq[0], bb ? 0.f : sq); mq[1] = fmaxf(mq[1], bb ? sq : 0.f); mk[0] = fmaxf(mk[0], bb ? 0.f : sk); mk[1] = fmaxf(mk[1], bb ? sk : 0.f);
                }
                LAS float* red = (LAS float*)F.lds;
                if ((F.lane & 15) == 0) { const int h = F.lane >> 4; LAS float* r = red + (F.wave * 4 + h) * 4; r[0] = mq[0]; r[1] = mk[0]; r[2] = mq[1]; r[3] = mk[1]; }
                __syncthreads();
                if (F.tid < 16) { const int h = F.tid >> 2, j = F.tid & 3; float v = 0.f;
                    for (int w = 0; w < 8; ++w) v = fmaxf(v, red[(w * 4 + h) * 4 + j]);
                    const int b = j >> 1, qk = j & 1;
                    atomicMax((unsigned*)((gu32*)(ws + WS_CTL) + CW_FMAX + ((l * 8 + b * 4 + h) * 2 + qk)), __float_as_uint(v)); }
                __syncthreads();
            }
            if (P2MASK & 8) for (int idx = cid; idx < 1024; idx += gsz) {
                ArgsP a = get_args(); unsigned char* ws = a->ws; const bf16_t* Y = WSP(bf16_t, WS_Y);
                att::AU u;
                if (idx < 256) {
                    const int b = idx >> 7, hq = (idx >> 5) & 3, qb = idx & 31;
                    const bf16_t* yb = Y + (size_t)b * SEQ * NY;
                    u.Q = yb + Y_SQ + hq * 64; u.K = yb + Y_SK + (hq >> 1) * 64; u.V = yb + Y_SV + (hq >> 1) * 64; u.qpitch = u.kpitch = u.vpitch = NY;
                    u.O = WSP(bf16_t, WS_MIX) + (size_t)b * SEQ * D + 256 + hq * 64; u.opitch = D; u.lse = nullptr; u.lpitch = 0; u.colb = nullptr;
                    u.q0 = qb * 256; u.span = 127; u.alibi = exp2f(-(float)(hq + 1)) * LOG2E; u.sink2 = a->sinks[l * 4 + hq] * LOG2E;
                } else {
                    const int p = (idx - 256) >> 8, rem = (idx - 256) & 255, b = rem >> 7, h = (rem >> 5) & 3, j = rem & 31;
                    const int dil = (p == 0) ? 1 : (p == 1) ? 4 : 16, nqb = (SEQ / dil) / 256, r = j / nqb, qb = j % nqb;
                    const bf16_t* yb = Y + (size_t)(b * SEQ + r) * NY;
                    u.Q = yb + Y_DQ + h * 64; u.K = yb + Y_DK + h * 64; u.V = yb + Y_DV + h * 64; u.qpitch = u.kpitch = u.vpitch = dil * NY;
                    u.O = WSP(bf16_t, WS_DP) + (size_t)p * T * 256 + (size_t)(b * SEQ + r) * 256 + h * 64; u.opitch = dil * 256;
                    u.lse = WSP(float, WS_DL) + (size_t)p * T * 4 + (size_t)(b * SEQ + r) * 4 + h; u.lpitch = dil * 4; u.colb = nullptr;
                    u.q0 = qb * 256; u.span = 128; u.alibi = exp2f(-(float)(h + 5)) * (float)dil * LOG2E; u.sink2 = -INFINITY;
                }
                u.kt0 = u.q0 / 64 - 2; if (u.kt0 < 0) u.kt0 = 0; u.kt1 = u.q0 / 64 + 4;
                att::attn_unit<4, 2, 6>(u, F.lds);
            }
        } PH_END
        SEAM(pb + 1);
        PH_BEGIN(pb + 2) {
            Frame F = F0; asm volatile("" : "+v"(F.tid)); F.lane = F.tid & 63; F.wave = __builtin_amdgcn_readfirstlane(F.tid >> 6);
            int cid = F.c, gsz = F.G; asm volatile("" : "+s"(cid), "+s"(gsz)); const int gw = cid * NWAVES + F.wave, NGW = gsz * NWAVES; (void)gw; (void)NGW;
            LAS unsigned* qslot = (LAS unsigned*)(F.lds + LDSCTL_OFF + 64);
            for (;;) {
                unsigned char* ws = get_args()->ws;
#if PROBE_REP >= 0
                const int qrep = rep_;
#else
                const int qrep = 0;
#endif
                if (F.tid == 0) *qslot = __hip_atomic_fetch_add((gu32*)(ws + WS_CTL) + CW_QUEUE + 64 * (l + 2 * qrep), 1u, RLX_AGENT);
                __syncthreads();
                const int idx = (int)*qslot;
                __syncthreads();
                if (idx >= 896) break;
                att::AU u; u.span = 1 << 30; u.alibi = 0.f; u.sink2 = -INFINITY; u.xthr = 0.f;
                if (idx < 640) {
                    int bh, qb, c;
                    if (idx < 192) { bh = idx & 7; const int r = idx >> 3; c = r % 3; qb = 24 + r / 3; }
                    else if (idx < 320) { const int n = idx - 192; bh = n & 7; const int r = n >> 3; c = r & 1; qb = 16 + (r >> 1); }
                    else if (idx < 384) { const int n = idx - 320; bh = n & 7; qb = 8 + (n >> 3); c = 0; }
                    else { const int n = idx - 384, sz = n >> 5, m = n & 31; bh = m & 7; c = m >> 3; qb = 8 * c + (7 - sz); }
                    const int b = bh >> 2, h = bh & 3;
                    u.q0 = qb * 256; u.kt0 = 32 * c; u.kt1 = 4 * qb + 4 < 32 * c + 32 ? 4 * qb + 4 : 32 * c + 32;
                    u.Q = WSP(bf16_t, WS_QM) + (size_t)b * SEQ * 384 + h * 96; u.K = WSP(bf16_t, WS_KM) + (size_t)b * SEQ * 384 + h * 96; u.V = WSP(bf16_t, WS_VM) + (size_t)b * SEQ * 256 + h * 64;
                    u.qpitch = 384; u.kpitch = 384; u.vpitch = 256; u.colb = nullptr;
                    u.O = WSP(bf16_t, WS_MP) + (size_t)c * T * 256 + (size_t)b * SEQ * 256 + h * 64; u.opitch = 256;
                    u.lse = WSP(float, WS_ML) + (size_t)c * T * 4 + (size_t)b * SEQ * 4 + h; u.lpitch = 4;
                    att::attn_unit<6, 0, 6>(u, F.lds);
                } else {
                    const int n = idx - 640, qb = 31 - (n >> 3), bh = n & 7, b = bh >> 2, h = bh & 3;
                    const bf16_t* yb = WSP(bf16_t, WS_Y) + (size_t)b * SEQ * NY;
                    u.lse = nullptr; u.lpitch = 0; u.q0 = qb * 256; u.kt0 = 0; u.kt1 = 4 * qb + 4; u.opitch = D;
                    u.Q = yb + Y_FQ + h * 64; u.K = yb + Y_FK + h * 64; u.V = yb + Y_FV + h * 64; u.qpitch = u.kpitch = u.vpitch = NY;
                    u.O = WSP(bf16_t, WS_MIX) + (size_t)b * SEQ * D + h * 64; u.colb = WSP(float, SM_CSL) + (size_t)bh * SEQ;
                    const gu32* fm = (const gu32*)(ws + WS_CTL) + CW_FMAX + (l * 8 + bh) * 2;
                    u.xthr = FOX_THRESH + 2.0f * sqrtf(__uint_as_float(fm[0]) * __uint_as_float(fm[1])) * 1.0001f + 1.0f;
                    att::attn_unit<4, 1, 5>(u, F.lds);
                }
            }
        } PH_END
        SEAM(pb + 2);
        PH_BEGIN(pb + 3) {
            Frame F = F0; asm volatile("" : "+v"(F.tid)); F.lane = F.tid & 63; F.wave = __builtin_amdgcn_readfirstlane(F.tid >> 6);
            int cid = F.c, gsz = F.G; asm volatile("" : "+s"(cid), "+s"(gsz)); const int gw = cid * NWAVES + F.wave, NGW = gsz * NWAVES; (void)gw; (void)NGW;
            unsigned char* ws = get_args()->ws;
            const bf16_t* Dp = WSP(bf16_t, WS_DP); const float* Dl = WSP(float, WS_DL); const bf16_t* Mp = WSP(bf16_t, WS_MP); const float* Ml = WSP(float, WS_ML); bf16_t* MIX = WSP(bf16_t, WS_MIX);
            for (int blk = cid; blk < T / 64; blk += gsz) {
                const int t = blk * 64 + (F.tid >> 3), dc = F.tid & 7;
                const int np = (((t & (SEQ - 1)) >> 8) >> 3) + 1;
#pragma unroll
                for (int h = 0; h < 4; ++h) {
                    {
                        const float l0 = Dl[(size_t)t * 4 + h], l1 = Dl[(size_t)(T + t) * 4 + h], l2 = Dl[(size_t)(2 * T + t) * 4 + h];
                        const float mx = fmaxf(l0, fmaxf(l1, l2));
                        float w0 = __builtin_amdgcn_exp2f(l0 - mx), w1 = __builtin_amdgcn_exp2f(l1 - mx), w2 = __builtin_amdgcn_exp2f(l2 - mx);
                        const float inv = 1.0f / (w0 + w1 + w2); w0 *= inv; w1 *= inv; w2 *= inv;
                        const u32x4 a0 = *(const u32x4*)(Dp + (size_t)t * 256 + h * 64 + dc * 8), a1 = *(const u32x4*)(Dp + (size_t)(T + t) * 256 + h * 64 + dc * 8),
                                    a2 = *(const u32x4*)(Dp + (size_t)(2 * T + t) * 256 + h * 64 + dc * 8);
                        u32x4 o;
#pragma unroll
                        for (int e = 0; e < 4; ++e) {
                            const float lo_ = w0 * __uint_as_float(a0[e] << 16) + w1 * __uint_as_float(a1[e] << 16) + w2 * __uint_as_float(a2[e] << 16);
                            const float hi_ = w0 * __uint_as_float(a0[e] & 0xffff0000u) + w1 * __uint_as_float(a1[e] & 0xffff0000u) + w2 * __uint_as_float(a2[e] & 0xffff0000u);
                            o[e] = cvtpk(lo_, hi_);
                        }
                        *(u32x4*)(MIX + (size_t)t * D + 768 + h * 64 + dc * 8) = o;
                    }
                    {
                        float lw[4]; float mx = -INFINITY;
#pragma unroll
                        for (int p = 0; p < 4; ++p) { lw[p] = (p < np) ? Ml[(size_t)(p * T + t) * 4 + h] : -INFINITY; mx = fmaxf(mx, lw[p]); }
                        float sw = 0.f;
#pragma unroll
                        for (int p = 0; p < 4; ++p) { lw[p] = __builtin_amdgcn_exp2f(lw[p] - mx); sw += lw[p]; }
                        const float inv = 1.0f / sw;
                        float acc[8] = {0.f, 0.f, 0.f, 0.f, 0.f, 0.f, 0.f, 0.f};
#pragma unroll
                        for (int p = 0; p < 4; ++p) if (p < np) {
                            const u32x4 av = *(const u32x4*)(Mp + (size_t)(p * T + t) * 256 + h * 64 + dc * 8); const float w = lw[p] * inv;
#pragma unroll
                            for (int e = 0; e < 4; ++e) { acc[2 * e] += w * __uint_as_float(av[e] << 16); acc[2 * e + 1] += w * __uint_as_float(av[e] & 0xffff0000u); }
                        }
                        u32x4 o; o.x = cvtpk(acc[0], acc[1]); o.y = cvtpk(acc[2], acc[3]); o.z = cvtpk(acc[4], acc[5]); o.w = cvtpk(acc[6], acc[7]);
                        *(u32x4*)(MIX + (size_t)t * D + 512 + h * 64 + dc * 8) = o;
                    }
                }
            }
        } PH_END
        SEAM(pb + 3);
        PH_BEGIN(pb + 4) {
            Frame F = F0; asm volatile("" : "+v"(F.tid)); F.lane = F.tid & 63; F.wave = __builtin_amdgcn_readfirstlane(F.tid >> 6);
            int cid = F.c, gsz = F.G; asm volatile("" : "+s"(cid), "+s"(gsz)); const int gw = cid * NWAVES + F.wave, NGW = gsz * NWAVES; (void)gw; (void)NGW;
            ArgsP a = get_args(); unsigned char* ws = a->ws;
            pg8::Gemm g{WSP(bf16_t, WS_MIX), WSP(bf16_t, WS_WOUT) + (size_t)l * D * D, D, D, D};
            pg8::SchedStatic S; S.o.init(T, D, gsz, cid);
            pg8::EpiRes E{l == 0 ? a->x : a->out, a->out, l == 0 ? WSP(bf16_t, WS_XB) : nullptr, WSP(float, SM_PART)};
            pg8::gemm_phase<pg8::EpiRes, pg8::SchedStatic, true>(F.lds, g, S, E);
        } PH_END
        SEAM(pb + 4);
        if (l == 0) {
            PH_BEGIN(6) {
            Frame F = F0; asm volatile("" : "+v"(F.tid)); F.lane = F.tid & 63; F.wave = __builtin_amdgcn_readfirstlane(F.tid >> 6);
            int cid = F.c, gsz = F.G; asm volatile("" : "+s"(cid), "+s"(gsz)); const int gw = cid * NWAVES + F.wave, NGW = gsz * NWAVES; (void)gw; (void)NGW;
                unsigned char* ws = get_args()->ws;
                pg8::Gemm g{WSP(bf16_t, WS_XB), WSP(bf16_t, WS_WGU0), D, D, D};
                pg8::SchedStatic S; S.o.init(T, 2 * FF, gsz, cid);
                pg8::EpiSwiglu E{WSP(bf16_t, WS_HID), nullptr, WSP(float, SM_PART)};
                pg8::gemm_phase<pg8::EpiSwiglu, pg8::SchedStatic, true>(F.lds, g, S, E);
            } PH_END
            SEAM(6);
            PH_BEGIN(7) {
            Frame F = F0; asm volatile("" : "+v"(F.tid)); F.lane = F.tid & 63; F.wave = __builtin_amdgcn_readfirstlane(F.tid >> 6);
            int cid = F.c, gsz = F.G; asm volatile("" : "+s"(cid), "+s"(gsz)); const int gw = cid * NWAVES + F.wave, NGW = gsz * NWAVES; (void)gw; (void)NGW;
                ArgsP a = get_args(); unsigned char* ws = a->ws;
                pg8::Gemm g{WSP(bf16_t, WS_HID), WSP(bf16_t, WS_WD0), FF, FF, FF};
                pg8::SchedStatic S; S.o.init(T, D, gsz, cid);
                pg8::EpiRes E{a->out, a->out, WSP(bf16_t, WS_XB), WSP(float, SM_PART)};
                pg8::gemm_phase<pg8::EpiRes, pg8::SchedStatic, true>(F.lds, g, S, E);
            } PH_END
            SEAM(7);
        }
}

__global__ void __launch_bounds__(NWAVES * 64, 2) mega_fwd(Args a_unused) {
    extern __shared__ __attribute__((aligned(16))) unsigned char lds_raw[];
    Frame F0;
    F0.lds = (LAS unsigned char*)lds_raw;
    F0.tid = threadIdx.x; F0.lane = F0.tid & 63; F0.wave = __builtin_amdgcn_readfirstlane(F0.tid >> 6);
    F0.G = gridDim.x; F0.c = blockIdx.x;
    volatile LAS unsigned* MISC = (volatile LAS unsigned*)(F0.lds + MISC_OFF);
    for (int u = F0.tid; u < (LDS_BYTES - LDSCTL_OFF) / 4; u += NWAVES * 64) ((LAS unsigned*)(F0.lds + LDSCTL_OFF))[u] = 0u;
    __syncthreads();
#if MK_ONE_LAUNCH
    XcdBarrier bar = xcd_barrier_post((unsigned*)(get_args()->ws + WS_CTL) + CW_BAR, MISC + 8);
#else
    XcdBarrier bar; bar.bar = nullptr; bar.x = 0; bar.st = MISC + 8;
#endif
    const int lo = get_args()->ph_lo, hi = get_args()->ph_hi;

    PH_BEGIN(0) {
            Frame F = F0; asm volatile("" : "+v"(F.tid)); F.lane = F.tid & 63; F.wave = __builtin_amdgcn_readfirstlane(F.tid >> 6);
            int cid = F.c, gsz = F.G; asm volatile("" : "+s"(cid), "+s"(gsz)); const int gw = cid * NWAVES + F.wave, NGW = gsz * NWAVES; (void)gw; (void)NGW;
        ArgsP a = get_args(); unsigned char* ws = a->ws;
        LAS float* scr = (LAS float*)(F.lds + F.wave * 16384);
        bf16_t* Win_t = WSP(bf16_t, WS_WIN); bf16_t* Wqup_t = WSP(bf16_t, WS_WQUP); bf16_t* Wkvup_t = WSP(bf16_t, WS_WKVUP); bf16_t* Wout_t = WSP(bf16_t, WS_WOUT);
        bf16_t* Wgu0_t = WSP(bf16_t, WS_WGU0); bf16_t* Wd0_t = WSP(bf16_t, WS_WD0); bf16_t* Wgu1_t = WSP(bf16_t, WS_WGU1);
        constexpr int I_IN = 16 * 78, I_QU = 4 * 12, I_KV = 2 * 16, I_WO = 16 * 32, I_GU = 16 * 112, I_DN = 56 * 32;
        constexpr int NIT = 2 * I_IN + 2 * I_QU + 2 * I_KV + 2 * I_WO + 2 * I_GU + I_DN + 16 * I_GU;
        for (int it = gw; it < NIT; it += NGW) {
            int r = it;
            if (r < 2 * I_IN) { const int l = r / I_IN; transpose_item(a->w_in + (size_t)l * D * NIN, D, NIN, Win_t + (size_t)l * NY * D, a->attn_norm + l * D, 1, scr, r % I_IN, F.lane); continue; } r -= 2 * I_IN;
            if (r < 2 * I_QU) { const int l = r / I_QU; transpose_item(a->w_q_up + (size_t)l * 256 * 384, 256, 384, Wqup_t + (size_t)l * 512 * 256, a->mla_q_norm + l * 256, 2, scr, r % I_QU, F.lane); continue; } r -= 2 * I_QU;
            if (r < 2 * I_KV) { const int l = r / I_KV; transpose_item(a->w_kv_up + (size_t)l * 128 * 512, 128, 512, Wkvup_t + (size_t)l * 512 * 128, a->mla_kv_norm + l * 128, 0, scr, r % I_KV, F.lane); continue; } r -= 2 * I_KV;
            if (r < 2 * I_WO) { const int l = r / I_WO; transpose_item(a->w_out + (size_t)l * D * D, D, D, Wout_t + (size_t)l * D * D, nullptr, 0, scr, r % I_WO, F.lane); continue; } r -= 2 * I_WO;
            if (r < I_GU) { transpose_item(a->dense_w_gate, D, FF, Wgu0_t, a->ffn_norm, 3, scr, r, F.lane); continue; } r -= I_GU;
            if (r < I_GU) { transpose_item(a->dense_w_up, D, FF, Wgu0_t, a->ffn_norm, 4, scr, r, F.lane); continue; } r -= I_GU;
            if (r < I_DN) { transpose_item(a->dense_w_down, FF, D, Wd0_t, nullptr, 0, scr, r, F.lane); continue; } r -= I_DN;
            if (r < 8 * I_GU) { const int e = r / I_GU; transpose_item(a->moe_w_gate + (size_t)e * D * FF, D, FF, Wgu1_t + (size_t)e * 2 * FF * D, a->ffn_norm + D, 3, scr, r % I_GU, F.lane); continue; } r -= 8 * I_GU;
            { const int e = r / I_GU; transpose_item(a->moe_w_up + (size_t)e * D * FF, D, FF, Wgu1_t + (size_t)e * 2 * FF * D, a->ffn_norm + D, 4, scr, r % I_GU, F.lane); }
        }
        const float* x = a->x; const int* pos = a->pos; bf16_t* XB = WSP(bf16_t, WS_XB); float* rstd0 = WSP(float, SM_RSTD0); float* rope = WSP(float, SM_ROPE);
        for (int m = gw; m < T; m += NGW) {
            const f32x4* xr = (const f32x4*)(x + (size_t)m * D) + F.lane;
            f32x4 v[4]; float s = 0.f;
#pragma unroll
            for (int j = 0; j < 4; ++j) { v[j] = xr[64 * j]; s += (v[j][0] * v[j][0] + v[j][1] * v[j][1]) + (v[j][2] * v[j][2] + v[j][3] * v[j][3]); }
            s = wave_sum(s);
            u32x2* o8 = (u32x2*)(XB + (size_t)m * D) + F.lane;
#pragma unroll
            for (int j = 0; j < 4; ++j) { u32x2 w; w.x = cvtpk(v[j][0], v[j][1]); w.y = cvtpk(v[j][2], v[j][3]); o8[64 * j] = w; }
            if (F.lane == 0) rstd0[m] = 1.0f / sqrtf(s * (1.0f / D) + EPS);
            if (F.lane < 16) {
                const float invf = powf(10000.0f, -(float)F.lane / 16.0f);
                const float ang = (float)pos[m] * invf;
                float sn, cs; sincos_acc((double)ang, sn, cs);
                *(f32x2*)(rope + (size_t)m * 32 + 2 * F.lane) = (f32x2){cs, sn};
            }
        }
    } PH_END
    SEAM(0);

    layer_fwd<0>(F0, lo, hi, bar);
    layer_fwd<1>(F0, lo, hi, bar);
    PH_BEGIN(13) {
            Frame F = F0; asm volatile("" : "+v"(F.tid)); F.lane = F.tid & 63; F.wave = __builtin_amdgcn_readfirstlane(F.tid >> 6);
            int cid = F.c, gsz = F.G; asm volatile("" : "+s"(cid), "+s"(gsz)); const int gw = cid * NWAVES + F.wave, NGW = gsz * NWAVES; (void)gw; (void)NGW;
        ArgsP a = get_args(); unsigned char* ws = a->ws; const float* xres = a->out;
        int* tok_e = WSP(int, SM_TOKE); float* tok_g = WSP(float, SM_TOKG); float* rstd_tok = WSP(float, SM_RSTDT); int* histg = WSP(int, SM_HIST);
        LAS float* Rg = (LAS float*)F.lds;
        LAS int* hist = (LAS int*)(F.lds + 32768);
        for (int i = F.tid; i < D * 8; i += 512) Rg[i] = a->router[i] * a->ffn_norm[D + (i >> 3)];
        for (int ch = cid; ch < 256; ch += gsz) {
            if (F.tid < 8) hist[F.tid] = 0;
            __syncthreads();
            for (int j = 0; j < 8; ++j) {
                const int t = ch * 64 + F.wave * 8 + j;
                const f32x4* xr = (const f32x4*)(xres + (size_t)t * D) + F.lane;
                float acc[8] = {0.f, 0.f, 0.f, 0.f, 0.f, 0.f, 0.f, 0.f}; float ss = 0.f;
#pragma unroll
                for (int jj = 0; jj < 4; ++jj) { const f32x4 v = xr[64 * jj];
#pragma unroll
                    for (int e4 = 0; e4 < 4; ++e4) { const int k = 4 * F.lane + 256 * jj + e4; const float xv = v[e4]; ss += xv * xv;
                        const f32x4 r0 = *(const LAS f32x4*)(Rg + k * 8), r1 = *(const LAS f32x4*)(Rg + k * 8 + 4);
#pragma unroll
                        for (int e = 0; e < 4; ++e) { acc[e] += xv * r0[e]; acc[4 + e] += xv * r1[e]; } } }
                ss = wave_sum(ss);
#pragma unroll
                for (int e = 0; e < 8; ++e) acc[e] = wave_sum(acc[e]);
                const float rs = 1.0f / sqrtf(ss * (1.0f / D) + EPS);
                float v1 = -INFINITY; int e1 = 0;
#pragma unroll
                for (int e = 0; e < 8; ++e) { const float lg = acc[e] * rs; if (lg > v1) { v1 = lg; e1 = e; } }
                float v2 = -INFINITY; int e2 = 0;
#pragma unroll
                for (int e = 0; e < 8; ++e) { const float lg = acc[e] * rs; if (e != e1 && lg > v2) { v2 = lg; e2 = e; } }
                const float g1 = 1.0f / (1.0f + expf(v2 - v1));
                if (F.lane == 0) { tok_e[2 * t] = e1; tok_e[2 * t + 1] = e2; tok_g[2 * t] = g1; tok_g[2 * t + 1] = 1.0f - g1; rstd_tok[t] = rs;
                    atomicAdd((int*)&hist[e1], 1); atomicAdd((int*)&hist[e2], 1); }
            }
            __syncthreads();
            if (F.tid < 8) histg[ch * 8 + F.tid] = hist[F.tid];
            __syncthreads();
        }
    } PH_END
    SEAM(13);
    PH_BEGIN(14) {
            Frame F = F0; asm volatile("" : "+v"(F.tid)); F.lane = F.tid & 63; F.wave = __builtin_amdgcn_readfirstlane(F.tid >> 6);
            int cid = F.c, gsz = F.G; asm volatile("" : "+s"(cid), "+s"(gsz)); const int gw = cid * NWAVES + F.wave, NGW = gsz * NWAVES; (void)gw; (void)NGW;
        ArgsP a = get_args(); unsigned char* ws = a->ws; const float* xres = a->out;
        const int* tok_e = WSP(int, SM_TOKE); const float* rstd_tok = WSP(float, SM_RSTDT); const int* histg = WSP(int, SM_HIST);
        int* slot = WSP(int, SM_SLOT); float* rstdg = WSP(float, SM_RSTDG); int* moetab = WSP(int, SM_MOETAB); bf16_t* XG = WSP(bf16_t, WS_XG);
        LAS int* tot = (LAS int*)F.lds; LAS int* pre = tot + 8; LAS int* rows = tot + 16;
        for (int ch = cid; ch < 256; ch += gsz) {
            if (F.tid < 16) tot[F.tid] = 0;
            __syncthreads();
            { const int cch = F.tid >> 1, e0 = (F.tid & 1) * 4;
#pragma unroll
              for (int e = 0; e < 4; ++e) { const int v = histg[cch * 8 + e0 + e]; atomicAdd((int*)&tot[e0 + e], v); if (cch < ch) atomicAdd((int*)&pre[e0 + e], v); } }
            __syncthreads();
            int tbase[9]; tbase[0] = 0;
#pragma unroll
            for (int e = 0; e < 8; ++e) tbase[e + 1] = tbase[e] + (tot[e] + 255) / 256;
            if (ch == 0 && F.tid == 0) {
#pragma unroll
                for (int e = 0; e < 9; ++e) moetab[e] = tbase[e];
            }
            if (F.wave == 0) {
                const int t = ch * 64 + F.lane; const int e1 = tok_e[2 * t], e2 = tok_e[2 * t + 1];
                int r1 = 0, r2 = 0;
#pragma unroll
                for (int e = 0; e < 8; ++e) {
                    const unsigned long long mk = __ballot(e1 == e || e2 == e);
                    const int rank = __popcll(mk & ((1ull << F.lane) - 1ull));
                    const int row = tbase[e] * 256 + pre[e] + rank;
                    if (e1 == e) r1 = row; if (e2 == e) r2 = row;
                }
                slot[2 * t] = r1; slot[2 * t + 1] = r2; rows[2 * F.lane] = r1; rows[2 * F.lane + 1] = r2;
                const float rs = rstd_tok[t]; rstdg[r1] = rs; rstdg[r2] = rs;
            }
            __syncthreads();
            for (int j = 0; j < 8; ++j) {
                const int tl = F.wave * 8 + j, t = ch * 64 + tl; const int r1 = rows[2 * tl], r2 = rows[2 * tl + 1];
                const f32x4* xr = (const f32x4*)(xres + (size_t)t * D) + F.lane;
                u32x2* o1 = (u32x2*)(XG + (size_t)r1 * D) + F.lane; u32x2* o2 = (u32x2*)(XG + (size_t)r2 * D) + F.lane;
#pragma unroll
                for (int jj = 0; jj < 4; ++jj) { const f32x4 v = xr[64 * jj]; u32x2 w; w.x = cvtpk(v[0], v[1]); w.y = cvtpk(v[2], v[3]); o1[64 * jj] = w; o2[64 * jj] = w; }
            }
            __syncthreads();
        }
    } PH_END
    SEAM(14);
    PH_BEGIN(15) {
            Frame F = F0; asm volatile("" : "+v"(F.tid)); F.lane = F.tid & 63; F.wave = __builtin_amdgcn_readfirstlane(F.tid >> 6);
            int cid = F.c, gsz = F.G; asm volatile("" : "+s"(cid), "+s"(gsz)); const int gw = cid * NWAVES + F.wave, NGW = gsz * NWAVES; (void)gw; (void)NGW;
        unsigned char* ws = get_args()->ws; const int* moetab = WSP(int, SM_MOETAB);
        pg8::Gemm g{WSP(bf16_t, WS_XG), WSP(bf16_t, WS_WGU1), D, D, D};
        pg8::SchedMoe S;
#pragma unroll
        for (int e = 0; e < 9; ++e) S.tb[e] = __builtin_amdgcn_readfirstlane(moetab[e]);
        S.o.init(S.tb[8] * 256, 2 * FF, gsz, cid); S.estride = (size_t)2 * FF * D * 2;
        pg8::EpiSwiglu E{WSP(bf16_t, WS_HG), WSP(float, SM_RSTDG), nullptr};
        pg8::gemm_phase<pg8::EpiSwiglu, pg8::SchedMoe, true>(F.lds, g, S, E);
    } PH_END
    SEAM(15);
    PH_BEGIN(16) {
            Frame F = F0; asm volatile("" : "+v"(F.tid)); F.lane = F.tid & 63; F.wave = __builtin_amdgcn_readfirstlane(F.tid >> 6);
            int cid = F.c, gsz = F.G; asm volatile("" : "+s"(cid), "+s"(gsz)); const int gw = cid * NWAVES + F.wave, NGW = gsz * NWAVES; (void)gw; (void)NGW;
        ArgsP a = get_args(); unsigned char* ws = a->ws;
        LAS float* scr = (LAS float*)(F.lds + F.wave * 16384);
        constexpr int I_DN = 56 * 32;
        for (int it = gw; it < 8 * I_DN; it += NGW) { const int e = it / I_DN; transpose_item(a->moe_w_down + (size_t)e * FF * D, FF, D, WSP(bf16_t, WS_WD1) + (size_t)e * D * FF, nullptr, 0, scr, it % I_DN, F.lane); }
    } PH_END
    SEAM(16);
    PH_BEGIN(17) {
            Frame F = F0; asm volatile("" : "+v"(F.tid)); F.lane = F.tid & 63; F.wave = __builtin_amdgcn_readfirstlane(F.tid >> 6);
            int cid = F.c, gsz = F.G; asm volatile("" : "+s"(cid), "+s"(gsz)); const int gw = cid * NWAVES + F.wave, NGW = gsz * NWAVES; (void)gw; (void)NGW;
        unsigned char* ws = get_args()->ws; const int* moetab = WSP(int, SM_MOETAB);
        pg8::Gemm g{WSP(bf16_t, WS_HG), WSP(bf16_t, WS_WD1), FF, FF, FF};
        pg8::SchedMoe S;
#pragma unroll
        for (int e = 0; e < 9; ++e) S.tb[e] = __builtin_amdgcn_readfirstlane(moetab[e]);
        S.o.init(S.tb[8] * 256, D, gsz, cid); S.estride = (size_t)D * FF * 2;
        pg8::EpiY E{WSP(bf16_t, WS_XG)};
        pg8::gemm_phase<pg8::EpiY, pg8::SchedMoe, true>(F.lds, g, S, E);
    } PH_END
    SEAM(17);
    PH_BEGIN(18) {
            Frame F = F0; asm volatile("" : "+v"(F.tid)); F.lane = F.tid & 63; F.wave = __builtin_amdgcn_readfirstlane(F.tid >> 6);
            int cid = F.c, gsz = F.G; asm volatile("" : "+s"(cid), "+s"(gsz)); const int gw = cid * NWAVES + F.wave, NGW = gsz * NWAVES; (void)gw; (void)NGW;
        ArgsP a = get_args(); unsigned char* ws = a->ws; float* out = a->out; const float* fn = a->final_norm;
        const int* slot = WSP(int, SM_SLOT); const float* tok_g = WSP(float, SM_TOKG); const bf16_t* YG = WSP(bf16_t, WS_XG);
        for (int t = gw; t < T; t += NGW) {
            const f32x4* xr = (const f32x4*)(out + (size_t)t * D) + F.lane;
            const int r1 = slot[2 * t], r2 = slot[2 * t + 1]; const float g1 = tok_g[2 * t], g2 = tok_g[2 * t + 1];
            const u32x2* y1 = (const u32x2*)(YG + (size_t)r1 * D) + F.lane; const u32x2* y2 = (const u32x2*)(YG + (size_t)r2 * D) + F.lane;
            f32x4 v[4]; float s = 0.f;
#pragma unroll
            for (int j = 0; j < 4; ++j) { v[j] = xr[64 * j]; const u32x2 p = y1[64 * j], q = y2[64 * j];
                v[j][0] += g1 * __uint_as_float(p.x << 16) + g2 * __uint_as_float(q.x << 16);
                v[j][1] += g1 * __uint_as_float(p.x & 0xffff0000u) + g2 * __uint_as_float(q.x & 0xffff0000u);
                v[j][2] += g1 * __uint_as_float(p.y << 16) + g2 * __uint_as_float(q.y << 16);
                v[j][3] += g1 * __uint_as_float(p.y & 0xffff0000u) + g2 * __uint_as_float(q.y & 0xffff0000u);
                s += (v[j][0] * v[j][0] + v[j][1] * v[j][1]) + (v[j][2] * v[j][2] + v[j][3] * v[j][3]); }
            s = wave_sum(s);
            const float rs = 1.0f / sqrtf(s * (1.0f / D) + EPS);
            f32x4* o = (f32x4*)(out + (size_t)t * D) + F.lane; const f32x4* gn = (const f32x4*)fn + F.lane;
#pragma unroll
            for (int j = 0; j < 4; ++j) o[64 * j] = v[j] * rs * gn[64 * j];
        }
    } PH_END
#undef IN
#undef SEAM
}

extern "C" void kernel_launch(void* const* d_in, const int* in_sizes, int n_in, void* d_out, int out_size, void* d_ws, size_t ws_size, hipStream_t stream) {
    static int grid = 0;
    if (grid == 0) {
        int dev = 0, cus = 0;
        if (n_in != 20 || ws_size < WS_END) { fprintf(stderr, "kernel_launch: unexpected inputs (n_in %d, ws %zu)\n", n_in, ws_size); grid = -1; return; }
        if (hipGetDevice(&dev) != hipSuccess || hipDeviceGetAttribute(&cus, hipDeviceAttributeMultiprocessorCount, dev) != hipSuccess) { grid = -1; return; }
        if (hipFuncSetAttribute((const void*)mega_fwd, hipFuncAttributeMaxDynamicSharedMemorySize, LDS_BYTES) != hipSuccess) { grid = -1; return; }
        int per_cu = 0;
        (void)hipOccupancyMaxActiveBlocksPerMultiprocessor(&per_cu, (const void*)mega_fwd, NWAVES * 64, LDS_BYTES);
        (void)hipGetLastError();
        grid = cus;
    }
    if (grid < 0) return;
    (void)hipMemsetAsync((char*)d_ws + WS_CTL, 0, CTL_ZERO_BYTES, stream);
    Args a{};
    a.x = (const float*)d_in[0]; a.pos = (const int*)d_in[1]; a.attn_norm = (const float*)d_in[2]; a.w_in = (const float*)d_in[3]; a.b_forget = (const float*)d_in[4];
    a.mla_q_norm = (const float*)d_in[5]; a.w_q_up = (const float*)d_in[6]; a.mla_kv_norm = (const float*)d_in[7]; a.w_kv_up = (const float*)d_in[8]; a.sinks = (const float*)d_in[9];
    a.w_out = (const float*)d_in[10]; a.ffn_norm = (const float*)d_in[11]; a.dense_w_gate = (const float*)d_in[12]; a.dense_w_up = (const float*)d_in[13]; a.dense_w_down = (const float*)d_in[14];
    a.router = (const float*)d_in[15]; a.moe_w_gate = (const float*)d_in[16]; a.moe_w_up = (const float*)d_in[17]; a.moe_w_down = (const float*)d_in[18]; a.final_norm = (const float*)d_in[19];
    a.out = (float*)d_out; a.ws = (unsigned char*)d_ws;
#if MK_ONE_LAUNCH
    a.ph_lo = 0; a.ph_hi = NPH;
    hipLaunchKernelGGL(mega_fwd, dim3(grid), dim3(NWAVES * 64), LDS_BYTES, stream, a);
#else
    for (int p = 0; p < NPH; ++p) { a.ph_lo = p; a.ph_hi = p + 1; hipLaunchKernelGGL(mega_fwd, dim3(grid), dim3(NWAVES * 64), LDS_BYTES, stream, a); }
#endif
}
```

```cpp
#include <hip/hip_runtime.h>
#include <cstdio>
#include <cstdint>

#ifndef PROBE_REP
#define PROBE_REP -1
#endif
#ifndef STAMP_MODE
#define STAMP_MODE 0
#endif
#ifndef MK_ONE_LAUNCH
#define MK_ONE_LAUNCH 1
#endif
#ifndef P4_FP8
#define P4_FP8 0
#endif
#ifndef UPM_FP6
#define UPM_FP6 1
#endif
#ifndef G1_FP8
#define G1_FP8 2
#endif

#define GAS __attribute__((address_space(1)))
#define LAS __attribute__((address_space(3)))
typedef unsigned short bf16_t;
typedef short bf16x8 __attribute__((ext_vector_type(8)));
typedef short s16x4 __attribute__((ext_vector_type(4)));
typedef float f32x2 __attribute__((ext_vector_type(2)));
typedef float f32x4 __attribute__((ext_vector_type(4)));
typedef float f32x16 __attribute__((ext_vector_type(16)));
typedef unsigned u32x2 __attribute__((ext_vector_type(2)));
typedef unsigned u32x4 __attribute__((ext_vector_type(4)));
typedef __bf16 bf16x2_t __attribute__((ext_vector_type(2)));
typedef GAS unsigned gu32;
typedef int i32x4 __attribute__((ext_vector_type(4)));
typedef int i32x8 __attribute__((ext_vector_type(8)));
typedef int i32x6 __attribute__((ext_vector_type(6)));

constexpr int NB = 2, SEQ = 8192, T = NB * SEQ, D = 1024, NY = 2560, FF = 3584, NEXP = 8;
constexpr int NIN = 2468;
constexpr float EPS = 1e-6f;
constexpr float LOG2E = 1.4426950408889634f;
constexpr float C2_64 = 0.125f * LOG2E;
constexpr float C2_96 = 0.10206207261596575f * LOG2E;
constexpr int Y_FQ = 0, Y_FK = 256, Y_FV = 512, Y_SQ = 768, Y_SK = 1024, Y_SV = 1152, Y_CQ = 1280, Y_DQ = 1536, Y_DK = 1792, Y_DV = 2048,
              Y_CKV = 2304, Y_KR = 2432, Y_FF = 2464;
constexpr int MOE_MAX_TILES = 136, MOE_MAX_ROWS = MOE_MAX_TILES * 256;

constexpr size_t MiB = 1u << 20, KiB = 1u << 10;
constexpr size_t WS_CTL = 0, CTL_ZERO_BYTES = 1 * MiB;
constexpr size_t WS_SM = 1 * MiB;
constexpr size_t SM_RSTD0 = WS_SM, SM_PARTQ = WS_SM + 64 * KiB, SM_PARTKV = WS_SM + 320 * KiB, SM_FF = WS_SM + 576 * KiB, SM_CSL = WS_SM + 832 * KiB,
                 SM_PART = WS_SM + 1088 * KiB, SM_ROPE = WS_SM + 2112 * KiB, SM_TOKE = WS_SM + 4160 * KiB, SM_TOKG = WS_SM + 4288 * KiB,
                 SM_RSTDT = WS_SM + 4416 * KiB, SM_SLOT = WS_SM + 4480 * KiB, SM_RSTDG = WS_SM + 4608 * KiB, SM_HIST = WS_SM + 4800 * KiB, SM_MOETAB = WS_SM + 4808 * KiB;
constexpr size_t WS_WIN = 9 * MiB;
constexpr size_t WS_WQUP = 19 * MiB;
constexpr size_t WS_WKVUP = 19 * MiB + 512 * KiB;
constexpr size_t WS_WOUT = 20 * MiB;
constexpr size_t WS_WGU0 = 24 * MiB;
constexpr size_t WS_WD0 = 38 * MiB;
constexpr size_t WS_WGU1 = 45 * MiB;
constexpr size_t WS_WD1 = 127 * MiB;
constexpr size_t WS_YP = 345 * MiB;
constexpr int YP_ROWS = 2048;
constexpr size_t WS_XB = 157 * MiB;
constexpr size_t WS_Y = 189 * MiB;
constexpr size_t WS_QM = 269 * MiB, WS_KM = 281 * MiB, WS_VM = 293 * MiB;
constexpr size_t WS_MIX = 301 * MiB;
constexpr size_t WS_DP = 333 * MiB;
constexpr size_t WS_DL = 357 * MiB;
constexpr size_t WS_MP = 360 * MiB;
constexpr size_t WS_ML = 392 * MiB;
constexpr size_t WS_HID = 189 * MiB;
constexpr size_t WS_XG = 157 * MiB;
constexpr size_t WS_HG = 225 * MiB;
constexpr size_t WS_XR = 400 * MiB;
constexpr size_t WS_XB8 = 432 * MiB;
constexpr size_t WS_END = 463 * MiB;
constexpr int CW_BAR = 4096;
constexpr int CW_QUEUE = 16384;
constexpr int CW_FMAX = 20480;
constexpr float FOX_THRESH = 100.0f;

constexpr int RING_BYTES = 131072;
constexpr int LDSCTL_OFF = RING_BYTES, MISC_OFF = LDSCTL_OFF + 320;
constexpr int LDS_BYTES = 147456;
constexpr int ROWTBL_OFF = LDSCTL_OFF + 1024;
constexpr int NWAVES = 8;

#define LDS_WAIT() asm volatile("s_waitcnt lgkmcnt(0)" ::: "memory")
#define VM_WAIT() asm volatile("s_waitcnt vmcnt(0)" ::: "memory")
#define RLX_AGENT __ATOMIC_RELAXED, __HIP_MEMORY_SCOPE_AGENT

__device__ __forceinline__ unsigned cvtpk(float lo, float hi) { f32x2 v = {lo, hi}; bf16x2_t b = __builtin_convertvector(v, bf16x2_t); return __builtin_bit_cast(unsigned, b); }
constexpr float F8_SX = 8.0f, F8_SW = 256.0f, F8_SH = 16.0f, F8_SM = 32.0f;
__device__ __forceinline__ unsigned cvt4_fp8(float a, float b, float c, float d) {
    a = __builtin_amdgcn_fmed3f(a, -448.0f, 448.0f); b = __builtin_amdgcn_fmed3f(b, -448.0f, 448.0f); c = __builtin_amdgcn_fmed3f(c, -448.0f, 448.0f); d = __builtin_amdgcn_fmed3f(d, -448.0f, 448.0f);
    int p = __builtin_amdgcn_cvt_pk_fp8_f32(a, b, 0, false); p = __builtin_amdgcn_cvt_pk_fp8_f32(c, d, p, true); return (unsigned)p;
}
constexpr float F6_SX = 2.0f, F6_SW = 64.0f;
__device__ __forceinline__ i32x6 pack32_fp6(const float (&t)[32]) {
    f32x16 x, y;
#pragma unroll
    for (int i = 0; i < 16; ++i) { x[i] = __builtin_amdgcn_fmed3f(t[i], -7.5f, 7.5f); y[i] = __builtin_amdgcn_fmed3f(t[16 + i], -7.5f, 7.5f); }
    return __builtin_amdgcn_cvt_scalef32_2xpk16_fp6_f32(x, y, 1.0f);
}
__device__ __forceinline__ void fp6_tiled_offset(int r, int kq, int KT, bool perm, size_t& P, size_t& Q) {
    const int kt = kq >> 2, fq = kq & 3; int rl = r & 127;
    if (perm) { const int c = rl & 31; rl = (rl & ~31) + (((c >> 2) & 1) * 16 + (c >> 3) * 4 + (c & 3)); }
    const size_t tb = ((size_t)(r >> 7) * KT + kt) * 12288;
    const int ob = (rl & 15) * 64 + fq * 16;
    P = tb + (rl >> 4) * 1024 + (ob ^ (((ob >> 9) & 1) << 5));
    Q = tb + 8192 + rl * 32 + (((fq >> 1) ^ (rl >> 3)) & 1) * 16 + (fq & 1) * 8;
}
__device__ __forceinline__ i32x8 cat8(const bf16x8 a, const bf16x8 b) { const i32x4 x = __builtin_bit_cast(i32x4, a), y = __builtin_bit_cast(i32x4, b); return __builtin_shufflevector(x, y, 0, 1, 2, 3, 4, 5, 6, 7); }
__device__ __forceinline__ float bf2f(unsigned short h) { return __uint_as_float((unsigned)h << 16); }
__device__ __forceinline__ float wave_sum(float v) {
#pragma unroll
    for (int o = 1; o < 64; o <<= 1) v += __shfl_xor(v, o);
    return v;
}

namespace pg8 {
constexpr int BM = 256, BK = 64, HALF = 128, HTB = HALF * BK * 2, STAGE_BYTES = 8 * HTB, NXCD = 8, WGM = 8;
__host__ __device__ __forceinline__ int lds_byte(int r, int c) { const int st = (r >> 4) * 2 + (c >> 5), rr = r & 15, cc = c & 31, ob = rr * 64 + cc * 2; return st * 1024 + (ob ^ (((ob >> 9) & 1) << 5)); }
__host__ __device__ __forceinline__ void stage_rc(int b, int& R, int& C) { const int st = b / 1024, sb = b % 1024, swz = sb ^ (((sb >> 9) & 1) << 5); R = (st >> 1) * 16 + swz / 64; C = (st & 1) * 32 + (swz % 64) / 2; }
__host__ __device__ __forceinline__ int perm32(int rho) { const int n = rho >> 4, i = rho & 15; return 8 * (i >> 2) + 4 * n + (i & 3); }

struct Unit { int pm, pn, e, ks; };
struct Gemm { const bf16_t* A; const bf16_t* Bt; int lda, ldb, K; };

struct StaticOrder {
    int nM, nN, nwg, G, c;
    __device__ void init(int M, int N, int G_, int c_) { nM = M / BM; nN = N / BM; nwg = nM * nN; G = G_; c = c_; }
    __device__ bool next(int i, Unit& u) const {
        const long L = (long)i * G + c; if (L >= nwg) return false;
        int wgid = (int)L; { const int q = nwg / NXCD, r = nwg % NXCD, xcd = wgid % NXCD, off = wgid / NXCD; wgid = (xcd < r ? xcd * (q + 1) : r * (q + 1) + (xcd - r) * q) + off; }
        const int nig = WGM * nN, gid = wgid / nig, fm = gid * WGM, gsz = (nM - fm) < WGM ? (nM - fm) : WGM;
        u.pm = fm + ((wgid % nig) % gsz); u.pn = (wgid % nig) / gsz; u.e = 0; u.ks = 0; return true;
    }
};
struct SchedStatic {
    StaticOrder o;
    __device__ __forceinline__ bool next(int i, Unit& u) const { return o.next(i, u); }
    __device__ __forceinline__ const char* abase(const Gemm& g, const Unit& u) const { return (const char*)g.A + (size_t)u.pm * BM * g.lda * 2; }
    __device__ __forceinline__ const char* bbase(const Gemm& g, const Unit& u) const { return (const char*)g.Bt + (size_t)u.pn * BM * g.ldb * 2; }
};
struct SchedMoe {
    StaticOrder o; int tb[9]; size_t estride;
    __device__ __forceinline__ bool next(int i, Unit& u) const {
        if (!o.next(i, u)) return false; int e = 0;
#pragma unroll
        for (int j = 1; j < 8; ++j) e += (u.pm >= tb[j]) ? 1 : 0;
        u.e = e; return true;
    }
    __device__ __forceinline__ const char* abase(const Gemm& g, const Unit& u) const { return (const char*)g.A + (size_t)u.pm * BM * g.lda * 2; }
    __device__ __forceinline__ const char* bbase(const Gemm& g, const Unit& u) const { return (const char*)g.Bt + (size_t)u.e * estride + (size_t)u.pn * BM * g.ldb * 2; }
};
struct SchedMoeSplit {
    int tb[9]; size_t estride; int G, c, n0, nUnits, ksl;
    static constexpr int KS = 7;
    __device__ __forceinline__ bool next(int i, Unit& u) const {
        const int L = i * G + c; if (L >= nUnits) return false;
        u.ks = L % KS; u.pn = (L / KS) & 3; u.pm = n0 + L / (4 * KS); int e = 0;
#pragma unroll
        for (int j = 1; j < 8; ++j) e += (u.pm >= tb[j]) ? 1 : 0;
        u.e = e; return true;
    }
    __device__ __forceinline__ const char* abase(const Gemm& g, const Unit& u) const { return (const char*)g.A + (size_t)u.pm * BM * g.lda * 2 + (size_t)u.ks * ksl * 2; }
    __device__ __forceinline__ const char* bbase(const Gemm& g, const Unit& u) const { return (const char*)g.Bt + (size_t)u.e * estride + (size_t)u.pn * BM * g.ldb * 2 + (size_t)u.ks * ksl * 2; }
};
struct SchedOne {
    bool has; Unit un;
    __device__ __forceinline__ bool next(int i, Unit& u) const { if (i > 0 || !has) return false; u = un; return true; }
    __device__ __forceinline__ const char* abase(const Gemm& g, const Unit& u) const { return (const char*)g.A + (size_t)u.pm * BM * g.lda * 2; }
    __device__ __forceinline__ const char* bbase(const Gemm& g, const Unit& u) const { return (const char*)g.Bt + (size_t)u.pn * BM * g.ldb * 2; }
};

template <class Epi, class Sched, bool ALIGN_EPI, bool FP8 = false>
__device__ __forceinline__ void gemm_phase(LAS unsigned char* lds, const Gemm g_in, const Sched& S, const Epi& E) {
    Gemm g = g_in; asm volatile("" : "+s"(g.A), "+s"(g.Bt), "+s"(g.K));
    int tid_l = threadIdx.x; asm volatile("" : "+v"(tid_l));
    const int tid = tid_l, wid = __builtin_amdgcn_readfirstlane(tid >> 6), lane = tid & 63, wr = wid >> 2, wc = wid & 3, fr = lane & 15, fq = lane >> 4;
    const int K = g.K, nt = K / BK;
    unsigned voffA[2], voffB[2];
#pragma unroll
    for (int i = 0; i < 2; ++i) { int R, C; stage_rc(tid * 16 + i * 8192, R, C); const int Rb = Epi::PERM ? ((R & ~31) + perm32(R & 31)) : R;
        voffA[i] = (unsigned)(R * g.lda + C) * 2u; voffB[i] = (unsigned)(Rb * g.ldb + C) * 2u; }
    const size_t kstep = (size_t)(BK * 2);
    const size_t hstepA = (size_t)HALF * g.lda * 2, hstepB = (size_t)HALF * g.ldb * 2;
    const unsigned ldsw = (unsigned)wid * 1024u;
    const int aoff = lds_byte(wr * 64 + fr, fq * 8), boff = lds_byte(wc * 32 + fr, fq * 8);
#define PG8_SA(b, h) (((b) * 2 + (h)) * HTB)
#define PG8_SB(b, h) ((4 + (b) * 2 + (h)) * HTB)
#define PG8_STAGE(bufoff, gbase, voff) do { _Pragma("unroll") for (int _i = 0; _i < 2; ++_i) \
        __builtin_amdgcn_global_load_lds((const unsigned*)((const char*)(gbase) + (voff)[_i]), (LAS unsigned*)(lds + (bufoff) + ldsw + _i * 8192), 16, 0, 0); } while (0)
#define PG8_LDA(dst, b, h) do { _Pragma("unroll") for (int m = 0; m < 4; ++m) _Pragma("unroll") for (int k = 0; k < 2; ++k) dst[m][k] = *(const LAS bf16x8*)(lds + PG8_SA(b, h) + aoff + m * 2048 + k * 1024); } while (0)
#define PG8_LDB(dst, b, h) do { _Pragma("unroll") for (int n = 0; n < 2; ++n) _Pragma("unroll") for (int k = 0; k < 2; ++k) dst[n][k] = *(const LAS bf16x8*)(lds + PG8_SB(b, h) + boff + n * 2048 + k * 1024); } while (0)
#define PG8_MMA(ai, bj, At, Bt) do { __builtin_amdgcn_s_setprio(1); \
        if constexpr (FP8) { _Pragma("unroll") for (int m = 0; m < 4; ++m) _Pragma("unroll") for (int n = 0; n < 2; ++n) \
            asm volatile("v_mfma_f32_16x16x128_f8f6f4 %0, %1, %2, %0" : "+v"(acc[ai][bj][m][n]) : "v"(cat8(Bt[n][0], Bt[n][1])), "v"(cat8(At[m][0], At[m][1]))); } \
        else { _Pragma("unroll") for (int m = 0; m < 4; ++m) _Pragma("unroll") for (int n = 0; n < 2; ++n) _Pragma("unroll") for (int k = 0; k < 2; ++k) \
            acc[ai][bj][m][n] = __builtin_amdgcn_mfma_f32_16x16x32_bf16(Bt[n][k], At[m][k], acc[ai][bj][m][n], 0, 0, 0); } \
        __builtin_amdgcn_s_setprio(0); } while (0)
#define PG8_WAIT_V(n) asm volatile("s_waitcnt vmcnt(" #n ")" ::: "memory")
#define PG8_WAIT_L(n) asm volatile("s_waitcnt lgkmcnt(" #n ")" ::: "memory")
#define PG8_BAR __builtin_amdgcn_s_barrier()
#define PG8_SCHED __builtin_amdgcn_sched_barrier(0)
    Unit cur, nxt; int ui = 0;
    if (!S.next(0, cur)) return;
    if constexpr (Epi::SCALE == 1) { f32x4 pv0[4]; rowtbl_issue(E.rt, cur.pm, tid, pv0); rowtbl_commit(E.rt, 0, tid, pv0); }
    f32x4 acc[2][2][4][2];
#pragma unroll
    for (int a = 0; a < 2; ++a)
#pragma unroll
        for (int b = 0; b < 2; ++b)
#pragma unroll
            for (int m = 0; m < 4; ++m)
#pragma unroll
                for (int n = 0; n < 2; ++n) acc[a][b][m][n] = (f32x4){0.f, 0.f, 0.f, 0.f};
    bf16x8 At[4][2], B0[2][2], B1[2][2];
    const char* cA = S.abase(g, cur); const char* cB = S.bbase(g, cur);
    PG8_STAGE(PG8_SB(0, 0), cB, voffB); PG8_STAGE(PG8_SB(0, 1), cB + hstepB, voffB); PG8_STAGE(PG8_SA(0, 0), cA, voffA); PG8_STAGE(PG8_SA(0, 1), cA + hstepA, voffA);
    if (wr == 1) PG8_BAR;
    PG8_WAIT_V(2); PG8_BAR;
    PG8_STAGE(PG8_SB(1, 0), cB + kstep, voffB); PG8_STAGE(PG8_SA(1, 0), cA + kstep, voffA); PG8_STAGE(PG8_SB(1, 1), cB + hstepB + kstep, voffB);
    PG8_WAIT_V(6); PG8_BAR;
    for (;;) {
        const bool has_next = S.next(ui + 1, nxt);
        const char* nA = has_next ? S.abase(g, nxt) : cA; const char* nB = has_next ? S.bbase(g, nxt) : cB;
        for (int t = 0; t < nt; t += 2) {
            const bool last = (t == nt - 2);
            const char* a1 = cA + (size_t)(t + 1) * kstep;
            const char* a2 = last ? nA : cA + (size_t)(t + 2) * kstep; const char* b2 = last ? nB : cB + (size_t)(t + 2) * kstep;
            const char* a3 = a2 + kstep; const char* b3 = b2 + kstep;
            PG8_LDB(B0, 0, 0); PG8_LDB(B1, 0, 1); PG8_SCHED; PG8_LDA(At, 0, 0); PG8_STAGE(PG8_SA(1, 1), a1 + hstepA, voffA);
            PG8_WAIT_V(8); PG8_WAIT_L(0); PG8_BAR; PG8_MMA(0, 0, At, B0); PG8_MMA(0, 1, At, B1); PG8_BAR; PG8_SCHED;
            PG8_LDA(At, 0, 1); PG8_STAGE(PG8_SB(0, 0), b2, voffB); PG8_STAGE(PG8_SB(0, 1), b2 + hstepB, voffB); PG8_STAGE(PG8_SA(0, 0), a2, voffA);
            PG8_WAIT_V(8); PG8_WAIT_L(0); PG8_BAR; PG8_MMA(1, 0, At, B0); PG8_MMA(1, 1, At, B1); PG8_BAR; PG8_SCHED;
            PG8_LDB(B0, 1, 0); PG8_LDB(B1, 1, 1); PG8_SCHED; PG8_LDA(At, 1, 0); PG8_STAGE(PG8_SA(0, 1), a2 + hstepA, voffA);
            PG8_WAIT_V(8); PG8_WAIT_L(0); PG8_BAR; PG8_MMA(0, 0, At, B0); PG8_MMA(0, 1, At, B1); PG8_BAR; PG8_SCHED;
            PG8_LDA(At, 1, 1); PG8_STAGE(PG8_SB(1, 0), b3, voffB); PG8_STAGE(PG8_SB(1, 1), b3 + hstepB, voffB); PG8_STAGE(PG8_SA(1, 0), a3, voffA);
            PG8_WAIT_V(8); PG8_WAIT_L(0); PG8_BAR; PG8_MMA(1, 0, At, B0); PG8_MMA(1, 1, At, B1); PG8_BAR; PG8_SCHED;
        }
        if constexpr (ALIGN_EPI) { if (wr == 0) PG8_BAR; }
        if constexpr (FP8) asm volatile("s_nop 15\n\ts_nop 15" ::: "memory");
        f32x4 pvn[4];
        if constexpr (Epi::SCALE == 1) { if (has_next) rowtbl_issue(E.rt, nxt.pm, tid, pvn); }
        E(acc, cur, wr, wc, fr, fq, ui & 1);
        if constexpr (Epi::SCALE == 1) { if (has_next) rowtbl_commit(E.rt, (ui + 1) & 1, tid, pvn); }
        if (!has_next) break;
#pragma unroll
        for (int a = 0; a < 2; ++a)
#pragma unroll
            for (int b = 0; b < 2; ++b)
#pragma unroll
                for (int m = 0; m < 4; ++m)
#pragma unroll
                    for (int n = 0; n < 2; ++n) acc[a][b][m][n] = (f32x4){0.f, 0.f, 0.f, 0.f};
        cur = nxt; cA = nA; cB = nB; ++ui;
        if constexpr (ALIGN_EPI) { if (wr == 1) PG8_BAR; }
    }
    PG8_WAIT_V(0);
    if constexpr (!ALIGN_EPI) { if (wr == 0) PG8_BAR; }
    PG8_BAR;
#undef PG8_SA
#undef PG8_SB
#undef PG8_STAGE
#undef PG8_LDA
#undef PG8_LDB
#undef PG8_MMA
#undef PG8_WAIT_V
#undef PG8_WAIT_L
#undef PG8_BAR
#undef PG8_SCHED
}

template <class Epi, class Sched, bool ALIGN_EPI>
__device__ __forceinline__ void gemm_phase6(LAS unsigned char* lds, const Gemm g_in, const Sched& S, const Epi& E) {
    Gemm g = g_in; asm volatile("" : "+s"(g.A), "+s"(g.Bt), "+s"(g.K));
    int tid_l = threadIdx.x; asm volatile("" : "+v"(tid_l));
    const int tid = tid_l, wid = __builtin_amdgcn_readfirstlane(tid >> 6), lane = tid & 63, wr = wid >> 2, wc = wid & 3, fr = lane & 15, fq = lane >> 4;
    const int K = g.K, nt = K / 48;
    unsigned voffA[2], voffB[2];
    voffA[0] = voffB[0] = (unsigned)tid * 16u; voffA[1] = voffB[1] = (tid < 256) ? 8192u + (unsigned)tid * 16u : 0u;
    const size_t kstep = 12288;
    const size_t hstepA = (size_t)HALF * g.lda * 2, hstepB = (size_t)HALF * g.ldb * 2;
    const unsigned ldsw = (unsigned)wid * 1024u;
    const int pob = fr * 64 + fq * 16, pof = pob ^ (((pob >> 9) & 1) << 5), qof = fr * 32 + (((fq >> 1) ^ (fr >> 3)) & 1) * 16 + (fq & 1) * 8;
    const int aoffP = wr * 4096 + pof, aoffQ = 8192 + wr * 2048 + qof, boffP = wc * 2048 + pof, boffQ = 8192 + wc * 1024 + qof;
#define P6_SA(b, h) (((b) * 2 + (h)) * HTB)
#define P6_SB(b, h) ((4 + (b) * 2 + (h)) * HTB)
#define P6_STAGE(bufoff, gbase, voff) do { _Pragma("unroll") for (int _i = 0; _i < 2; ++_i) \
        __builtin_amdgcn_global_load_lds((const unsigned*)((const char*)(gbase) + (voff)[_i]), (LAS unsigned*)(lds + (bufoff) + ldsw + _i * 8192), 16, 0, 0); } while (0)
#define P6_RD(dst, pp, qq) do { const u32x4 _a = *(const LAS u32x4*)(pp); const u32x2 _c = *(const LAS u32x2*)(qq); \
        dst = (i32x6){(int)_a.x, (int)_a.y, (int)_a.z, (int)_a.w, (int)_c.x, (int)_c.y}; } while (0)
#define P6_LDA(dst, b, h) do { _Pragma("unroll") for (int m = 0; m < 4; ++m) P6_RD(dst[m], lds + P6_SA(b, h) + aoffP + m * 1024, lds + P6_SA(b, h) + aoffQ + m * 512); } while (0)
#define P6_LDB(dst, b, h) do { _Pragma("unroll") for (int n = 0; n < 2; ++n) P6_RD(dst[n], lds + P6_SB(b, h) + boffP + n * 1024, lds + P6_SB(b, h) + boffQ + n * 512); } while (0)
#define P6_MMA(ai, bj, At, Bt) do { __builtin_amdgcn_s_setprio(1); _Pragma("unroll") for (int m = 0; m < 4; ++m) _Pragma("unroll") for (int n = 0; n < 2; ++n) \
        asm volatile("v_mfma_f32_16x16x128_f8f6f4 %0, %1, %2, %0 cbsz:2 blgp:2" : "+v"(acc[ai][bj][m][n]) : "v"(Bt[n]), "v"(At[m])); \
        __builtin_amdgcn_s_setprio(0); } while (0)
#define P6_WAIT_V(n) asm volatile("s_waitcnt vmcnt(" #n ")" ::: "memory")
#define P6_WAIT_L(n) asm volatile("s_waitcnt lgkmcnt(" #n ")" ::: "memory")
#define P6_BAR __builtin_amdgcn_s_barrier()
#define P6_SCHED __builtin_amdgcn_sched_barrier(0)
    Unit cur, nxt; int ui = 0;
    if (!S.next(0, cur)) return;
    if constexpr (Epi::SCALE == 1) { f32x4 pv0[4]; rowtbl_issue(E.rt, cur.pm, tid, pv0); rowtbl_commit(E.rt, 0, tid, pv0); }
    f32x4 acc[2][2][4][2];
#pragma unroll
    for (int a = 0; a < 2; ++a)
#pragma unroll
        for (int b = 0; b < 2; ++b)
#pragma unroll
            for (int m = 0; m < 4; ++m)
#pragma unroll
                for (int n = 0; n < 2; ++n) acc[a][b][m][n] = (f32x4){0.f, 0.f, 0.f, 0.f};
    i32x6 At[4], B0[2], B1[2];
    const char* cA = S.abase(g, cur); const char* cB = S.bbase(g, cur);
    P6_STAGE(P6_SB(0, 0), cB, voffB); P6_STAGE(P6_SB(0, 1), cB + hstepB, voffB); P6_STAGE(P6_SA(0, 0), cA, voffA); P6_STAGE(P6_SA(0, 1), cA + hstepA, voffA);
    if (wr == 1) P6_BAR;
    P6_WAIT_V(2); P6_BAR;
    P6_STAGE(P6_SB(1, 0), cB + kstep, voffB); P6_STAGE(P6_SA(1, 0), cA + kstep, voffA); P6_STAGE(P6_SB(1, 1), cB + hstepB + kstep, voffB);
    P6_WAIT_V(6); P6_BAR;
    for (;;) {
        const bool has_next = S.next(ui + 1, nxt);
        const char* nA = has_next ? S.abase(g, nxt) : cA; const char* nB = has_next ? S.bbase(g, nxt) : cB;
        for (int t = 0; t < nt; t += 2) {
            const bool last = (t == nt - 2);
            const char* a1 = cA + (size_t)(t + 1) * kstep;
            const char* a2 = last ? nA : cA + (size_t)(t + 2) * kstep; const char* b2 = last ? nB : cB + (size_t)(t + 2) * kstep;
            const char* a3 = a2 + kstep; const char* b3 = b2 + kstep;
            P6_LDB(B0, 0, 0); P6_LDB(B1, 0, 1); P6_SCHED; P6_LDA(At, 0, 0); P6_STAGE(P6_SA(1, 1), a1 + hstepA, voffA);
            P6_WAIT_V(8); P6_WAIT_L(0); P6_BAR; P6_MMA(0, 0, At, B0); P6_MMA(0, 1, At, B1); P6_BAR; P6_SCHED;
            P6_LDA(At, 0, 1); P6_STAGE(P6_SB(0, 0), b2, voffB); P6_STAGE(P6_SB(0, 1), b2 + hstepB, voffB); P6_STAGE(P6_SA(0, 0), a2, voffA);
            P6_WAIT_V(8); P6_WAIT_L(0); P6_BAR; P6_MMA(1, 0, At, B0); P6_MMA(1, 1, At, B1); P6_BAR; P6_SCHED;
            P6_LDB(B0, 1, 0); P6_LDB(B1, 1, 1); P6_SCHED; P6_LDA(At, 1, 0); P6_STAGE(P6_SA(0, 1), a2 + hstepA, voffA);
            P6_WAIT_V(8); P6_WAIT_L(0); P6_BAR; P6_MMA(0, 0, At, B0); P6_MMA(0, 1, At, B1); P6_BAR; P6_SCHED;
            P6_LDA(At, 1, 1); P6_STAGE(P6_SB(1, 0), b3, voffB); P6_STAGE(P6_SB(1, 1), b3 + hstepB, voffB); P6_STAGE(P6_SA(1, 0), a3, voffA);
            P6_WAIT_V(8); P6_WAIT_L(0); P6_BAR; P6_MMA(1, 0, At, B0); P6_MMA(1, 1, At, B1); P6_BAR; P6_SCHED;
        }
        if constexpr (ALIGN_EPI) { if (wr == 0) P6_BAR; }
        asm volatile("s_nop 15\n\ts_nop 15" ::: "memory");
        f32x4 pvn[4];
        if constexpr (Epi::SCALE == 1) { if (has_next) rowtbl_issue(E.rt, nxt.pm, tid, pvn); }
        E(acc, cur, wr, wc, fr, fq, ui & 1);
        if constexpr (Epi::SCALE == 1) { if (has_next) rowtbl_commit(E.rt, (ui + 1) & 1, tid, pvn); }
        if (!has_next) break;
#pragma unroll
        for (int a = 0; a < 2; ++a)
#pragma unroll
            for (int b = 0; b < 2; ++b)
#pragma unroll
                for (int m = 0; m < 4; ++m)
#pragma unroll
                    for (int n = 0; n < 2; ++n) acc[a][b][m][n] = (f32x4){0.f, 0.f, 0.f, 0.f};
        cur = nxt; cA = nA; cB = nB; ++ui;
        if constexpr (ALIGN_EPI) { if (wr == 1) P6_BAR; }
    }
    P6_WAIT_V(0);
    if constexpr (!ALIGN_EPI) { if (wr == 0) P6_BAR; }
    P6_BAR;
#undef P6_SA
#undef P6_SB
#undef P6_STAGE
#undef P6_RD
#undef P6_LDA
#undef P6_LDB
#undef P6_MMA
#undef P6_WAIT_V
#undef P6_WAIT_L
#undef P6_BAR
#undef P6_SCHED
}

__device__ __forceinline__ float rstd_part(const float* part, int row) {
    const f32x4* p = (const f32x4*)(part + (size_t)row * 16);
    const f32x4 a = p[0], b = p[1], c = p[2], d = p[3];
    const float s = ((a[0] + a[1]) + (a[2] + a[3])) + ((b[0] + b[1]) + (b[2] + b[3])) + ((c[0] + c[1]) + (c[2] + c[3])) + ((d[0] + d[1]) + (d[2] + d[3]));
    return __builtin_amdgcn_rsqf(s * (1.0f / D) + EPS);
}
struct RowTbl { const float* part; LAS float* tbl; };
__device__ __forceinline__ void rowtbl_issue(const RowTbl& R, int pm, int tid, f32x4 (&pv)[4]) {
    if (tid < 256) { const f32x4* p = (const f32x4*)(R.part + ((size_t)pm * BM + tid) * 16); pv[0] = p[0]; pv[1] = p[1]; pv[2] = p[2]; pv[3] = p[3]; }
}
__device__ __forceinline__ void rowtbl_commit(const RowTbl& R, int parity, int tid, const f32x4 (&pv)[4]) {
    if (tid < 256) { const float s = ((pv[0][0] + pv[0][1]) + (pv[0][2] + pv[0][3])) + ((pv[1][0] + pv[1][1]) + (pv[1][2] + pv[1][3])) + ((pv[2][0] + pv[2][1]) + (pv[2][2] + pv[2][3])) + ((pv[3][0] + pv[3][1]) + (pv[3][2] + pv[3][3]));
        R.tbl[parity * 256 + tid] = __builtin_amdgcn_rsqf(s * (1.0f / D) + EPS); }
}
__device__ __forceinline__ u32x4 pack8(const f32x4 v0, const f32x4 v1) { u32x4 w; w.x = cvtpk(v0[0], v0[1]); w.y = cvtpk(v0[2], v0[3]); w.z = cvtpk(v1[0], v1[1]); w.w = cvtpk(v1[2], v1[3]); return w; }

template <int SCALE_, bool F8 = false>
struct EpiG1 {
    static constexpr int SCALE = SCALE_; static constexpr bool PERM = true;
    bf16_t* Y; RowTbl rt; float* partq; float* partkv; float* ff; bf16_t* Km; const float* rope;
    __device__ __forceinline__ void operator()(const f32x4 (&acc)[2][2][4][2], const Unit& u, int wr, int wc, int fr, int fq, int par) const {
#pragma unroll
        for (int ai = 0; ai < 2; ++ai)
#pragma unroll
            for (int m = 0; m < 4; ++m) {
                asm volatile("" ::: "memory");
                const int row = u.pm * BM + ai * HALF + wr * 64 + m * 16 + fr;
                const float rs = (SCALE ? rt.tbl[par * 256 + ai * HALF + wr * 64 + m * 16 + fr] : 1.0f) * (F8 ? 1.0f / (F8_SX * F8_SW) : 1.0f);
                f32x4 v[2][2];
#pragma unroll
                for (int bj = 0; bj < 2; ++bj) { v[bj][0] = acc[ai][bj][m][0] * rs; v[bj][1] = acc[ai][bj][m][1] * rs;
                    *(u32x4*)(Y + (size_t)row * NY + u.pn * BM + bj * HALF + wc * 32 + 8 * fq) = pack8(v[bj][0], v[bj][1]); }
                if (u.pn == Y_CQ / 256) {
                    float s = 0.f;
#pragma unroll
                    for (int bj = 0; bj < 2; ++bj)
#pragma unroll
                        for (int n = 0; n < 2; ++n) { const f32x4 x = v[bj][n]; s += (x[0] * x[0] + x[1] * x[1]) + (x[2] * x[2] + x[3] * x[3]); }
                    s += __shfl_xor(s, 16); s += __shfl_xor(s, 32);
                    if (fq == 0) partq[row * 4 + wc] = s;
                }
                if (u.pn == Y_CKV / 256) {
                    float s = 0.f;
#pragma unroll
                    for (int n = 0; n < 2; ++n) { const f32x4 x = v[0][n]; s += (x[0] * x[0] + x[1] * x[1]) + (x[2] * x[2] + x[3] * x[3]); }
                    s += __shfl_xor(s, 16); s += __shfl_xor(s, 32);
                    if (fq == 0) partkv[row * 4 + wc] = s;
                    if (wc == 0) {
                        const f32x4* rp = (const f32x4*)(rope + (size_t)row * 32 + 8 * fq);
                        const f32x4 cs0 = rp[0], cs1 = rp[1];
                        const f32x4 t1 = v[1][0], t2 = v[1][1];
                        f32x4 o1, o2;
                        o1[0] = t1[0] * cs0[0] - t2[0] * cs0[1]; o2[0] = t2[0] * cs0[0] + t1[0] * cs0[1];
                        o1[1] = t1[1] * cs0[2] - t2[1] * cs0[3]; o2[1] = t2[1] * cs0[2] + t1[1] * cs0[3];
                        o1[2] = t1[2] * cs1[0] - t2[2] * cs1[1]; o2[2] = t2[2] * cs1[0] + t1[2] * cs1[1];
                        o1[3] = t1[3] * cs1[2] - t2[3] * cs1[3]; o2[3] = t2[3] * cs1[2] + t1[3] * cs1[3];
                        const u32x4 w = pack8(o1, o2);
#pragma unroll
                        for (int h = 0; h < 4; ++h) *(u32x4*)(Km + (size_t)row * 384 + h * 96 + 64 + 8 * fq) = w;
                    }
                    if (wc == 1 && fq == 0) *(f32x4*)(ff + (size_t)row * 4) = v[1][0];
                }
            }
    }
};
struct EpiQup {
    static constexpr int SCALE = 0; static constexpr bool PERM = true;
    bf16_t* Qm; const float* partq; const float* rope;
    __device__ __forceinline__ void operator()(const f32x4 (&acc)[2][2][4][2], const Unit& u, int wr, int wc, int fr, int fq, int par) const {
        int col[2], cm[2];
#pragma unroll
        for (int bj = 0; bj < 2; ++bj) { col[bj] = u.pn * BM + bj * HALF + wc * 32 + 8 * fq; cm[bj] = col[bj] % 96; }
#pragma unroll
        for (int ai = 0; ai < 2; ++ai) {
            asm volatile("" ::: "memory");
            f32x4 pq[4], cs[4][2][2];
#pragma unroll
            for (int m = 0; m < 4; ++m) { const int row = u.pm * BM + ai * HALF + wr * 64 + m * 16 + fr;
                pq[m] = *(const f32x4*)(partq + (size_t)row * 4);
#pragma unroll
                for (int bj = 0; bj < 2; ++bj) if (col[bj] < 384 && cm[bj] >= 64) { const f32x4* rp = (const f32x4*)(rope + (size_t)row * 32 + (cm[bj] - 64)); cs[m][bj][0] = rp[0]; cs[m][bj][1] = rp[1]; } }
#pragma unroll
            for (int m = 0; m < 4; ++m) {
                const int row = u.pm * BM + ai * HALF + wr * 64 + m * 16 + fr;
                const float rs = __builtin_amdgcn_rsqf(((pq[m][0] + pq[m][1]) + (pq[m][2] + pq[m][3])) * (1.0f / 256.0f) + EPS);
#pragma unroll
                for (int bj = 0; bj < 2; ++bj) {
                    if (col[bj] < 384) {
                        f32x4 v0 = acc[ai][bj][m][0] * rs, v1 = acc[ai][bj][m][1] * rs;
                        if (cm[bj] >= 64) {
                            const f32x4 cs0 = cs[m][bj][0], cs1 = cs[m][bj][1];
                            const f32x4 t1 = v0, t2 = v1;
                            v0[0] = t1[0] * cs0[0] - t2[0] * cs0[1]; v1[0] = t2[0] * cs0[0] + t1[0] * cs0[1];
                            v0[1] = t1[1] * cs0[2] - t2[1] * cs0[3]; v1[1] = t2[1] * cs0[2] + t1[1] * cs0[3];
                            v0[2] = t1[2] * cs1[0] - t2[2] * cs1[1]; v1[2] = t2[2] * cs1[0] + t1[2] * cs1[1];
                            v0[3] = t1[3] * cs1[2] - t2[3] * cs1[3]; v1[3] = t2[3] * cs1[2] + t1[3] * cs1[3];
                        }
                        *(u32x4*)(Qm + (size_t)row * 384 + col[bj]) = pack8(v0, v1);
                    }
                }
            }
        }
    }
};
struct EpiKVup {
    static constexpr int SCALE = 0; static constexpr bool PERM = true;
    bf16_t* Km; bf16_t* Vm; const float* partkv;
    __device__ __forceinline__ void operator()(const f32x4 (&acc)[2][2][4][2], const Unit& u, int wr, int wc, int fr, int fq, int par) const {
#pragma unroll
        for (int ai = 0; ai < 2; ++ai) {
            asm volatile("" ::: "memory");
            f32x4 pqv[4];
#pragma unroll
            for (int m = 0; m < 4; ++m) pqv[m] = *(const f32x4*)(partkv + (size_t)(u.pm * BM + ai * HALF + wr * 64 + m * 16 + fr) * 4);
#pragma unroll
            for (int m = 0; m < 4; ++m) {
                const int row = u.pm * BM + ai * HALF + wr * 64 + m * 16 + fr;
                const f32x4 pq = pqv[m];
                const float rs = __builtin_amdgcn_rsqf(((pq[0] + pq[1]) + (pq[2] + pq[3])) * (1.0f / 128.0f) + EPS);
#pragma unroll
                for (int bj = 0; bj < 2; ++bj) {
                    const int col = u.pn * BM + bj * HALF + wc * 32 + 8 * fq;
                    const int h = col >> 7, c = col & 127;
                    const u32x4 w = pack8(acc[ai][bj][m][0] * rs, acc[ai][bj][m][1] * rs);
                    if (c < 64) *(u32x4*)(Km + (size_t)row * 384 + h * 96 + c) = w;
                    else *(u32x4*)(Vm + (size_t)row * 256 + h * 64 + (c - 64)) = w;
                }
            }
        }
    }
};
template <bool BASE16>
struct EpiRes {
    static constexpr int SCALE = 0; static constexpr bool PERM = true;
    const void* base; bf16_t* xo; float* part; unsigned char* x8; float dsc;
    __device__ __forceinline__ void operator()(const f32x4 (&acc)[2][2][4][2], const Unit& u, int wr, int wc, int fr, int fq, int par) const {
#pragma unroll
        for (int ai = 0; ai < 2; ++ai) {
            asm volatile("" ::: "memory");
            f32x4 pre[4][2][2];
            u32x4 pre16[4][2];
#pragma unroll
            for (int m = 0; m < 4; ++m) { const size_t roff = (size_t)(u.pm * BM + ai * HALF + wr * 64 + m * 16 + fr) * D + u.pn * BM + wc * 32 + 8 * fq;
#pragma unroll
                for (int bj = 0; bj < 2; ++bj) {
                    if constexpr (BASE16) pre16[m][bj] = *(const u32x4*)((const bf16_t*)base + roff + bj * HALF);
                    else { pre[m][bj][0] = *(const f32x4*)((const float*)base + roff + bj * HALF); pre[m][bj][1] = *(const f32x4*)((const float*)base + roff + bj * HALF + 4); } } }
#pragma unroll
            for (int m = 0; m < 4; ++m) {
                const int row = u.pm * BM + ai * HALF + wr * 64 + m * 16 + fr;
                float s = 0.f;
#pragma unroll
                for (int bj = 0; bj < 2; ++bj) {
                    f32x4 x0, x1;
                    if constexpr (BASE16) { const u32x4 w = pre16[m][bj];
                        x0 = (f32x4){__uint_as_float(w.x << 16), __uint_as_float(w.x & 0xffff0000u), __uint_as_float(w.y << 16), __uint_as_float(w.y & 0xffff0000u)};
                        x1 = (f32x4){__uint_as_float(w.z << 16), __uint_as_float(w.z & 0xffff0000u), __uint_as_float(w.w << 16), __uint_as_float(w.w & 0xffff0000u)}; }
                    else { x0 = pre[m][bj][0]; x1 = pre[m][bj][1]; }
                    x0 += acc[ai][bj][m][0] * dsc; x1 += acc[ai][bj][m][1] * dsc;
                    *(u32x4*)(xo + (size_t)row * D + u.pn * BM + bj * HALF + wc * 32 + 8 * fq) = pack8(x0, x1);
                    if (x8) { u32x2 w8; w8.x = cvt4_fp8(x0[0] * F8_SX, x0[1] * F8_SX, x0[2] * F8_SX, x0[3] * F8_SX); w8.y = cvt4_fp8(x1[0] * F8_SX, x1[1] * F8_SX, x1[2] * F8_SX, x1[3] * F8_SX);
                        *(u32x2*)(x8 + (size_t)row * D + u.pn * BM + bj * HALF + wc * 32 + 8 * fq) = w8; }
                    s += ((x0[0] * x0[0] + x0[1] * x0[1]) + (x0[2] * x0[2] + x0[3] * x0[3])) + ((x1[0] * x1[0] + x1[1] * x1[1]) + (x1[2] * x1[2] + x1[3] * x1[3]));
                }
                s += __shfl_xor(s, 16); s += __shfl_xor(s, 32);
                if (fq == 0) part[(size_t)row * 16 + u.pn * 4 + wc] = s;
            }
        }
    }
};
template <int SCALE_, int F8IN, bool F8OUT>
struct EpiSwigluT {
    static constexpr int SCALE = SCALE_; static constexpr bool PERM = true;
    void* H; RowTbl rt;
    __device__ __forceinline__ void operator()(const f32x4 (&acc)[2][2][4][2], const Unit& u, int wr, int wc, int fr, int fq, int par) const {
#pragma unroll
        for (int ai = 0; ai < 2; ++ai)
#pragma unroll
            for (int m = 0; m < 4; ++m) {
                asm volatile("" ::: "memory");
                const int row = u.pm * BM + ai * HALF + wr * 64 + m * 16 + fr;
                const float rs = (SCALE ? rt.tbl[par * 256 + ai * HALF + wr * 64 + m * 16 + fr] : 1.0f) * (F8IN == 1 ? 1.0f / (F8_SX * F8_SW) : F8IN == 2 ? 1.0f / (F6_SX * F6_SW) : 1.0f);
                f32x4 hv[2];
                const float rl = -rs * LOG2E, rr = rs * rs * (F8OUT ? F8_SH : 1.0f);
#pragma unroll
                for (int n = 0; n < 2; ++n) {
                    const f32x4 a0 = acc[ai][0][m][n], a1 = acc[ai][1][m][n];
#pragma unroll
                    for (int e = 0; e < 4; ++e) { const float sg = __builtin_amdgcn_rcpf(1.0f + __builtin_amdgcn_exp2f(a0[e] * rl)); hv[n][e] = (a0[e] * a1[e]) * (rr * sg); }
                }
                if constexpr (F8OUT) { u32x2 w; w.x = cvt4_fp8(hv[0][0], hv[0][1], hv[0][2], hv[0][3]); w.y = cvt4_fp8(hv[1][0], hv[1][1], hv[1][2], hv[1][3]);
                    *(u32x2*)((unsigned char*)H + (size_t)row * FF + u.pn * HALF + wc * 32 + 8 * fq) = w; }
                else *(u32x4*)((bf16_t*)H + (size_t)row * FF + u.pn * HALF + wc * 32 + 8 * fq) = pack8(hv[0], hv[1]);
            }
    }
};
struct EpiY {
    static constexpr int SCALE = 0; static constexpr bool PERM = true;
    bf16_t* O;
    __device__ __forceinline__ void operator()(const f32x4 (&acc)[2][2][4][2], const Unit& u, int wr, int wc, int fr, int fq, int par) const {
#pragma unroll
        for (int ai = 0; ai < 2; ++ai)
#pragma unroll
            for (int m = 0; m < 4; ++m) {
                asm volatile("" ::: "memory");
                const int row = u.pm * BM + ai * HALF + wr * 64 + m * 16 + fr;
#pragma unroll
                for (int bj = 0; bj < 2; ++bj) *(u32x4*)(O + (size_t)row * D + u.pn * BM + bj * HALF + wc * 32 + 8 * fq) = pack8(acc[ai][bj][m][0], acc[ai][bj][m][1]);
            }
    }
};
struct EpiYs {
    static constexpr int SCALE = 0; static constexpr bool PERM = true;
    bf16_t* O; int n0, prow;
    __device__ __forceinline__ void operator()(const f32x4 (&acc)[2][2][4][2], const Unit& u, int wr, int wc, int fr, int fq, int par) const {
#pragma unroll
        for (int ai = 0; ai < 2; ++ai)
#pragma unroll
            for (int m = 0; m < 4; ++m) {
                const int row = u.ks * prow + (u.pm - n0) * BM + ai * HALF + wr * 64 + m * 16 + fr;
#pragma unroll
                for (int bj = 0; bj < 2; ++bj) *(u32x4*)(O + (size_t)row * D + u.pn * BM + bj * HALF + wc * 32 + 8 * fq) = pack8(acc[ai][bj][m][0], acc[ai][bj][m][1]);
            }
    }
};
}

namespace att {
constexpr int VSLOT = 8192;
template <int NDK, int MODE, int NSL> struct Lay {
    static constexpr int KSLOT = NDK * 2048, LDS_K = 0, LDS_V = NSL * KSLOT, LDS_WS = LDS_V + NSL * VSLOT, LDS_CB = LDS_WS + 8 * 256, LDS_OST = 0,
                         LDS_TOTAL = LDS_CB + (MODE == 1 ? 32768 : 0);
    static_assert(LDS_TOTAL <= RING_BYTES && 8 * 4096 <= LDS_WS, "attention LDS");
};
struct AU {
    const bf16_t* Q; const bf16_t* K; const bf16_t* V; bf16_t* O; float* lse; const float* colb;
    int qpitch, kpitch, vpitch, opitch, lpitch;
    unsigned char* O8; int o8pitch;
    int q0, kt0, kt1, span; float alibi, sink2, xthr;
    unsigned long long* stamp;
};
__device__ __forceinline__ int crow(int r, int hi) { return (r & 3) + 8 * (r >> 2) + 4 * hi; }
__device__ __forceinline__ void glds16(const void* gsrc, unsigned lds_dst) { unsigned keep;
    asm volatile("s_mov_b32 %0, m0\n\ts_mov_b32 m0, %2\n\ts_nop 0\n\tglobal_load_lds_dwordx4 %1, off\n\ts_mov_b32 m0, %0" : "=&s"(keep) : "v"(gsrc), "s"(lds_dst) : "memory"); }
__device__ __forceinline__ void glds16s(unsigned voff, const void* sbase, unsigned lds_dst) { unsigned keep;
    asm volatile("s_mov_b32 %0, m0\n\ts_mov_b32 m0, %3\n\ts_nop 0\n\tglobal_load_lds_dwordx4 %1, %2\n\ts_mov_b32 m0, %0" : "=&s"(keep) : "v"(voff), "s"(sbase), "s"(lds_dst) : "memory"); }
#define ATT_WAIT_BAR() asm volatile("s_waitcnt vmcnt(0) lgkmcnt(0)\n\ts_barrier" ::: "memory")
#define ATT_WAITV_BAR(N) asm volatile("s_waitcnt vmcnt(%0) lgkmcnt(0)\n\ts_barrier" :: "n"(N) : "memory")
__device__ __forceinline__ float permswap_max(float m) { auto rr = __builtin_amdgcn_permlane32_swap(__float_as_uint(m), __float_as_uint(m), false, false); return fmaxf(__uint_as_float(rr[0]), __uint_as_float(rr[1])); }
__device__ __forceinline__ float permswap_sum(float m) { auto rr = __builtin_amdgcn_permlane32_swap(__float_as_uint(m), __float_as_uint(m), false, false); return __uint_as_float(rr[0]) + __uint_as_float(rr[1]); }

#if STAMP_MODE
__device__ __forceinline__ unsigned long long stamp_now() { unsigned long long t; asm volatile("s_memtime %0\n\ts_waitcnt lgkmcnt(0)" : "=s"(t) :: "memory"); return t; }
#endif
#define ATT_PIN() __builtin_amdgcn_sched_barrier(0)
#define KHOFF(d0) (((d0) < 4) ? 4096 : 2048)
#define KA(d0) (((d0) < 4) ? (ka[0] ^ (unsigned)((d0) << 5)) : (ka[1] ^ (unsigned)(((d0) - 4) << 5)))
template <int NDK>
__device__ __forceinline__ void k_issue(bf16x8 (&kf)[2 * NDK], const LAS unsigned char* kslot, const unsigned (&ka)[2]) {
#pragma unroll
    for (int d0 = 0; d0 < NDK; ++d0) { kf[2 * d0] = *(const LAS bf16x8*)(kslot + KA(d0)); kf[2 * d0 + 1] = *(const LAS bf16x8*)(kslot + KA(d0) + KHOFF(d0)); }
}
template <int NDK>
__device__ __forceinline__ void qk_mma_c(f32x16& p0, f32x16& p1, const bf16x8 (&kf)[2 * NDK], const bf16x8 (&qr)[NDK], const f32x16& cin) {
    p0 = __builtin_amdgcn_mfma_f32_32x32x16_bf16(kf[0], qr[0], cin, 0, 0, 0);
    p1 = __builtin_amdgcn_mfma_f32_32x32x16_bf16(kf[1], qr[0], cin, 0, 0, 0);
#pragma unroll
    for (int d0 = 1; d0 < NDK; ++d0) {
        p0 = __builtin_amdgcn_mfma_f32_32x32x16_bf16(kf[2 * d0], qr[d0], p0, 0, 0, 0);
        p1 = __builtin_amdgcn_mfma_f32_32x32x16_bf16(kf[2 * d0 + 1], qr[d0], p1, 0, 0, 0);
    }
}
template <int NDK>
__device__ __forceinline__ void qk_mma(f32x16& p0, f32x16& p1, const bf16x8 (&kf)[2 * NDK], const bf16x8 (&qr)[NDK]) {
    p0 = (f32x16){}; p1 = (f32x16){};
#pragma unroll
    for (int d0 = 0; d0 < NDK; ++d0) {
        p0 = __builtin_amdgcn_mfma_f32_32x32x16_bf16(kf[2 * d0], qr[d0], p0, 0, 0, 0);
        p1 = __builtin_amdgcn_mfma_f32_32x32x16_bf16(kf[2 * d0 + 1], qr[d0], p1, 0, 0, 0);
    }
}
__device__ __forceinline__ void v_issue(s16x4 (&vlo)[8], s16x4 (&vhi)[8], const LAS unsigned char* vp) {
#pragma unroll
    for (int i = 0; i < 8; ++i) {
        vlo[i] = __builtin_bit_cast(s16x4, __builtin_amdgcn_ds_read_tr16_b64_v4i16((LAS s16x4*)(vp + (i >> 2) * 4096 + (i & 3) * 1024)));
        vhi[i] = __builtin_bit_cast(s16x4, __builtin_amdgcn_ds_read_tr16_b64_v4i16((LAS s16x4*)(vp + (i >> 2) * 4096 + (i & 3) * 1024 + 512)));
    }
}
__device__ __forceinline__ void pv_mma(f32x16& o0, f32x16& o1, f32x16& lacc, const s16x4 (&vlo)[8], const s16x4 (&vhi)[8], const u32x4 pw0, const u32x4 pw1, const u32x4 pw2, const u32x4 pw3) {
    const bf16x8 ones = {0x3F80, 0x3F80, 0x3F80, 0x3F80, 0x3F80, 0x3F80, 0x3F80, 0x3F80};
#define ATT_VF(i) (bf16x8){vlo[i][0], vlo[i][1], vlo[i][2], vlo[i][3], vhi[i][0], vhi[i][1], vhi[i][2], vhi[i][3]}
    o0 = __builtin_amdgcn_mfma_f32_32x32x16_bf16(__builtin_bit_cast(bf16x8, pw0), ATT_VF(0), o0, 0, 0, 0);
    o1 = __builtin_amdgcn_mfma_f32_32x32x16_bf16(__builtin_bit_cast(bf16x8, pw0), ATT_VF(4), o1, 0, 0, 0);
    lacc = __builtin_amdgcn_mfma_f32_32x32x16_bf16(__builtin_bit_cast(bf16x8, pw0), ones, lacc, 0, 0, 0);
    o0 = __builtin_amdgcn_mfma_f32_32x32x16_bf16(__builtin_bit_cast(bf16x8, pw1), ATT_VF(1), o0, 0, 0, 0);
    o1 = __builtin_amdgcn_mfma_f32_32x32x16_bf16(__builtin_bit_cast(bf16x8, pw1), ATT_VF(5), o1, 0, 0, 0);
    lacc = __builtin_amdgcn_mfma_f32_32x32x16_bf16(__builtin_bit_cast(bf16x8, pw1), ones, lacc, 0, 0, 0);
    o0 = __builtin_amdgcn_mfma_f32_32x32x16_bf16(__builtin_bit_cast(bf16x8, pw2), ATT_VF(2), o0, 0, 0, 0);
    o1 = __builtin_amdgcn_mfma_f32_32x32x16_bf16(__builtin_bit_cast(bf16x8, pw2), ATT_VF(6), o1, 0, 0, 0);
    lacc = __builtin_amdgcn_mfma_f32_32x32x16_bf16(__builtin_bit_cast(bf16x8, pw2), ones, lacc, 0, 0, 0);
    o0 = __builtin_amdgcn_mfma_f32_32x32x16_bf16(__builtin_bit_cast(bf16x8, pw3), ATT_VF(3), o0, 0, 0, 0);
    o1 = __builtin_amdgcn_mfma_f32_32x32x16_bf16(__builtin_bit_cast(bf16x8, pw3), ATT_VF(7), o1, 0, 0, 0);
    lacc = __builtin_amdgcn_mfma_f32_32x32x16_bf16(__builtin_bit_cast(bf16x8, pw3), ones, lacc, 0, 0, 0);
#undef ATT_VF
}
__device__ __forceinline__ float max3f(float a, float b, float c) { float r; asm("v_max3_f32 %0, %1, %2, %3" : "=v"(r) : "v"(a), "v"(b), "v"(c)); return r; }

template <int I>
__device__ __forceinline__ void gap_a(f32x16& C0, f32x16& C1, bf16x8 (&kw)[3], const LAS unsigned char* kp, const unsigned (&ka)[2], const bf16x8 (&qr)[6],
                                      const f32x16& P0, const f32x16& P1, u32x4 (&pw)[4], s16x4 (&vlo)[8], s16x4 (&vhi)[8], const LAS unsigned char* vp) {
    const f32x16 zero = {};
    if (I & 1) C1 = __builtin_amdgcn_mfma_f32_32x32x16_bf16(kw[I % 3], qr[I >> 1], (I < 2) ? zero : C1, 0, 0, 0);
    else       C0 = __builtin_amdgcn_mfma_f32_32x32x16_bf16(kw[I % 3], qr[I >> 1], (I < 2) ? zero : C0, 0, 0, 0);
    if (I + 2 < 12) kw[(I + 2) % 3] = *(const LAS bf16x8*)(kp + KA((I + 2) >> 1) + ((I + 2) & 1) * KHOFF((I + 2) >> 1));
    if (I < 8) {
        const f32x16& Ps = (I < 4) ? P0 : P1; constexpr int b = (I & 3) * 4;
        pw[I >> 1][2 * (I & 1)] = cvtpk(Ps[b], Ps[b + 1]); pw[I >> 1][2 * (I & 1) + 1] = cvtpk(Ps[b + 2], Ps[b + 3]);
        asm volatile("" : "+v"(pw[I >> 1]));
        vlo[I] = __builtin_bit_cast(s16x4, __builtin_amdgcn_ds_read_tr16_b64_v4i16((LAS s16x4*)(vp + (I >> 2) * 4096 + (I & 3) * 1024)));
        vhi[I] = __builtin_bit_cast(s16x4, __builtin_amdgcn_ds_read_tr16_b64_v4i16((LAS s16x4*)(vp + (I >> 2) * 4096 + (I & 3) * 1024 + 512)));
    }
    __builtin_amdgcn_sched_barrier(0);
}
template <int J>
__device__ __forceinline__ void gap_b(f32x16& o0, f32x16& o1, f32x16& lacc, const u32x4 (&pw)[4], const s16x4 (&vlo)[8], const s16x4 (&vhi)[8], f32x16& C0, f32x16& C1, float mn) {
    constexpr int g = J / 3, w = J % 3;
    const bf16x8 pa = __builtin_bit_cast(bf16x8, pw[g]);
    if (w == 0)      o0 = __builtin_amdgcn_mfma_f32_32x32x16_bf16(pa, (bf16x8){vlo[g][0], vlo[g][1], vlo[g][2], vlo[g][3], vhi[g][0], vhi[g][1], vhi[g][2], vhi[g][3]}, o0, 0, 0, 0);
    else if (w == 1) o1 = __builtin_amdgcn_mfma_f32_32x32x16_bf16(pa, (bf16x8){vlo[g + 4][0], vlo[g + 4][1], vlo[g + 4][2], vlo[g + 4][3], vhi[g + 4][0], vhi[g + 4][1], vhi[g + 4][2], vhi[g + 4][3]}, o1, 0, 0, 0);
    else             lacc = __builtin_amdgcn_mfma_f32_32x32x16_bf16(pa, (bf16x8){0x3F80, 0x3F80, 0x3F80, 0x3F80, 0x3F80, 0x3F80, 0x3F80, 0x3F80}, lacc, 0, 0, 0);
    constexpr int e0 = (J < 8) ? 3 * J : 24 + 2 * (J - 8), ne = (J < 8) ? 3 : 2;
#pragma unroll
    for (int e = e0; e < e0 + ne; ++e) { if (e < 16) C0[e] = __builtin_amdgcn_exp2f(C0[e] - mn); else C1[e - 16] = __builtin_amdgcn_exp2f(C1[e - 16] - mn); }
    if (e0 < 16) asm volatile("" : "+v"(C0)); if (e0 + ne > 16) asm volatile("" : "+v"(C1));
    __builtin_amdgcn_sched_barrier(0);
}

template <int NDK, int MODE, int NSL>
__device__ __forceinline__ void attn_unit(const AU& u, LAS unsigned char* shm) {
    typedef Lay<NDK, MODE, NSL> L; constexpr int KSLOT = L::KSLOT, LDS_K = L::LDS_K, LDS_V = L::LDS_V, LDS_WS = L::LDS_WS, LDS_CB = L::LDS_CB, LDS_OST = L::LDS_OST, DF = NSL - 2;
    int tid_l = threadIdx.x; asm volatile("" : "+v"(tid_l));
    const int tid = tid_l, lane = tid & 63, r32 = lane & 31, hi = lane >> 5; const int wid = __builtin_amdgcn_readfirstlane(tid >> 6);
    const unsigned lds0 = (unsigned)(uintptr_t)shm;
    LAS float* wsf = (LAS float*)(shm + LDS_WS) + wid * 64;
    LAS float* cb = (LAS float*)(shm + LDS_CB);
    const int q = u.q0 + wid * 32 + r32;
    const int qmin = u.q0 + wid * 32, qmax = qmin + 31;
    float cq = 0.f;
    int ukt0 = u.kt0;
    if (MODE == 1) {
        LAS int* red = (LAS int*)cb;
        if (tid == 0) *red = u.kt1 - 1;
        ATT_WAIT_BAR();
        const float thr = u.colb[u.q0] + u.xthr;
        for (int j = tid; j < u.kt1; j += 512) if (u.colb[64 * j + 63] <= thr) atomicMin((int*)red, j);
        ATT_WAIT_BAR();
        ukt0 = __builtin_amdgcn_readfirstlane(*red);
        ATT_WAIT_BAR();
        const int nk = (u.kt1 - ukt0) * 64;
        for (int i = tid; i < nk; i += 512) cb[i] = u.colb[ukt0 * 64 + i];
        cq = u.colb[q];
    }
    bf16x8 qr[NDK];
    { const bf16_t* qp = u.Q + (size_t)q * u.qpitch + hi * 8;
#pragma unroll
      for (int d0 = 0; d0 < NDK; ++d0) qr[d0] = *(const bf16x8*)(qp + d0 * 16); }
    const unsigned dk_off = (unsigned)(8 * wid + (lane >> 3)) * (unsigned)u.kpitch * 2u + (unsigned)(((lane & 7) ^ (((8 * wid + (lane >> 3)) >> 1) & 7)) * 16);
    const unsigned dk_off2 = (unsigned)(16 * (wid & 3) + (lane >> 2)) * (unsigned)u.kpitch * 2u + 128u + (unsigned)(((lane & 3) ^ (((16 * (wid & 3) + (lane >> 2)) >> 2) & 3)) * 16);
    const unsigned dv_off = (unsigned)(16 * (wid & 3) + (lane >> 2)) * (unsigned)u.vpitch * 2u + (unsigned)(wid >> 2) * 64u + (unsigned)(lane & 3) * 16u;
#define ATT_ISSUE(kt_, s_) do { \
        const char* kb_ = (const char*)u.K + (size_t)(kt_) * 64 * u.kpitch * 2; const char* vb_ = (const char*)u.V + (size_t)(kt_) * 64 * u.vpitch * 2; \
        glds16s(dk_off, kb_, (unsigned)__builtin_amdgcn_readfirstlane(lds0 + LDS_K + (s_) * KSLOT + wid * 1024)); \
        if (NDK == 6) { if (wid < 4) glds16s(dk_off2, kb_, (unsigned)__builtin_amdgcn_readfirstlane(lds0 + LDS_K + (s_) * KSLOT + (wid + 8) * 1024)); } \
        glds16s(dv_off, vb_, (unsigned)__builtin_amdgcn_readfirstlane(lds0 + LDS_V + (s_) * VSLOT + wid * 1024)); } while (0)
    float mrun = -3.0e38f;
    f32x16 o0 = {}, o1 = {}, lacc = {};
    const int nT = u.kt1 - ukt0;
    int whi = qmax >> 6; if (whi > u.kt1 - 1) whi = u.kt1 - 1;
    int wlo = ukt0; if (MODE == 2) { const int l_ = (qmin - u.span) >> 6; if (l_ > wlo) wlo = l_; }
    const int mask_from = qmin >> 6;
    u32x4 pw0, pw1, pw2, pw3;
#define ATT_SOFT(p0, p1, kt_) do { \
        const int kmin_ = (kt_) * 64; \
        if (MODE == 1) { \
            const LAS f32x4* cp_ = (const LAS f32x4*)(cb + ((kt_) - ukt0) * 64 + 4 * hi); \
            _Pragma("unroll") for (int j = 0; j < 4; ++j) { const f32x4 c0_ = cp_[2 * j], c1_ = cp_[2 * j + 8]; \
                _Pragma("unroll") for (int e = 0; e < 4; ++e) { p0[4 * j + e] += cq - c0_[e]; p1[4 * j + e] += cq - c1_[e]; } } \
        } \
        if (MODE == 2) { \
            _Pragma("unroll") for (int r = 0; r < 16; ++r) { const int d0_ = q - (kmin_ + crow(r, hi)), d1_ = d0_ - 32; \
                p0[r] = ((unsigned)d0_ <= (unsigned)u.span) ? p0[r] - u.alibi * (float)d0_ : -INFINITY; \
                p1[r] = ((unsigned)d1_ <= (unsigned)u.span) ? p1[r] - u.alibi * (float)d1_ : -INFINITY; } \
        } else if ((kt_) >= mask_from) { \
            _Pragma("unroll") for (int r = 0; r < 16; ++r) { const int kj_ = kmin_ + crow(r, hi); if (kj_ > q) p0[r] = -INFINITY; if (kj_ + 32 > q) p1[r] = -INFINITY; } \
        } \
        float ra_ = max3f(p0[0], p0[1], p1[0]), rb_ = max3f(p0[2], p0[3], p1[1]); ra_ = max3f(ra_, p1[2], p1[3]); \
        _Pragma("unroll") for (int r = 4; r < 16; r += 4) { ra_ = max3f(ra_, p0[r], p0[r + 1]); rb_ = max3f(rb_, p0[r + 2], p0[r + 3]); ra_ = max3f(ra_, p1[r], p1[r + 1]); rb_ = max3f(rb_, p1[r + 2], p1[r + 3]); } \
        float rm_ = max3f(ra_, rb_, mrun); \
        { auto rr_ = __builtin_amdgcn_permlane32_swap(__float_as_uint(rm_), __float_as_uint(rm_), false, false); rm_ = max3f(__uint_as_float(rr_[0]), __uint_as_float(rr_[1]), mrun); } \
        const bool grow_ = __any(rm_ > mrun + 8.0f);                        \
        const float mn_ = grow_ ? rm_ : mrun, alpha_ = __builtin_amdgcn_exp2f(mrun - mn_); \
        mrun = mn_; \
        _Pragma("unroll") for (int r = 0; r < 16; ++r) { p0[r] = __builtin_amdgcn_exp2f(p0[r] - mn_); p1[r] = __builtin_amdgcn_exp2f(p1[r] - mn_); } \
        if (!__all(alpha_ == 1.0f)) { \
            if (hi == 0) wsf[r32] = alpha_; \
            LDS_WAIT(); \
            _Pragma("unroll") for (int j = 0; j < 4; ++j) { const f32x4 f_ = *(const LAS f32x4*)(wsf + 8 * j + 4 * hi); \
                _Pragma("unroll") for (int e = 0; e < 4; ++e) { o0[4 * j + e] *= f_[e]; o1[4 * j + e] *= f_[e]; lacc[4 * j + e] *= f_[e]; } } \
        } \
        pw0 = (u32x4){cvtpk(p0[0], p0[1]), cvtpk(p0[2], p0[3]), cvtpk(p0[4], p0[5]), cvtpk(p0[6], p0[7])}; \
        pw1 = (u32x4){cvtpk(p0[8], p0[9]), cvtpk(p0[10], p0[11]), cvtpk(p0[12], p0[13]), cvtpk(p0[14], p0[15])}; \
        pw2 = (u32x4){cvtpk(p1[0], p1[1]), cvtpk(p1[2], p1[3]), cvtpk(p1[4], p1[5]), cvtpk(p1[6], p1[7])}; \
        pw3 = (u32x4){cvtpk(p1[8], p1[9]), cvtpk(p1[10], p1[11]), cvtpk(p1[12], p1[13]), cvtpk(p1[14], p1[15])}; \
    } while (0)
    f32x16 negm = {}; bool first = true;
#define ATT_THR 8.0f
#define ATT_SOFT_N(p0, p1, kt_) do { \
        const int kmin_ = (kt_) * 64; \
        if (MODE == 1) { \
            const LAS f32x4* cp_ = (const LAS f32x4*)(cb + ((kt_) - ukt0) * 64 + 4 * hi); \
            _Pragma("unroll") for (int j = 0; j < 4; ++j) { const f32x4 c0_ = cp_[2 * j], c1_ = cp_[2 * j + 8]; \
                _Pragma("unroll") for (int e = 0; e < 4; ++e) { p0[4 * j + e] += cq - c0_[e]; p1[4 * j + e] += cq - c1_[e]; } } \
        } \
        if ((kt_) >= mask_from) { \
            _Pragma("unroll") for (int r = 0; r < 16; ++r) { const int kj_ = kmin_ + crow(r, hi); if (kj_ > q) p0[r] = -INFINITY; if (kj_ + 32 > q) p1[r] = -INFINITY; } \
        } \
        float ra_ = max3f(p0[0], p0[1], p1[0]), rb_ = max3f(p0[2], p0[3], p1[1]); ra_ = max3f(ra_, p1[2], p1[3]); \
        _Pragma("unroll") for (int r = 4; r < 16; r += 4) { ra_ = max3f(ra_, p0[r], p0[r + 1]); rb_ = max3f(rb_, p0[r + 2], p0[r + 3]); ra_ = max3f(ra_, p1[r], p1[r + 1]); rb_ = max3f(rb_, p1[r + 2], p1[r + 3]); } \
        float rm_ = fmaxf(ra_, rb_); \
        { auto rr_ = __builtin_amdgcn_permlane32_swap(__float_as_uint(rm_), __float_as_uint(rm_), false, false); rm_ = fmaxf(__uint_as_float(rr_[0]), __uint_as_float(rr_[1])); } \
        const float dl_ = first ? rm_ : fmaxf(rm_, 0.f);                   \
        if (first || __any(rm_ > ATT_THR)) {                                \
            mrun = first ? dl_ : mrun + dl_; \
            _Pragma("unroll") for (int r = 0; r < 16; ++r) { p0[r] -= dl_; p1[r] -= dl_; negm[r] = -mrun; } \
            if (!first) { \
                if (hi == 0) wsf[r32] = __builtin_amdgcn_exp2f(-dl_); \
                LDS_WAIT(); \
                _Pragma("unroll") for (int j = 0; j < 4; ++j) { const f32x4 f_ = *(const LAS f32x4*)(wsf + 8 * j + 4 * hi); \
                    _Pragma("unroll") for (int e = 0; e < 4; ++e) { o0[4 * j + e] *= f_[e]; o1[4 * j + e] *= f_[e]; lacc[4 * j + e] *= f_[e]; } } \
            } \
            first = false; \
        } \
        _Pragma("unroll") for (int r = 0; r < 16; ++r) { p0[r] = __builtin_amdgcn_exp2f(p0[r]); p1[r] = __builtin_amdgcn_exp2f(p1[r]); } \
        pw0 = (u32x4){cvtpk(p0[0], p0[1]), cvtpk(p0[2], p0[3]), cvtpk(p0[4], p0[5]), cvtpk(p0[6], p0[7])}; \
        pw1 = (u32x4){cvtpk(p0[8], p0[9]), cvtpk(p0[10], p0[11]), cvtpk(p0[12], p0[13]), cvtpk(p0[14], p0[15])}; \
        pw2 = (u32x4){cvtpk(p1[0], p1[1]), cvtpk(p1[2], p1[3]), cvtpk(p1[4], p1[5]), cvtpk(p1[6], p1[7])}; \
        pw3 = (u32x4){cvtpk(p1[8], p1[9]), cvtpk(p1[10], p1[11]), cvtpk(p1[12], p1[13]), cvtpk(p1[14], p1[15])}; \
    } while (0)
#pragma unroll
    for (int j = 0; j < (MODE == 2 ? NSL : DF + 1); ++j) if (j < nT) ATT_ISSUE(ukt0 + j, j);
    const LAS unsigned char* kaddr0 = shm + LDS_K;
    const unsigned ka[2] = {(unsigned)(r32 * 128 + ((hi ^ ((r32 >> 1) & 7)) * 16)), (unsigned)(8192 + r32 * 64 + ((hi ^ ((r32 >> 2) & 3)) * 16))};
    const LAS unsigned char* vaddr0 = shm + LDS_V + ((lane >> 4) & 1) * 32 + (lane & 3) * 8 + (4 * hi + ((lane & 15) >> 2)) * 64;
#define ATT_LOOP(HB) do { \
    constexpr int PER = (NDK == 6 && !(HB)) ? 3 : 2; \
    if (ukt0 + DF < u.kt1) ATT_WAITV_BAR((DF - 1) * PER); else ATT_WAIT_BAR(); \
    f32x16 p0 = {}, p1 = {}; bf16x8 kf[2 * NDK]; s16x4 vlo[8], vhi[8]; \
    if (wlo <= ukt0 && ukt0 <= whi) { k_issue<NDK>(kf, kaddr0, ka); if (HB) { qk_mma_c<NDK>(p0, p1, kf, qr, negm); } } \
    int sc = 0; bool pend = false;                   \
    for (int i = 0; i < nT; ++i) { \
        const int kt = ukt0 + i; \
        ATT_STAMP_PRE(); \
        if (i > 0) { if (kt + DF < u.kt1) ATT_WAITV_BAR((DF - 1) * PER); else ATT_WAIT_BAR(); } \
        ATT_STAMP_POST(); \
        const int sn = (sc + 1 == NSL) ? 0 : sc + 1; \
        if (kt + DF + 1 < u.kt1) { const int sf_ = (sc == 0) ? NSL - 1 : sc - 1; ATT_ISSUE(kt + DF + 1, sf_); } \
        const bool actc = (wlo <= kt) && (kt <= whi), actn = (kt + 1 < u.kt1) && (wlo <= kt + 1) && (kt + 1 <= whi); \
        if (!(HB)) {                                  \
            if (pend) { pv_mma(o0, o1, lacc, vlo, vhi, pw0, pw1, pw2, pw3); pend = false; } \
            if (actc) { \
                qk_mma_c<NDK>(p0, p1, kf, qr, negm); ATT_PIN(); \
                v_issue(vlo, vhi, vaddr0 + sc * VSLOT); ATT_PIN(); \
                ATT_SOFT_N(p0, p1, kt); \
                ATT_PIN(); \
                pend = true; \
            } \
            if (actn) { k_issue<NDK>(kf, kaddr0 + sn * KSLOT, ka); ATT_PIN(); } \
        } else {                                      \
            if (actc) { \
                v_issue(vlo, vhi, vaddr0 + sc * VSLOT); ATT_PIN(); \
                ATT_SOFT_N(p0, p1, kt); \
                ATT_PIN(); \
                if (actn) { k_issue<NDK>(kf, kaddr0 + sn * KSLOT, ka); ATT_PIN(); } \
                pv_mma(o0, o1, lacc, vlo, vhi, pw0, pw1, pw2, pw3); \
                if (actn) qk_mma_c<NDK>(p0, p1, kf, qr, negm); \
            } else if (actn) { k_issue<NDK>(kf, kaddr0 + sn * KSLOT, ka); qk_mma_c<NDK>(p0, p1, kf, qr, negm); } \
        } \
        sc = sn; \
    } \
    if (!(HB)) { if (pend) pv_mma(o0, o1, lacc, vlo, vhi, pw0, pw1, pw2, pw3); } \
    } while (0)
#if STAMP_MODE
    const bool stamper = (NDK == 6) && u.stamp && (wid == ((STAMP_MODE == 2) ? 4 : 0));
    unsigned long long st_wait = 0, st_t0 = 0, st_pre = 0; if (stamper) st_t0 = stamp_now();
#define ATT_STAMP_PRE() do { if (stamper) st_pre = stamp_now(); } while (0)
#define ATT_STAMP_POST() do { if (stamper) st_wait += stamp_now() - st_pre; } while (0)
#else
#define ATT_STAMP_PRE() do { } while (0)
#define ATT_STAMP_POST() do { } while (0)
#endif
#define ATT_IL_MID(C0, C1, kt_) do { \
        if ((kt_) >= mask_from) { const int kmin_ = (kt_) * 64; \
            _Pragma("unroll") for (int r = 0; r < 16; ++r) { const int kj_ = kmin_ + crow(r, hi); if (kj_ > q) C0[r] = -INFINITY; if (kj_ + 32 > q) C1[r] = -INFINITY; } } \
        float ra_ = max3f(C0[0], C0[1], C1[0]), rb_ = max3f(C0[2], C0[3], C1[1]); ra_ = max3f(ra_, C1[2], C1[3]); \
        _Pragma("unroll") for (int r = 4; r < 16; r += 4) { ra_ = max3f(ra_, C0[r], C0[r + 1]); rb_ = max3f(rb_, C0[r + 2], C0[r + 3]); ra_ = max3f(ra_, C1[r], C1[r + 1]); rb_ = max3f(rb_, C1[r + 2], C1[r + 3]); } \
        float rm_ = max3f(ra_, rb_, mrun); \
        { auto rr_ = __builtin_amdgcn_permlane32_swap(__float_as_uint(rm_), __float_as_uint(rm_), false, false); rm_ = max3f(__uint_as_float(rr_[0]), __uint_as_float(rr_[1]), mrun); } \
        alpha = __builtin_amdgcn_exp2f(mrun - rm_); mrun = rm_; \
        __builtin_amdgcn_sched_barrier(0); \
    } while (0)
#define ATT_IL_RESC() do { \
        if (!__all(alpha == 1.0f)) { \
            if (hi == 0) wsf[r32] = alpha; \
            LDS_WAIT(); \
            _Pragma("unroll") for (int j = 0; j < 4; ++j) { const f32x4 f_ = *(const LAS f32x4*)(wsf + 8 * j + 4 * hi); \
                _Pragma("unroll") for (int e = 0; e < 4; ++e) { o0[4 * j + e] *= f_[e]; o1[4 * j + e] *= f_[e]; lacc[4 * j + e] *= f_[e]; } } \
        } } while (0)
#define ATT_IL_WAIT(need_, PER) do { if ((need_) + (NSL - 3) <= last_iss) ATT_WAITV_BAR((NSL - 3) * PER); else ATT_WAIT_BAR(); } while (0)
#define ATT_IL_STEP(C0, C1, P0, P1, PER) do { \
        ATT_IL_WAIT(kt, PER); \
        if (last_iss + 1 < u.kt1) { ++last_iss; ATT_ISSUE(last_iss, (last_iss - ukt0) % NSL); } \
        const LAS unsigned char* kp_ = kaddr0 + ((kt - ukt0) % NSL) * KSLOT; const LAS unsigned char* vp_ = vaddr0 + ((kt - 1 - ukt0) % NSL) * VSLOT; \
        kw[0] = *(const LAS bf16x8*)(kp_ + KA(0)); kw[1] = *(const LAS bf16x8*)(kp_ + KA(0) + KHOFF(0)); __builtin_amdgcn_sched_barrier(0); \
        gap_a<0>(C0, C1, kw, kp_, ka, qr, P0, P1, pw, vlo, vhi, vp_); gap_a<1>(C0, C1, kw, kp_, ka, qr, P0, P1, pw, vlo, vhi, vp_); gap_a<2>(C0, C1, kw, kp_, ka, qr, P0, P1, pw, vlo, vhi, vp_); \
        gap_a<3>(C0, C1, kw, kp_, ka, qr, P0, P1, pw, vlo, vhi, vp_); gap_a<4>(C0, C1, kw, kp_, ka, qr, P0, P1, pw, vlo, vhi, vp_); gap_a<5>(C0, C1, kw, kp_, ka, qr, P0, P1, pw, vlo, vhi, vp_); \
        gap_a<6>(C0, C1, kw, kp_, ka, qr, P0, P1, pw, vlo, vhi, vp_); gap_a<7>(C0, C1, kw, kp_, ka, qr, P0, P1, pw, vlo, vhi, vp_); gap_a<8>(C0, C1, kw, kp_, ka, qr, P0, P1, pw, vlo, vhi, vp_); \
        gap_a<9>(C0, C1, kw, kp_, ka, qr, P0, P1, pw, vlo, vhi, vp_); gap_a<10>(C0, C1, kw, kp_, ka, qr, P0, P1, pw, vlo, vhi, vp_); gap_a<11>(C0, C1, kw, kp_, ka, qr, P0, P1, pw, vlo, vhi, vp_); \
        float alpha; ATT_IL_MID(C0, C1, kt); \
        gap_b<0>(o0, o1, lacc, pw, vlo, vhi, C0, C1, mrun); gap_b<1>(o0, o1, lacc, pw, vlo, vhi, C0, C1, mrun); gap_b<2>(o0, o1, lacc, pw, vlo, vhi, C0, C1, mrun); \
        gap_b<3>(o0, o1, lacc, pw, vlo, vhi, C0, C1, mrun); gap_b<4>(o0, o1, lacc, pw, vlo, vhi, C0, C1, mrun); gap_b<5>(o0, o1, lacc, pw, vlo, vhi, C0, C1, mrun); \
        gap_b<6>(o0, o1, lacc, pw, vlo, vhi, C0, C1, mrun); gap_b<7>(o0, o1, lacc, pw, vlo, vhi, C0, C1, mrun); gap_b<8>(o0, o1, lacc, pw, vlo, vhi, C0, C1, mrun); \
        gap_b<9>(o0, o1, lacc, pw, vlo, vhi, C0, C1, mrun); gap_b<10>(o0, o1, lacc, pw, vlo, vhi, C0, C1, mrun); gap_b<11>(o0, o1, lacc, pw, vlo, vhi, C0, C1, mrun); \
        ATT_IL_RESC(); \
    } while (0)
#define ATT_IL(PER) do { \
    int last_iss = ukt0 - 1; \
    _Pragma("unroll") for (int j = 0; j < NSL - 1; ++j) if (j < nT) { ATT_ISSUE(ukt0 + j, j); last_iss = ukt0 + j; } \
    f32x16 pA0, pA1, pB0, pB1; bf16x8 kw[3]; s16x4 vlo[8], vhi[8]; u32x4 pw[4]; \
    ATT_IL_WAIT(ukt0, PER); \
    { int kt = ukt0; { bf16x8 kf0_[2 * NDK]; k_issue<NDK>(kf0_, kaddr0, ka); qk_mma<NDK>(pA0, pA1, kf0_, qr); } float alpha; ATT_IL_MID(pA0, pA1, kt); (void)alpha; \
      _Pragma("unroll") for (int r = 0; r < 16; ++r) { pA0[r] = __builtin_amdgcn_exp2f(pA0[r] - mrun); pA1[r] = __builtin_amdgcn_exp2f(pA1[r] - mrun); } } \
    int kt = ukt0 + 1; \
    for (; kt + 1 < u.kt1; kt += 2) { ATT_IL_STEP(pB0, pB1, pA0, pA1, PER); ++kt; ATT_IL_STEP(pA0, pA1, pB0, pB1, PER); --kt; } \
    bool lastB = false; \
    if (kt < u.kt1) { ATT_IL_STEP(pB0, pB1, pA0, pA1, PER); ++kt; lastB = true; } \
      \
    { const LAS unsigned char* vp_ = vaddr0 + ((u.kt1 - 1 - ukt0) % NSL) * VSLOT; u32x4 q0_, q1_, q2_, q3_; \
      if (lastB) { q0_ = (u32x4){cvtpk(pB0[0], pB0[1]), cvtpk(pB0[2], pB0[3]), cvtpk(pB0[4], pB0[5]), cvtpk(pB0[6], pB0[7])}; q1_ = (u32x4){cvtpk(pB0[8], pB0[9]), cvtpk(pB0[10], pB0[11]), cvtpk(pB0[12], pB0[13]), cvtpk(pB0[14], pB0[15])}; \
                    q2_ = (u32x4){cvtpk(pB1[0], pB1[1]), cvtpk(pB1[2], pB1[3]), cvtpk(pB1[4], pB1[5]), cvtpk(pB1[6], pB1[7])}; q3_ = (u32x4){cvtpk(pB1[8], pB1[9]), cvtpk(pB1[10], pB1[11]), cvtpk(pB1[12], pB1[13]), cvtpk(pB1[14], pB1[15])}; } \
      else       { q0_ = (u32x4){cvtpk(pA0[0], pA0[1]), cvtpk(pA0[2], pA0[3]), cvtpk(pA0[4], pA0[5]), cvtpk(pA0[6], pA0[7])}; q1_ = (u32x4){cvtpk(pA0[8], pA0[9]), cvtpk(pA0[10], pA0[11]), cvtpk(pA0[12], pA0[13]), cvtpk(pA0[14], pA0[15])}; \
                    q2_ = (u32x4){cvtpk(pA1[0], pA1[1]), cvtpk(pA1[2], pA1[3]), cvtpk(pA1[4], pA1[5]), cvtpk(pA1[6], pA1[7])}; q3_ = (u32x4){cvtpk(pA1[8], pA1[9]), cvtpk(pA1[10], pA1[11]), cvtpk(pA1[12], pA1[13]), cvtpk(pA1[14], pA1[15])}; } \
      v_issue(vlo, vhi, vp_); pv_mma(o0, o1, lacc, vlo, vhi, q0_, q1_, q2_, q3_); } \
    } while (0)
    if constexpr (false && MODE == 0 && NDK == 6) { if (wid < 4) ATT_IL(3); else ATT_IL(2); }
    else if constexpr (MODE == 2) {
        ATT_WAIT_BAR();
        f32x16 p0 = {}, p1 = {}; bf16x8 kf[2 * NDK]; s16x4 vlo[8], vhi[8];
        const int t0 = wlo - ukt0, t1 = whi - ukt0;
        if (t0 <= t1) k_issue<NDK>(kf, kaddr0 + t0 * KSLOT, ka);
        for (int sc = t0; sc <= t1; ++sc) {
            const int kt = ukt0 + sc;
            qk_mma<NDK>(p0, p1, kf, qr); ATT_PIN();
            v_issue(vlo, vhi, vaddr0 + sc * VSLOT); ATT_PIN();
            ATT_SOFT(p0, p1, kt);
            ATT_PIN();
            if (sc < t1) { k_issue<NDK>(kf, kaddr0 + (sc + 1) * KSLOT, ka); ATT_PIN(); }
            pv_mma(o0, o1, lacc, vlo, vhi, pw0, pw1, pw2, pw3);
        }
    }
    else { if (wid < 4) ATT_LOOP(false); else ATT_LOOP(true); }
#undef ATT_IL
#undef ATT_IL_STEP
#undef ATT_IL_WAIT
#undef ATT_IL_RESC
#undef ATT_IL_MID
#if STAMP_MODE
    if (stamper && lane == 0) { u.stamp[0] += st_wait; u.stamp[1] += stamp_now() - st_t0; u.stamp[2] += (unsigned long long)nT; }
#endif
#undef ATT_LOOP
    asm volatile("s_waitcnt lgkmcnt(0)\n\ts_barrier" ::: "memory");
    if (u.lse) {
        if ((lane & 31) == 0) {
#pragma unroll
            for (int j = 0; j < 4; ++j) *(LAS f32x4*)(wsf + 8 * j + 4 * hi) = (f32x4){lacc[4 * j], lacc[4 * j + 1], lacc[4 * j + 2], lacc[4 * j + 3]};
        }
        LDS_WAIT();
        const float lrow = wsf[r32];
        if (hi == 0) u.lse[(size_t)q * u.lpitch] = mrun + __builtin_amdgcn_logf(lrow);
    }
    float rli[16];
    if (MODE == 2) {
        LDS_WAIT();
        if (hi == 0) wsf[32 + r32] = __builtin_amdgcn_exp2f(u.sink2 - mrun);
        LDS_WAIT();
#pragma unroll
        for (int j = 0; j < 4; ++j) { const f32x4 f = *(const LAS f32x4*)(wsf + 32 + 8 * j + 4 * hi);
#pragma unroll
            for (int e = 0; e < 4; ++e) rli[4 * j + e] = __builtin_amdgcn_rcpf(lacc[4 * j + e] + f[e]); }
    } else {
#pragma unroll
        for (int r = 0; r < 16; ++r) rli[r] = __builtin_amdgcn_rcpf(lacc[r]);
    }
    { LAS bf16_t* stg = (LAS bf16_t*)(shm + LDS_OST) + wid * 2048;
#pragma unroll
      for (int r = 0; r < 16; ++r) { const int orow = crow(r, hi);
          stg[orow * 64 + r32] = (bf16_t)(cvtpk(o0[r] * rli[r], 0.f) & 0xffffu);
          stg[orow * 64 + 32 + r32] = (bf16_t)(cvtpk(o1[r] * rli[r], 0.f) & 0xffffu); }
      LDS_WAIT();
      bf16_t* Ow = u.O + (size_t)(u.q0 + wid * 32) * u.opitch;
#pragma unroll
      for (int i = 0; i < 4; ++i) { const int row = i * 8 + (lane >> 3), ch = lane & 7; const u32x4 v = *(const LAS u32x4*)(stg + row * 64 + ch * 8);
          if (u.O8) { u32x2 w8;
              w8.x = cvt4_fp8(__uint_as_float(v.x << 16) * F8_SM, __uint_as_float(v.x & 0xffff0000u) * F8_SM, __uint_as_float(v.y << 16) * F8_SM, __uint_as_float(v.y & 0xffff0000u) * F8_SM);
              w8.y = cvt4_fp8(__uint_as_float(v.z << 16) * F8_SM, __uint_as_float(v.z & 0xffff0000u) * F8_SM, __uint_as_float(v.w << 16) * F8_SM, __uint_as_float(v.w & 0xffff0000u) * F8_SM);
              *(u32x2*)(u.O8 + (size_t)(u.q0 + wid * 32 + row) * u.o8pitch + ch * 8) = w8; }
          else *(u32x4*)(Ow + (size_t)row * u.opitch + ch * 8) = v; } }
    ATT_WAIT_BAR();
#undef ATT_ISSUE
#undef ATT_SOFT
}
}

#define XB_TMO      128
#define XB_XCNT(j)  (256  + 64 * (j))
#define XB_XSUB(j)  (1280 + 64 * (j))
#define XB_XGEN(j)  (2304 + 64 * (j))
#define XB_TOP      3328
#define XB_TOPGEN   3392
#define XCD_BAR_WORDS 3456
#define XB_SPIN_CAP (1u << 18)
__device__ __forceinline__ unsigned xb_ld(unsigned* p)              { return __hip_atomic_load(p, __ATOMIC_RELAXED, __HIP_MEMORY_SCOPE_AGENT); }
__device__ __forceinline__ unsigned xb_add(unsigned* p, unsigned v) { return __hip_atomic_fetch_add(p, v, __ATOMIC_RELAXED, __HIP_MEMORY_SCOPE_AGENT); }
__device__ __forceinline__ unsigned xb_xcc_id() { return (unsigned)__builtin_amdgcn_s_getreg((3 << 11) | 20) & 0xFu; }
#define XB_SPIN(cond, bar) do { unsigned _sp = 0; while (cond) { __builtin_amdgcn_s_sleep(1); \
    if ((++_sp & 255u) == 0u) { if (xb_ld(&(bar)[XB_TMO])) break; if (_sp > XB_SPIN_CAP) { atomicAdd(&(bar)[XB_TMO], 1u); break; } } } } while (0)
struct XcdBarrier { unsigned* bar; unsigned x; volatile LAS unsigned* st; };
__device__ __forceinline__ XcdBarrier xcd_barrier_post(unsigned* bar, volatile LAS unsigned* st) {
    XcdBarrier b; b.bar = bar; b.x = xb_xcc_id(); b.st = st;
    if (threadIdx.x == 0) (void)xb_add(&bar[XB_XCNT(b.x)], 1u);
    return b;
}
__device__ __forceinline__ void xcd_barrier_complete(unsigned* bar, unsigned x, unsigned& nloc, unsigned& nx) {
    const unsigned G = gridDim.x * gridDim.y * gridDim.z;
    unsigned sum, cnt, mine, sp = 0u;
    for (;;) {
        sum = 0u; cnt = 0u; mine = 0u;
#pragma unroll
        for (unsigned j = 0; j < 16; ++j) { const unsigned c = xb_ld(&bar[XB_XCNT(j)]); sum += c; cnt += (c > 0u) ? 1u : 0u; mine = (j == x) ? c : mine; }
        if (sum == G) break;
        __builtin_amdgcn_s_sleep(1);
        if ((++sp & 255u) == 0u) { if (xb_ld(&bar[XB_TMO])) break; if (sp > XB_SPIN_CAP) { atomicAdd(&bar[XB_TMO], 1u); break; } }
    }
    nloc = mine > 0u ? mine : 1u; nx = cnt > 0u ? cnt : 1u;
}
__device__ __forceinline__ void xcd_barrier(const XcdBarrier& b) {
    asm volatile("s_waitcnt vmcnt(0)" ::: "memory");
    __syncthreads();
    if (threadIdx.x == 0) {
        unsigned* bar = b.bar;
        __builtin_amdgcn_s_waitcnt(0);
        unsigned nloc = b.st[0], nx = b.st[1];
        if (nloc == 0u) { xcd_barrier_complete(bar, b.x, nloc, nx); b.st[0] = nloc; b.st[1] = nx; }
        const unsigned old = xb_add(&bar[XB_XSUB(b.x)], 1u);
        const unsigned gen = old / nloc;
        if (old + 1u == (gen + 1u) * nloc) {
            __builtin_amdgcn_fence(__ATOMIC_RELEASE, "agent");
            asm volatile("s_waitcnt vmcnt(0)" ::: "memory");
            const unsigned og = xb_add(&bar[XB_TOP], 1u);
            const unsigned tg = og / nx;
            if (og + 1u == (tg + 1u) * nx) xb_add(&bar[XB_TOPGEN], 1u);
            else XB_SPIN(xb_ld(&bar[XB_TOPGEN]) == tg, bar);
            __builtin_amdgcn_fence(__ATOMIC_ACQUIRE, "agent");
            xb_add(&bar[XB_XGEN(b.x)], 1u);
            asm volatile("s_waitcnt vmcnt(0)" ::: "memory");
        } else {
            XB_SPIN(xb_ld(&bar[XB_XGEN(b.x)]) == gen, bar);
            __builtin_amdgcn_fence(__ATOMIC_ACQUIRE, "agent");
            asm volatile("s_waitcnt vmcnt(0)" ::: "memory");
        }
    }
    __syncthreads();
}

struct Args {
    const float* x; const int* pos; const float* attn_norm; const float* w_in; const float* b_forget; const float* mla_q_norm; const float* w_q_up;
    const float* mla_kv_norm; const float* w_kv_up; const float* sinks; const float* w_out; const float* ffn_norm; const float* dense_w_gate; const float* dense_w_up;
    const float* dense_w_down; const float* router; const float* moe_w_gate; const float* moe_w_up; const float* moe_w_down; const float* final_norm;
    float* out; unsigned char* ws; int ph_lo, ph_hi;
};
struct Frame {
    LAS unsigned char* lds; int tid, lane, wave, G, c;
};

__device__ __forceinline__ int rope_perm(int j) { const int i = j & 15, t2 = j >> 4; return 8 * (i >> 2) + 4 * t2 + (i & 3); }
__device__ __forceinline__ int map_col(int kind, int n, float& sc) {
    sc = 1.0f;
    if (kind == 0) return n;
    if (kind == 1) {
        if (n < 256) { sc = C2_64; return Y_FQ + n; }
        if (n < 512) return Y_FK + (n - 256);
        if (n < 768) return Y_FV + (n - 512);
        if (n < 772) return Y_FF + (n - 768);
        if (n < 1028) { sc = C2_64; return Y_SQ + (n - 772); }
        if (n < 1156) return Y_SK + (n - 1028);
        if (n < 1284) return Y_SV + (n - 1156);
        if (n < 1540) return Y_CQ + (n - 1284);
        if (n < 1668) return Y_CKV + (n - 1540);
        if (n < 1700) return Y_KR + rope_perm(n - 1668);
        if (n < 1956) { sc = C2_64; return Y_DQ + (n - 1700); }
        if (n < 2212) return Y_DK + (n - 1956);
        if (n < 2468) return Y_DV + (n - 2212);
        return -1;
    }
    if (kind == 2) { sc = C2_96; const int h = n / 96, c = n % 96; return h * 96 + (c < 64 ? c : 64 + rope_perm(c - 64)); }
    if (kind == 3) return 256 * (n >> 7) + (n & 127);
    return 256 * (n >> 7) + 128 + (n & 127);
}
__device__ __forceinline__ void transpose_item(const float* W, int K, int N, bf16_t* WT, const float* gain, int kind, LAS float* scr, int item, int lane) {
    (void)scr;
    const int nblk = (N + 31) / 32, kblk = item / nblk, nb = item % nblk, kb = lane >> 3, ng = lane & 7;
    const int k0 = 64 * kblk + 8 * kb, n0 = 32 * nb + 4 * ng;
    if (n0 >= N) return;
    const float* src = W + (size_t)k0 * N + n0;
    f32x4 v[8];
#pragma unroll
    for (int e = 0; e < 8; ++e) v[e] = __builtin_nontemporal_load((const f32x4*)(src + (size_t)e * N));
    f32x4 g0 = {1.f, 1.f, 1.f, 1.f}, g1 = {1.f, 1.f, 1.f, 1.f};
    if (gain) { g0 = *(const f32x4*)(gain + k0); g1 = *(const f32x4*)(gain + k0 + 4); }
#pragma unroll
    for (int j = 0; j < 4; ++j) {
        float sc; const int dr = map_col(kind, n0 + j, sc);
        if (dr >= 0) {
            u32x4 o;
            o.x = cvtpk(v[0][j] * g0[0] * sc, v[1][j] * g0[1] * sc); o.y = cvtpk(v[2][j] * g0[2] * sc, v[3][j] * g0[3] * sc);
            o.z = cvtpk(v[4][j] * g1[0] * sc, v[5][j] * g1[1] * sc); o.w = cvtpk(v[6][j] * g1[2] * sc, v[7][j] * g1[3] * sc);
            *(u32x4*)(WT + (size_t)dr * K + k0) = o;
        }
    }
}
__device__ __forceinline__ void transpose_item8(const float* W, int K, int N, unsigned char* WT, const float* gain, int kind, int item, int lane) {
    const int nblk = (N + 31) / 32, kblk = item / nblk, nb = item % nblk, kb = lane >> 3, ng = lane & 7;
    const int k0 = 128 * kblk + 16 * kb, n0 = 32 * nb + 4 * ng;
    if (n0 >= N) return;
    const float* src = W + (size_t)k0 * N + n0;
    f32x4 v[16];
#pragma unroll
    for (int e = 0; e < 16; ++e) v[e] = __builtin_nontemporal_load((const f32x4*)(src + (size_t)e * N));
    f32x4 g[4];
#pragma unroll
    for (int i = 0; i < 4; ++i) g[i] = gain ? *(const f32x4*)(gain + k0 + 4 * i) : (f32x4){1.f, 1.f, 1.f, 1.f};
#pragma unroll
    for (int j = 0; j < 4; ++j) {
        float sc; const int dr = map_col(kind, n0 + j, sc); sc *= F8_SW;
        if (dr >= 0) {
            u32x4 o;
#pragma unroll
            for (int i = 0; i < 4; ++i) o[i] = cvt4_fp8(v[4 * i][j] * g[i][0] * sc, v[4 * i + 1][j] * g[i][1] * sc, v[4 * i + 2][j] * g[i][2] * sc, v[4 * i + 3][j] * g[i][3] * sc);
            *(u32x4*)(WT + (size_t)dr * K + k0) = o;
        }
    }
}
__device__ __forceinline__ void transpose_pair8(const float* W, int K, int N, unsigned char* WT, const float* gain, int kind, int item, int lane) {
    const int nblk = N / 32, kblk = item / nblk, nb = item % nblk, kb = lane >> 3, ng = lane & 7;
    const int k0 = 128 * kblk + 16 * kb, n0 = 32 * nb + 4 * ng;
    const float* src = W + (size_t)k0 * N + n0;
    f32x4 v[2][16];
#pragma unroll
    for (int e = 0; e < 16; ++e) { v[0][e] = __builtin_nontemporal_load((const f32x4*)(src + (size_t)e * N)); v[1][e] = __builtin_nontemporal_load((const f32x4*)(src + (size_t)e * N + 32)); }
    f32x4 g[4];
#pragma unroll
    for (int i = 0; i < 4; ++i) g[i] = gain ? *(const f32x4*)(gain + k0 + 4 * i) : (f32x4){1.f, 1.f, 1.f, 1.f};
#pragma unroll
    for (int q = 0; q < 2; ++q)
#pragma unroll
        for (int j = 0; j < 4; ++j) {
            float sc; const int dr = map_col(kind, n0 + 32 * q + j, sc); sc *= F8_SW;
            u32x4 o;
#pragma unroll
            for (int i = 0; i < 4; ++i) o[i] = cvt4_fp8(v[q][4 * i][j] * g[i][0] * sc, v[q][4 * i + 1][j] * g[i][1] * sc, v[q][4 * i + 2][j] * g[i][2] * sc, v[q][4 * i + 3][j] * g[i][3] * sc);
            *(u32x4*)(WT + (size_t)dr * K + k0) = o;
        }
}
__device__ __forceinline__ void transpose_item6(const float* W, int K, int N, unsigned char* WT6, const float* gain, int kind, int item, int lane) {
    const int nblk = N / 32, kblk = item / nblk, nb = item % nblk, kb = lane >> 3, ng = lane & 7;
    const int k0 = 256 * kblk + 32 * kb, n0 = 32 * nb + 4 * ng, pitch = K / 128 * 96;
    const float* src = W + (size_t)k0 * N + n0;
    f32x4 v[32];
#pragma unroll
    for (int e = 0; e < 32; ++e) v[e] = __builtin_nontemporal_load((const f32x4*)(src + (size_t)e * N));
    f32x4 g[8];
#pragma unroll
    for (int i = 0; i < 8; ++i) g[i] = gain ? *(const f32x4*)(gain + k0 + 4 * i) : (f32x4){1.f, 1.f, 1.f, 1.f};
#pragma unroll
    for (int j = 0; j < 4; ++j) {
        float sc; const int dr = map_col(kind, n0 + j, sc); sc *= F6_SW;
        float t[32];
#pragma unroll
        for (int e = 0; e < 32; ++e) t[e] = v[e][j] * g[e >> 2][e & 3] * sc;
        const i32x6 pk = pack32_fp6(t);
        size_t oP, oQ; fp6_tiled_offset(dr, k0 >> 5, K / 128, true, oP, oQ); (void)pitch;
        *(u32x4*)(WT6 + oP) = (u32x4){(unsigned)pk[0], (unsigned)pk[1], (unsigned)pk[2], (unsigned)pk[3]};
        *(u32x2*)(WT6 + oQ) = (u32x2){(unsigned)pk[4], (unsigned)pk[5]};
    }
}
__device__ __forceinline__ void sincos_acc(double a, float& s, float& c) {
    const double n = rint(a * 0.63661977236758134308);
    double r = fma(-n, 1.5707963267948966192, a); r = fma(-n, 6.123233995736766e-17, r);
    const int qd = (int)((long long)n & 3);
    const float x = (float)r, x2 = x * x;
    const float sp = x + x * x2 * (-1.6666667163e-1f + x2 * (8.3333337680e-3f + x2 * (-1.9841270114e-4f + x2 * 2.7557314297e-6f)));
    const float cp = 1.0f + x2 * (-0.5f + x2 * (4.1666667908e-2f + x2 * (-1.3888889225e-3f + x2 * 2.4801587642e-5f)));
    s = (qd == 0) ? sp : (qd == 1) ? cp : (qd == 2) ? -sp : -cp;
    c = (qd == 0) ? cp : (qd == 1) ? -sp : (qd == 2) ? -cp : sp;
}

constexpr int NPH = 18;
typedef __attribute__((address_space(4))) const Args* ArgsP;
__device__ __forceinline__ ArgsP get_args() { ArgsP p = (ArgsP)__builtin_amdgcn_kernarg_segment_ptr(); asm volatile("" : "+s"(p)); return p; }
#define WSP(T_, off) ((T_*)(ws + (off)))

#if MK_ONE_LAUNCH
#define GRID_BAR() do { bar.bar = (unsigned*)(get_args()->ws + WS_CTL) + CW_BAR; xcd_barrier(bar); } while (0)
#else
#define GRID_BAR() do { } while (0)
#endif
#ifndef PHMASK
#define PHMASK 0x3ffff
#endif
#define IN(k) ((((PHMASK) >> (k)) & 1) && lo <= (k) && (k) < hi)
#define SEAM(k) do { if (IN(k) && IN((k) + 1)) GRID_BAR(); } while (0)
#if PROBE_REP >= 0
#define PH_BEGIN(k) if (IN(k)) for (int rep_ = 0; rep_ < (((k) == PROBE_REP) ? 2 : 1); ++rep_) { if (rep_) GRID_BAR();
#define PH_END }
#else
#define PH_BEGIN(k) if (IN(k)) {
#define PH_END }
#endif
#ifndef P2MASK
#define P2MASK 15
#endif

template <int l>
__device__ __forceinline__ void moe_convert_unit(int cvi, int wave, int lane) {
    ArgsP a = get_args(); unsigned char* ws = a->ws;
    const int pr = cvi * 8 + wave, mat = pr / 448, item = (pr % 448) * 2;
    if (l == 0) { const int e = mat >> 1, up = mat & 1;
        if (UPM_FP6) transpose_item6((up ? a->moe_w_up : a->moe_w_gate) + (size_t)e * D * FF, D, FF, WSP(unsigned char, WS_WGU1) + (size_t)e * 2 * FF * 768, a->ffn_norm + D, up ? 4 : 3, pr % 448, lane);
        else transpose_pair8((up ? a->moe_w_up : a->moe_w_gate) + (size_t)e * D * FF, D, FF, WSP(unsigned char, WS_WGU1) + (size_t)e * 2 * FF * D, a->ffn_norm + D, up ? 4 : 3, item, lane); }
    else transpose_pair8(a->moe_w_down + (size_t)mat * FF * D, FF, D, WSP(unsigned char, WS_WD1) + (size_t)mat * D * FF, nullptr, 0, item, lane);
}
template <int l>
__device__ __forceinline__ void layer_fwd(const Frame& F0, const int lo, const int hi, XcdBarrier& bar) {
        constexpr int pb = 1 + 7 * l;
        PH_BEGIN(pb) {
            Frame F = F0; asm volatile("" : "+v"(F.tid)); F.lane = F.tid & 63; F.wave = __builtin_amdgcn_readfirstlane(F.tid >> 6);
            int cid = F.c, gsz = F.G; asm volatile("" : "+s"(cid), "+s"(gsz)); const int gw = cid * NWAVES + F.wave, NGW = gsz * NWAVES; (void)gw; (void)NGW;
            unsigned char* ws = get_args()->ws;
            constexpr bool F8 = ((G1_FP8 >> l) & 1) != 0; constexpr int KD = F8 ? D / 2 : D;
            pg8::Gemm g{F8 ? WSP(bf16_t, WS_XB8) : WSP(bf16_t, WS_XB), WSP(bf16_t, WS_WIN) + (size_t)l * NY * D, KD, KD, KD};
            pg8::SchedStatic S; S.o.init(T, NY, gsz, cid);
            typedef pg8::EpiG1<1, F8> EG1;
            EG1 E{WSP(bf16_t, WS_Y), pg8::RowTbl{WSP(float, SM_PART), (LAS float*)(F.lds + ROWTBL_OFF)}, WSP(float, SM_PARTQ), WSP(float, SM_PARTKV), WSP(float, SM_FF), WSP(bf16_t, WS_KM), WSP(float, SM_ROPE)};
            pg8::gemm_phase<EG1, pg8::SchedStatic, true, F8>(F.lds, g, S, E);
#ifndef G1_CONV
#define G1_CONV 1
#endif
            if (G1_CONV && gsz == 256 && cid >= 128) {
                LAS unsigned* qslot = (LAS unsigned*)(F.lds + LDSCTL_OFF + 64);
                for (int k = 0; k < (l == 0 ? 2 : 1); ++k) {
                    if (F.tid == 0) qslot[1] = __hip_atomic_fetch_add((gu32*)(get_args()->ws + WS_CTL) + CW_QUEUE + 64 * (4 + l), 1u, RLX_AGENT);
                    __syncthreads();
                    const int cvi = (int)qslot[1];
                    __syncthreads();
                    if (cvi < (l == 0 ? 896 : 448)) moe_convert_unit<l>(cvi, F.wave, F.lane);
                }
            }
        } PH_END
        SEAM(pb);
        PH_BEGIN(pb + 1) {
            Frame F = F0; asm volatile("" : "+v"(F.tid)); F.lane = F.tid & 63; F.wave = __builtin_amdgcn_readfirstlane(F.tid >> 6);
            int cid = F.c, gsz = F.G; asm volatile("" : "+s"(cid), "+s"(gsz)); const int gw = cid * NWAVES + F.wave, NGW = gsz * NWAVES; (void)gw; (void)NGW;
            if ((P2MASK & 1) && cid < 128) {
                unsigned char* ws = get_args()->ws;
                pg8::Gemm g{WSP(bf16_t, WS_Y) + Y_CQ, WSP(bf16_t, WS_WQUP) + (size_t)l * 512 * 256, NY, 256, 256};
                pg8::SchedOne S; S.has = true; S.un.pm = cid >> 1; S.un.pn = cid & 1; S.un.e = 0; S.un.ks = 0;
                pg8::EpiQup E{WSP(bf16_t, WS_QM), WSP(float, SM_PARTQ), WSP(float, SM_ROPE)};
                pg8::gemm_phase<pg8::EpiQup, pg8::SchedOne, false>(F.lds, g, S, E);
            } else if (P2MASK & 2) {
                unsigned char* ws = get_args()->ws;
                pg8::Gemm g{WSP(bf16_t, WS_Y) + Y_CKV, WSP(bf16_t, WS_WKVUP) + (size_t)l * 512 * 128, NY, 128, 128};
                pg8::SchedOne S; S.has = cid < 256; S.un.pm = (cid - 128) >> 1; S.un.pn = cid & 1; S.un.e = 0; S.un.ks = 0;
                pg8::EpiKVup E{WSP(bf16_t, WS_KM), WSP(bf16_t, WS_VM), WSP(float, SM_PARTKV)};
                pg8::gemm_phase<pg8::EpiKVup, pg8::SchedOne, false>(F.lds, g, S, E);
            }
            __syncthreads();
            const int lt0 = (gsz >= 256) ? 128 : 0;
            if (P2MASK & 4) for (int sq = cid - lt0; sq >= 0 && sq < 8; sq += gsz) {
                ArgsP a = get_args(); unsigned char* ws = a->ws; const float* ffb = WSP(float, SM_FF); float* csl = WSP(float, SM_CSL);
                const int b = sq >> 2, h = sq & 3; const float bfv = a->b_forget[l * 4 + h];
                LAS double* sd = (LAS double*)F.lds;
                double loc[16]; double run = 0.0;
#pragma unroll
                for (int i = 0; i < 16; ++i) { const float z = ffb[(size_t)(b * SEQ + F.tid * 16 + i) * 4 + h] + bfv;
                    const float ls = fminf(z, 0.f) - 0.6931471805599453f * __builtin_amdgcn_logf(1.0f + __builtin_amdgcn_exp2f(-fabsf(z) * LOG2E)); run += (double)ls; loc[i] = run; }
                double incl = run;
#pragma unroll
                for (int o = 1; o < 64; o <<= 1) { const double t = __shfl_up(incl, o); if (F.lane >= o) incl += t; }
                if (F.lane == 63) sd[F.wave] = incl;
                __syncthreads();
                double base = 0.0;
                for (int w = 0; w < F.wave; ++w) base += sd[w];
                const double excl = base + incl - run;
#pragma unroll
                for (int i = 0; i < 16; ++i) csl[(size_t)sq * SEQ + F.tid * 16 + i] = (float)((excl + loc[i]) * (double)LOG2E);
                __syncthreads();
            }
            if (cid >= lt0) {
                unsigned char* ws = get_args()->ws; const bf16_t* Y = WSP(bf16_t, WS_Y);
                float mq[2] = {0.f, 0.f}, mk[2] = {0.f, 0.f};
                for (int m = gw - lt0 * NWAVES; m < T; m += NGW - lt0 * NWAVES) {
                    const u32x2 qv = *(const u32x2*)(Y + (size_t)m * NY + Y_FQ + 4 * F.lane), kv = *(const u32x2*)(Y + (size_t)m * NY + Y_FK + 4 * F.lane);
                    float a0 = __uint_as_float(qv.x << 16), a1 = __uint_as_float(qv.x & 0xffff0000u), a2 = __uint_as_float(qv.y << 16), a3 = __uint_as_float(qv.y & 0xffff0000u);
                    float b0 = __uint_as_float(kv.x << 16), b1 = __uint_as_float(kv.x & 0xffff0000u), b2 = __uint_as_float(kv.y << 16), b3 = __uint_as_float(kv.y & 0xffff0000u);
                    float sq = (a0 * a0 + a1 * a1) + (a2 * a2 + a3 * a3), sk = (b0 * b0 + b1 * b1) + (b2 * b2 + b3 * b3);
#pragma unroll
                    for (int o = 1; o < 16; o <<= 1) { sq += __shfl_xor(sq, o); sk += __shfl_xor(sk, o); }
                    const int bb = m >= SEQ ? 1 : 0;
                    mq[0] = fmaxf(mq[0], bb ? 0.f : sq); mq[1] = fmaxf(mq[1], bb ? sq : 0.f); mk[0] = fmaxf(mk[0], bb ? 0.f : sk); mk[1] = fmaxf(mk[1], bb ? sk : 0.f);
                }
                LAS float* red = (LAS float*)F.lds;
                if ((F.lane & 15) == 0) { const int h = F.lane >> 4; LAS float* r = red + (F.wave * 4 + h) * 4; r[0] = mq[0]; r[1] = mk[0]; r[2] = mq[1]; r[3] = mk[1]; }
                __syncthreads();
                if (F.tid < 16) { const int h = F.tid >> 2, j = F.tid & 3; float v = 0.f;
                    for (int w = 0; w < 8; ++w) v = fmaxf(v, red[(w * 4 + h) * 4 + j]);
                    const int b = j >> 1, qk = j & 1;
                    atomicMax((unsigned*)((gu32*)(ws + WS_CTL) + CW_FMAX + ((l * 8 + b * 4 + h) * 2 + qk)), __float_as_uint(v)); }
                __syncthreads();
            }
            if (P2MASK & 8) for (int idx = cid; idx < 1024; idx += gsz) {
                ArgsP a = get_args(); unsigned char* ws = a->ws; const bf16_t* Y = WSP(bf16_t, WS_Y);
                att::AU u; u.stamp = nullptr; u.O8 = nullptr; u.o8pitch = 0;
                if (idx < 256) {
                    const int b = idx >> 7, hq = (idx >> 5) & 3, qb = idx & 31;
                    const bf16_t* yb = Y + (size_t)b * SEQ * NY;
                    u.Q = yb + Y_SQ + hq * 64; u.K = yb + Y_SK + (hq >> 1) * 64; u.V = yb + Y_SV + (hq >> 1) * 64; u.qpitch = u.kpitch = u.vpitch = NY;
                    u.O = WSP(bf16_t, WS_MIX) + (size_t)b * SEQ * D + 256 + hq * 64; u.opitch = D; u.lse = nullptr; u.lpitch = 0; u.colb = nullptr;
                    if (P4_FP8) { u.O8 = WSP(unsigned char, WS_MIX) + (size_t)b * SEQ * D + 256 + hq * 64; u.o8pitch = D; }
                    u.q0 = qb * 256; u.span = 127; u.alibi = exp2f(-(float)(hq + 1)) * LOG2E; u.sink2 = a->sinks[l * 4 + hq] * LOG2E;
                } else {
                    const int p = (idx - 256) >> 8, rem = (idx - 256) & 255, b = rem >> 7, h = (rem >> 5) & 3, j = rem & 31;
                    const int dil = (p == 0) ? 1 : (p == 1) ? 4 : 16, nqb = (SEQ / dil) / 256, r = j / nqb, qb = j % nqb;
                    const bf16_t* yb = Y + (size_t)(b * SEQ + r) * NY;
                    u.Q = yb + Y_DQ + h * 64; u.K = yb + Y_DK + h * 64; u.V = yb + Y_DV + h * 64; u.qpitch = u.kpitch = u.vpitch = dil * NY;
                    u.O = WSP(bf16_t, WS_DP) + (size_t)p * T * 256 + (size_t)(b * SEQ + r) * 256 + h * 64; u.opitch = dil * 256;
                    u.lse = WSP(float, WS_DL) + (size_t)p * T * 4 + (size_t)(b * SEQ + r) * 4 + h; u.lpitch = dil * 4; u.colb = nullptr;
                    u.q0 = qb * 256; u.span = 128; u.alibi = exp2f(-(float)(h + 5)) * (float)dil * LOG2E; u.sink2 = -INFINITY;
                }
                u.kt0 = u.q0 / 64 - 2; if (u.kt0 < 0) u.kt0 = 0; u.kt1 = u.q0 / 64 + 4;
                att::attn_unit<4, 2, 6>(u, F.lds);
            }
        } PH_END
        SEAM(pb + 1);
        PH_BEGIN(pb + 2) {
            Frame F = F0; asm volatile("" : "+v"(F.tid)); F.lane = F.tid & 63; F.wave = __builtin_amdgcn_readfirstlane(F.tid >> 6);
            int cid = F.c, gsz = F.G; asm volatile("" : "+s"(cid), "+s"(gsz)); const int gw = cid * NWAVES + F.wave, NGW = gsz * NWAVES; (void)gw; (void)NGW;
            LAS unsigned* qslot = (LAS unsigned*)(F.lds + LDSCTL_OFF + 64);
            for (;;) {
                unsigned char* ws = get_args()->ws;
#if PROBE_REP >= 0
                const int qrep = rep_;
#else
                const int qrep = 0;
#endif
                if (F.tid == 0) { qslot[0] = __hip_atomic_fetch_add((gu32*)(ws + WS_CTL) + CW_QUEUE + 64 * (l + 2 * qrep), 1u, RLX_AGENT);
                                  qslot[1] = __hip_atomic_fetch_add((gu32*)(ws + WS_CTL) + CW_QUEUE + 64 * (4 + l + 2 * qrep), 1u, RLX_AGENT); }
                __syncthreads();
                const int idx = (int)qslot[0], cvi = (int)qslot[1];
                __syncthreads();
                if (cvi < (l == 0 ? 896 : 448)) moe_convert_unit<l>(cvi, F.wave, F.lane);
                if (idx >= 896) { if (cvi < (l == 0 ? 896 : 448)) continue; break; }
                att::AU u; u.O8 = nullptr; u.o8pitch = 0; u.span = 1 << 30; u.alibi = 0.f; u.sink2 = -INFINITY; u.xthr = 0.f; u.stamp = (cid == 0) ? (unsigned long long*)(ws + WS_CTL + 512 * 1024) : nullptr;
                if (idx < 512 || idx >= 768) {
                    int bh, qb, c;
                    if (idx < 192) { bh = idx & 7; const int r = idx >> 3; c = r % 3; qb = 24 + r / 3; }
                    else if (idx < 320) { const int n = idx - 192; bh = n & 7; const int r = n >> 3; c = r & 1; qb = 16 + (r >> 1); }
                    else if (idx < 384) { const int n = idx - 320; bh = n & 7; qb = 8 + (n >> 3); c = 0; }
                    else { const int n = (idx < 512) ? idx - 384 : idx - 640, sz = n >> 5, m = n & 31; bh = m & 7; c = m >> 3; qb = 8 * c + (7 - sz); }
                    const int b = bh >> 2, h = bh & 3;
                    u.q0 = qb * 256; u.kt0 = 32 * c; u.kt1 = 4 * qb + 4 < 32 * c + 32 ? 4 * qb + 4 : 32 * c + 32;
                    u.Q = WSP(bf16_t, WS_QM) + (size_t)b * SEQ * 384 + h * 96; u.K = WSP(bf16_t, WS_KM) + (size_t)b * SEQ * 384 + h * 96; u.V = WSP(bf16_t, WS_VM) + (size_t)b * SEQ * 256 + h * 64;
                    u.qpitch = 384; u.kpitch = 384; u.vpitch = 256; u.colb = nullptr;
                    u.O = WSP(bf16_t, WS_MP) + (size_t)c * T * 256 + (size_t)b * SEQ * 256 + h * 64; u.opitch = 256;
                    u.lse = WSP(float, WS_ML) + (size_t)c * T * 4 + (size_t)b * SEQ * 4 + h; u.lpitch = 4;
                    att::attn_unit<6, 0, 6>(u, F.lds);
                } else {
                    const int n = idx - 512, qb = 31 - (n >> 3), bh = n & 7, b = bh >> 2, h = bh & 3;
                    const bf16_t* yb = WSP(bf16_t, WS_Y) + (size_t)b * SEQ * NY;
                    u.lse = nullptr; u.lpitch = 0; u.q0 = qb * 256; u.kt0 = 0; u.kt1 = 4 * qb + 4; u.opitch = D;
                    u.Q = yb + Y_FQ + h * 64; u.K = yb + Y_FK + h * 64; u.V = yb + Y_FV + h * 64; u.qpitch = u.kpitch = u.vpitch = NY;
                    u.O = WSP(bf16_t, WS_MIX) + (size_t)b * SEQ * D + h * 64; u.colb = WSP(float, SM_CSL) + (size_t)bh * SEQ;
                    if (P4_FP8) { u.O8 = WSP(unsigned char, WS_MIX) + (size_t)b * SEQ * D + h * 64; u.o8pitch = D; }
                    const gu32* fm = (const gu32*)(ws + WS_CTL) + CW_FMAX + (l * 8 + bh) * 2;
                    u.xthr = FOX_THRESH + 2.0f * sqrtf(__uint_as_float(fm[0]) * __uint_as_float(fm[1])) * 1.0001f + 1.0f;
                    att::attn_unit<4, 1, 5>(u, F.lds);
                }
            }
        } PH_END
        SEAM(pb + 2);
        PH_BEGIN(pb + 3) {
            Frame F = F0; asm volatile("" : "+v"(F.tid)); F.lane = F.tid & 63; F.wave = __builtin_amdgcn_readfirstlane(F.tid >> 6);
            int cid = F.c, gsz = F.G; asm volatile("" : "+s"(cid), "+s"(gsz)); const int gw = cid * NWAVES + F.wave, NGW = gsz * NWAVES; (void)gw; (void)NGW;
            unsigned char* ws = get_args()->ws;
            const bf16_t* Dp = WSP(bf16_t, WS_DP); const float* Dl = WSP(float, WS_DL); const bf16_t* Mp = WSP(bf16_t, WS_MP); const float* Ml = WSP(float, WS_ML); bf16_t* MIX = WSP(bf16_t, WS_MIX);
            for (int blk = cid; blk < T / 64; blk += gsz) {
                const int t = blk * 64 + (F.tid >> 3), dc = F.tid & 7;
                const int np = (((t & (SEQ - 1)) >> 8) >> 3) + 1;
                f32x4 dl[3], ml[4];
#pragma unroll
                for (int p = 0; p < 3; ++p) dl[p] = *(const f32x4*)(Dl + (size_t)(p * T + t) * 4);
#pragma unroll
                for (int p = 0; p < 4; ++p) ml[p] = (p < np) ? *(const f32x4*)(Ml + (size_t)(p * T + t) * 4) : (f32x4){-INFINITY, -INFINITY, -INFINITY, -INFINITY};
#pragma unroll
                for (int h = 0; h < 4; ++h) {
                    u32x4 dv[3], mv[4];
#pragma unroll
                    for (int p = 0; p < 3; ++p) dv[p] = *(const u32x4*)(Dp + (size_t)(p * T + t) * 256 + h * 64 + dc * 8);
#pragma unroll
                    for (int p = 0; p < 4; ++p) mv[p] = (p < np) ? *(const u32x4*)(Mp + (size_t)(p * T + t) * 256 + h * 64 + dc * 8) : (u32x4){0u, 0u, 0u, 0u};
                    {
                        const float mx = fmaxf(dl[0][h], fmaxf(dl[1][h], dl[2][h]));
                        float w0 = __builtin_amdgcn_exp2f(dl[0][h] - mx), w1 = __builtin_amdgcn_exp2f(dl[1][h] - mx), w2 = __builtin_amdgcn_exp2f(dl[2][h] - mx);
                        const float inv = __builtin_amdgcn_rcpf(w0 + w1 + w2); w0 *= inv; w1 *= inv; w2 *= inv;
                        u32x4 o;
#pragma unroll
                        for (int e = 0; e < 4; ++e) {
                            const float lo_ = w0 * __uint_as_float(dv[0][e] << 16) + w1 * __uint_as_float(dv[1][e] << 16) + w2 * __uint_as_float(dv[2][e] << 16);
                            const float hi_ = w0 * __uint_as_float(dv[0][e] & 0xffff0000u) + w1 * __uint_as_float(dv[1][e] & 0xffff0000u) + w2 * __uint_as_float(dv[2][e] & 0xffff0000u);
                            o[e] = cvtpk(lo_, hi_);
                        }
                        if (P4_FP8) { float f[8];
#pragma unroll
                            for (int e = 0; e < 4; ++e) { f[2 * e] = __uint_as_float(o[e] << 16) * F8_SM; f[2 * e + 1] = __uint_as_float(o[e] & 0xffff0000u) * F8_SM; }
                            u32x2 w8; w8.x = cvt4_fp8(f[0], f[1], f[2], f[3]); w8.y = cvt4_fp8(f[4], f[5], f[6], f[7]);
                            *(u32x2*)((unsigned char*)MIX + (size_t)t * D + 768 + h * 64 + dc * 8) = w8; }
                        else *(u32x4*)(MIX + (size_t)t * D + 768 + h * 64 + dc * 8) = o;
                    }
                    {
                        const float mx = fmaxf(fmaxf(ml[0][h], ml[1][h]), fmaxf(ml[2][h], ml[3][h]));
                        float w[4]; float sw = 0.f;
#pragma unroll
                        for (int p = 0; p < 4; ++p) { w[p] = __builtin_amdgcn_exp2f(ml[p][h] - mx); sw += w[p]; }
                        const float inv = __builtin_amdgcn_rcpf(sw);
                        float acc[8] = {0.f, 0.f, 0.f, 0.f, 0.f, 0.f, 0.f, 0.f};
#pragma unroll
                        for (int p = 0; p < 4; ++p) { const float wp = w[p] * inv;
#pragma unroll
                            for (int e = 0; e < 4; ++e) { acc[2 * e] += wp * __uint_as_float(mv[p][e] << 16); acc[2 * e + 1] += wp * __uint_as_float(mv[p][e] & 0xffff0000u); } }
                        if (P4_FP8) { u32x2 w8; w8.x = cvt4_fp8(acc[0] * F8_SM, acc[1] * F8_SM, acc[2] * F8_SM, acc[3] * F8_SM); w8.y = cvt4_fp8(acc[4] * F8_SM, acc[5] * F8_SM, acc[6] * F8_SM, acc[7] * F8_SM);
                            *(u32x2*)((unsigned char*)MIX + (size_t)t * D + 512 + h * 64 + dc * 8) = w8; }
                        else { u32x4 o; o.x = cvtpk(acc[0], acc[1]); o.y = cvtpk(acc[2], acc[3]); o.z = cvtpk(acc[4], acc[5]); o.w = cvtpk(acc[6], acc[7]);
                            *(u32x4*)(MIX + (size_t)t * D + 512 + h * 64 + dc * 8) = o; }
                    }
                }
            }
        } PH_END
        SEAM(pb + 3);
        PH_BEGIN(pb + 4) {
            Frame F = F0; asm volatile("" : "+v"(F.tid)); F.lane = F.tid & 63; F.wave = __builtin_amdgcn_readfirstlane(F.tid >> 6);
            int cid = F.c, gsz = F.G; asm volatile("" : "+s"(cid), "+s"(gsz)); const int gw = cid * NWAVES + F.wave, NGW = gsz * NWAVES; (void)gw; (void)NGW;
            ArgsP a = get_args(); unsigned char* ws = a->ws;
            constexpr int KD = P4_FP8 ? D / 2 : D;
            pg8::Gemm g{WSP(bf16_t, WS_MIX), WSP(bf16_t, WS_WOUT) + (size_t)l * D * D, KD, KD, KD};
            pg8::SchedStatic S; S.o.init(T, D, gsz, cid);
            typedef pg8::EpiRes<true> ER;
            ER E{(const void*)WSP(bf16_t, WS_XB), l == 0 ? WSP(bf16_t, WS_XB) : WSP(bf16_t, WS_XR), WSP(float, SM_PART), nullptr, P4_FP8 ? 1.0f / (F8_SM * F8_SW) : 1.0f};
            pg8::gemm_phase<ER, pg8::SchedStatic, true, P4_FP8 != 0>(F.lds, g, S, E);
        } PH_END
        SEAM(pb + 4);
        if (l == 0) {
            PH_BEGIN(6) {
            Frame F = F0; asm volatile("" : "+v"(F.tid)); F.lane = F.tid & 63; F.wave = __builtin_amdgcn_readfirstlane(F.tid >> 6);
            int cid = F.c, gsz = F.G; asm volatile("" : "+s"(cid), "+s"(gsz)); const int gw = cid * NWAVES + F.wave, NGW = gsz * NWAVES; (void)gw; (void)NGW;
                unsigned char* ws = get_args()->ws;
                pg8::Gemm g{WSP(bf16_t, WS_XB), WSP(bf16_t, WS_WGU0), D, D, D};
                pg8::SchedStatic S; S.o.init(T, 2 * FF, gsz, cid);
                typedef pg8::EpiSwigluT<1, 0, false> ES;
                ES E{WSP(void, WS_HID), pg8::RowTbl{WSP(float, SM_PART), (LAS float*)(F.lds + ROWTBL_OFF)}};
                pg8::gemm_phase<ES, pg8::SchedStatic, true>(F.lds, g, S, E);
            } PH_END
            SEAM(6);
            PH_BEGIN(7) {
            Frame F = F0; asm volatile("" : "+v"(F.tid)); F.lane = F.tid & 63; F.wave = __builtin_amdgcn_readfirstlane(F.tid >> 6);
            int cid = F.c, gsz = F.G; asm volatile("" : "+s"(cid), "+s"(gsz)); const int gw = cid * NWAVES + F.wave, NGW = gsz * NWAVES; (void)gw; (void)NGW;
                ArgsP a = get_args(); unsigned char* ws = a->ws;
                pg8::Gemm g{WSP(bf16_t, WS_HID), WSP(bf16_t, WS_WD0), FF, FF, FF};
                pg8::SchedStatic S; S.o.init(T, D, gsz, cid);
                pg8::EpiRes<true> E{WSP(bf16_t, WS_XB), WSP(bf16_t, WS_XB), WSP(float, SM_PART), (G1_FP8 & 2) ? WSP(unsigned char, WS_XB8) : nullptr, 1.0f};
                pg8::gemm_phase<pg8::EpiRes<true>, pg8::SchedStatic, true>(F.lds, g, S, E);
            } PH_END
            SEAM(7);
        }
}

__global__ void __launch_bounds__(NWAVES * 64, 2) mega_fwd(Args a_unused) {
    extern __shared__ __attribute__((aligned(16))) unsigned char lds_raw[];
    Frame F0;
    F0.lds = (LAS unsigned char*)lds_raw;
    F0.tid = threadIdx.x; F0.lane = F0.tid & 63; F0.wave = __builtin_amdgcn_readfirstlane(F0.tid >> 6);
    F0.G = gridDim.x; F0.c = blockIdx.x;
    volatile LAS unsigned* MISC = (volatile LAS unsigned*)(F0.lds + MISC_OFF);
    for (int u = F0.tid; u < (LDS_BYTES - LDSCTL_OFF) / 4; u += NWAVES * 64) ((LAS unsigned*)(F0.lds + LDSCTL_OFF))[u] = 0u;
    __syncthreads();
#if MK_ONE_LAUNCH
    XcdBarrier bar = xcd_barrier_post((unsigned*)(get_args()->ws + WS_CTL) + CW_BAR, MISC + 8);
#else
    XcdBarrier bar; bar.bar = nullptr; bar.x = 0; bar.st = MISC + 8;
#endif
    const int lo = get_args()->ph_lo, hi = get_args()->ph_hi;

    PH_BEGIN(0) {
            Frame F = F0; asm volatile("" : "+v"(F.tid)); F.lane = F.tid & 63; F.wave = __builtin_amdgcn_readfirstlane(F.tid >> 6);
            int cid = F.c, gsz = F.G; asm volatile("" : "+s"(cid), "+s"(gsz)); const int gw = cid * NWAVES + F.wave, NGW = gsz * NWAVES; (void)gw; (void)NGW;
        ArgsP a = get_args(); unsigned char* ws = a->ws;
        LAS float* scr = (LAS float*)(F.lds + F.wave * 16384);
        bf16_t* Win_t = WSP(bf16_t, WS_WIN); bf16_t* Wqup_t = WSP(bf16_t, WS_WQUP); bf16_t* Wkvup_t = WSP(bf16_t, WS_WKVUP); bf16_t* Wout_t = WSP(bf16_t, WS_WOUT);
        bf16_t* Wgu0_t = WSP(bf16_t, WS_WGU0); bf16_t* Wd0_t = WSP(bf16_t, WS_WD0);
        constexpr int I_IN = 16 * 78, I_QU = 4 * 12, I_KV = 2 * 16, I_WO = 16 * 32, I_GU = 16 * 112, I_DN = 56 * 32;
        constexpr int I_IN8 = 8 * 78, I_WO8 = 8 * 32;
        constexpr int NIT = ((G1_FP8 & 1) ? I_IN8 : I_IN) + ((G1_FP8 & 2) ? I_IN8 : I_IN) + 2 * I_QU + 2 * I_KV + 2 * (P4_FP8 ? I_WO8 : I_WO) + 2 * I_GU + I_DN;
        for (int it = gw; it < NIT; it += NGW) {
            int r = it;
            bool done = false;
#pragma unroll
            for (int l = 0; l < 2; ++l) if (!done) {
                if ((G1_FP8 >> l) & 1) { if (r < I_IN8) { transpose_item8(a->w_in + (size_t)l * D * NIN, D, NIN, (unsigned char*)(Win_t + (size_t)l * NY * D), a->attn_norm + l * D, 1, r, F.lane); done = true; } else r -= I_IN8; }
                else { if (r < I_IN) { transpose_item(a->w_in + (size_t)l * D * NIN, D, NIN, Win_t + (size_t)l * NY * D, a->attn_norm + l * D, 1, scr, r, F.lane); done = true; } else r -= I_IN; }
            }
            if (done) continue;
            if (r < 2 * I_QU) { const int l = r / I_QU; transpose_item(a->w_q_up + (size_t)l * 256 * 384, 256, 384, Wqup_t + (size_t)l * 512 * 256, a->mla_q_norm + l * 256, 2, scr, r % I_QU, F.lane); continue; } r -= 2 * I_QU;
            if (r < 2 * I_KV) { const int l = r / I_KV; transpose_item(a->w_kv_up + (size_t)l * 128 * 512, 128, 512, Wkvup_t + (size_t)l * 512 * 128, a->mla_kv_norm + l * 128, 0, scr, r % I_KV, F.lane); continue; } r -= 2 * I_KV;
            if (P4_FP8) { if (r < 2 * I_WO8) { const int l = r / I_WO8; transpose_item8(a->w_out + (size_t)l * D * D, D, D, (unsigned char*)(Wout_t + (size_t)l * D * D), nullptr, 0, r % I_WO8, F.lane); continue; } r -= 2 * I_WO8; }
            else { if (r < 2 * I_WO) { const int l = r / I_WO; transpose_item(a->w_out + (size_t)l * D * D, D, D, Wout_t + (size_t)l * D * D, nullptr, 0, scr, r % I_WO, F.lane); continue; } r -= 2 * I_WO; }
            if (r < I_GU) { transpose_item(a->dense_w_gate, D, FF, Wgu0_t, a->ffn_norm, 3, scr, r, F.lane); continue; } r -= I_GU;
            if (r < I_GU) { transpose_item(a->dense_w_up, D, FF, Wgu0_t, a->ffn_norm, 4, scr, r, F.lane); continue; } r -= I_GU;
            if (r < I_DN) { transpose_item(a->dense_w_down, FF, D, Wd0_t, nullptr, 0, scr, r, F.lane); continue; } r -= I_DN;
        }
        const float* x = a->x; const int* pos = a->pos; bf16_t* XB = WSP(bf16_t, WS_XB); float* part0 = WSP(float, SM_PART); float* rope = WSP(float, SM_ROPE);
        const float invf = powf(10000.0f, -(float)(F.lane & 15) / 16.0f);
        constexpr int NBR = 4;
        for (int m0 = gw; m0 < T; m0 += NBR * NGW) {
            f32x4 v[NBR][4]; int mm[NBR], pp[NBR];
#pragma unroll
            for (int k = 0; k < NBR; ++k) { mm[k] = (m0 + k * NGW < T) ? m0 + k * NGW : m0;
                const f32x4* xr = (const f32x4*)(x + (size_t)mm[k] * D) + F.lane;
#pragma unroll
                for (int j = 0; j < 4; ++j) v[k][j] = xr[64 * j];
                pp[k] = pos[mm[k]]; }
#pragma unroll
            for (int k = 0; k < NBR; ++k) if (m0 + k * NGW < T) {
                const int m = mm[k];
                float s = 0.f;
                u32x2* o8 = (u32x2*)(XB + (size_t)m * D) + F.lane;
#pragma unroll
                for (int j = 0; j < 4; ++j) { s += (v[k][j][0] * v[k][j][0] + v[k][j][1] * v[k][j][1]) + (v[k][j][2] * v[k][j][2] + v[k][j][3] * v[k][j][3]);
                    u32x2 w; w.x = cvtpk(v[k][j][0], v[k][j][1]); w.y = cvtpk(v[k][j][2], v[k][j][3]); o8[64 * j] = w; }
                s = wave_sum(s);
                if (F.lane < 16) part0[(size_t)m * 16 + F.lane] = (F.lane == 0) ? s : 0.f;
                if (F.lane < 16) {
                    const float ang = (float)pp[k] * invf;
                    float sn, cs; sincos_acc((double)ang, sn, cs);
                    *(f32x2*)(rope + (size_t)m * 32 + 2 * F.lane) = (f32x2){cs, sn};
                }
            }
        }
    } PH_END
    SEAM(0);

    layer_fwd<0>(F0, lo, hi, bar);
    layer_fwd<1>(F0, lo, hi, bar);
    PH_BEGIN(13) {
            Frame F = F0; asm volatile("" : "+v"(F.tid)); F.lane = F.tid & 63; F.wave = __builtin_amdgcn_readfirstlane(F.tid >> 6);
            int cid = F.c, gsz = F.G; asm volatile("" : "+s"(cid), "+s"(gsz)); const int gw = cid * NWAVES + F.wave, NGW = gsz * NWAVES; (void)gw; (void)NGW;
        ArgsP a = get_args(); unsigned char* ws = a->ws; const bf16_t* xres = WSP(bf16_t, WS_XR);
        int* tok_e = WSP(int, SM_TOKE); float* tok_g = WSP(float, SM_TOKG); float* rstd_tok = WSP(float, SM_RSTDT); int* histg = WSP(int, SM_HIST);
        LAS float* Rg = (LAS float*)F.lds;
        LAS int* hist = (LAS int*)(F.lds + 40960);
        for (int i = F.tid; i < D * 8; i += 512) { const int k = i >> 3; Rg[k * 8 + (k >> 2) * 4 + (i & 7)] = a->router[i] * a->ffn_norm[D + k]; }
        for (int ch = cid; ch < 256; ch += gsz) {
            if (F.tid < 8) hist[F.tid] = 0;
            __syncthreads();
            {
                const int j = F.lane >> 3, g = F.lane & 7, t = ch * 64 + F.wave * 8 + j;
                const u32x2* xr = (const u32x2*)(xres + (size_t)t * D) + g;
                float acc[8] = {0.f, 0.f, 0.f, 0.f, 0.f, 0.f, 0.f, 0.f}; float ss = 0.f;
                u32x2 xw[32];
#pragma unroll
                for (int i = 0; i < 32; ++i) xw[i] = xr[8 * i];
#pragma unroll
                for (int ib = 0; ib < 32; ib += 8) {
                    f32x4 v[8];
#pragma unroll
                    for (int ii = 0; ii < 8; ++ii) { const u32x2 w = xw[ib + ii];
                        v[ii] = (f32x4){__uint_as_float(w.x << 16), __uint_as_float(w.x & 0xffff0000u), __uint_as_float(w.y << 16), __uint_as_float(w.y & 0xffff0000u)}; }
#pragma unroll
                    for (int ii = 0; ii < 8; ++ii)
#pragma unroll
                        for (int e4 = 0; e4 < 4; ++e4) { const int k = 4 * g + 32 * (ib + ii) + e4; const float xv = v[ii][e4]; ss += xv * xv;
                            const LAS float* rp = Rg + k * 8 + (k >> 2) * 4;
                            const f32x4 r0 = *(const LAS f32x4*)rp, r1 = *(const LAS f32x4*)(rp + 4);
#pragma unroll
                            for (int e = 0; e < 4; ++e) { acc[e] += xv * r0[e]; acc[4 + e] += xv * r1[e]; } }
                }
#pragma unroll
                for (int o = 1; o < 8; o <<= 1) { ss += __shfl_xor(ss, o);
#pragma unroll
                    for (int e = 0; e < 8; ++e) acc[e] += __shfl_xor(acc[e], o); }
                const float rs = __builtin_amdgcn_rsqf(ss * (1.0f / D) + EPS);
                float v1 = -INFINITY; int e1 = 0;
#pragma unroll
                for (int e = 0; e < 8; ++e) { const float lg = acc[e] * rs; if (lg > v1) { v1 = lg; e1 = e; } }
                float v2 = -INFINITY; int e2 = 0;
#pragma unroll
                for (int e = 0; e < 8; ++e) { const float lg = acc[e] * rs; if (e != e1 && lg > v2) { v2 = lg; e2 = e; } }
                const float g1 = 1.0f / (1.0f + expf(v2 - v1));
                if (g == 0) { tok_e[2 * t] = e1; tok_e[2 * t + 1] = e2; tok_g[2 * t] = g1; tok_g[2 * t + 1] = 1.0f - g1; rstd_tok[t] = rs;
                    atomicAdd((int*)&hist[e1], 1); atomicAdd((int*)&hist[e2], 1); }
            }
            __syncthreads();
            if (F.tid < 8) histg[ch * 8 + F.tid] = hist[F.tid];
            __syncthreads();
        }
    } PH_END
    SEAM(13);
    PH_BEGIN(14) {
            Frame F = F0; asm volatile("" : "+v"(F.tid)); F.lane = F.tid & 63; F.wave = __builtin_amdgcn_readfirstlane(F.tid >> 6);
            int cid = F.c, gsz = F.G; asm volatile("" : "+s"(cid), "+s"(gsz)); const int gw = cid * NWAVES + F.wave, NGW = gsz * NWAVES; (void)gw; (void)NGW;
        ArgsP a = get_args(); unsigned char* ws = a->ws; const bf16_t* xres = WSP(bf16_t, WS_XR);
        const int* tok_e = WSP(int, SM_TOKE); const float* rstd_tok = WSP(float, SM_RSTDT); const int* histg = WSP(int, SM_HIST);
        int* slot = WSP(int, SM_SLOT); float* rstdg = WSP(float, SM_RSTDG); int* moetab = WSP(int, SM_MOETAB); unsigned char* XG = WSP(unsigned char, WS_XG);
        LAS int* tot = (LAS int*)F.lds; LAS int* pre = tot + 8; LAS int* rows = tot + 16;
        for (int ch = cid; ch < 256; ch += gsz) {
            if (F.tid < 16) tot[F.tid] = 0;
            u32x2 xv[8][4]; float rsv[8]; u32x4 xv6[4][4]; float rs6[4];
            if (UPM_FP6) {
#pragma unroll
                for (int j = 0; j < 4; ++j) { const int t = ch * 64 + F.wave * 8 + 2 * j + (F.lane >> 5); const u32x4* xr = (const u32x4*)(xres + (size_t)t * D + (F.lane & 31) * 32);
#pragma unroll
                    for (int c = 0; c < 4; ++c) xv6[j][c] = xr[c];
                    rs6[j] = rstd_tok[t] * F6_SX; }
            } else {
#pragma unroll
            for (int j = 0; j < 8; ++j) { const int t = ch * 64 + F.wave * 8 + j; const u32x2* xr = (const u32x2*)(xres + (size_t)t * D) + F.lane;
#pragma unroll
                for (int jj = 0; jj < 4; ++jj) xv[j][jj] = xr[64 * jj];
                rsv[j] = rstd_tok[t] * F8_SX; }
            }
            __syncthreads();
            { const int cch = F.tid >> 1, e0 = (F.tid & 1) * 4;
#pragma unroll
              for (int e = 0; e < 4; ++e) { const int v = histg[cch * 8 + e0 + e]; atomicAdd((int*)&tot[e0 + e], v); if (cch < ch) atomicAdd((int*)&pre[e0 + e], v); } }
            __syncthreads();
            int tbase[9]; tbase[0] = 0;
#pragma unroll
            for (int e = 0; e < 8; ++e) tbase[e + 1] = tbase[e] + (tot[e] + 255) / 256;
            if (ch == 0 && F.tid == 0) {
#pragma unroll
                for (int e = 0; e < 9; ++e) moetab[e] = tbase[e];
            }
            if (F.wave == 0) {
                const int t = ch * 64 + F.lane; const int e1 = tok_e[2 * t], e2 = tok_e[2 * t + 1];
                int r1 = 0, r2 = 0;
#pragma unroll
                for (int e = 0; e < 8; ++e) {
                    const unsigned long long mk = __ballot(e1 == e || e2 == e);
                    const int rank = __popcll(mk & ((1ull << F.lane) - 1ull));
                    const int row = tbase[e] * 256 + pre[e] + rank;
                    if (e1 == e) r1 = row; if (e2 == e) r2 = row;
                }
                slot[2 * t] = r1; slot[2 * t + 1] = r2; rows[2 * F.lane] = r1; rows[2 * F.lane + 1] = r2;
            }
            __syncthreads();
            if (UPM_FP6) {
#pragma unroll
                for (int j = 0; j < 4; ++j) {
                    const int tl = F.wave * 8 + 2 * j + (F.lane >> 5); const int r1 = rows[2 * tl], r2 = rows[2 * tl + 1];
                    const float rsx = rs6[j];
                    float t[32];
#pragma unroll
                    for (int c = 0; c < 4; ++c) { const u32x4 p = xv6[j][c];
#pragma unroll
                        for (int e = 0; e < 4; ++e) { t[8 * c + 2 * e] = __uint_as_float(p[e] << 16) * rsx; t[8 * c + 2 * e + 1] = __uint_as_float(p[e] & 0xffff0000u) * rsx; } }
                    const i32x6 pk = pack32_fp6(t);
                    const int blk = F.lane & 31;
                    size_t p1, q1, p2, q2; fp6_tiled_offset(r1, blk, 8, false, p1, q1); fp6_tiled_offset(r2, blk, 8, false, p2, q2);
                    const u32x4 w0 = {(unsigned)pk[0], (unsigned)pk[1], (unsigned)pk[2], (unsigned)pk[3]}; const u32x2 w1 = {(unsigned)pk[4], (unsigned)pk[5]};
                    *(u32x4*)(XG + p1) = w0; *(u32x2*)(XG + q1) = w1; *(u32x4*)(XG + p2) = w0; *(u32x2*)(XG + q2) = w1;
                }
            } else {
#pragma unroll
            for (int j = 0; j < 8; ++j) {
                const int tl = F.wave * 8 + j; const int r1 = rows[2 * tl], r2 = rows[2 * tl + 1];
                unsigned* o1 = (unsigned*)(XG + (size_t)r1 * D) + F.lane; unsigned* o2 = (unsigned*)(XG + (size_t)r2 * D) + F.lane;
                const float rsx = rsv[j];
#pragma unroll
                for (int jj = 0; jj < 4; ++jj) { const u32x2 p = xv[j][jj];
                    const unsigned w = cvt4_fp8(__uint_as_float(p.x << 16) * rsx, __uint_as_float(p.x & 0xffff0000u) * rsx, __uint_as_float(p.y << 16) * rsx, __uint_as_float(p.y & 0xffff0000u) * rsx); o1[64 * jj] = w; o2[64 * jj] = w; }
            }
            }
            __syncthreads();
        }
    } PH_END
    SEAM(14);
    PH_BEGIN(15) {
            Frame F = F0; asm volatile("" : "+v"(F.tid)); F.lane = F.tid & 63; F.wave = __builtin_amdgcn_readfirstlane(F.tid >> 6);
            int cid = F.c, gsz = F.G; asm volatile("" : "+s"(cid), "+s"(gsz)); const int gw = cid * NWAVES + F.wave, NGW = gsz * NWAVES; (void)gw; (void)NGW;
        unsigned char* ws = get_args()->ws; const int* moetab = WSP(int, SM_MOETAB);
        constexpr int RB = UPM_FP6 ? 768 : D;
        pg8::Gemm g{WSP(bf16_t, WS_XG), WSP(bf16_t, WS_WGU1), RB / 2, RB / 2, RB / 2};
        pg8::SchedMoe S;
#pragma unroll
        for (int e = 0; e < 9; ++e) S.tb[e] = __builtin_amdgcn_readfirstlane(moetab[e]);
        S.o.init(S.tb[8] * 256, 2 * FF, gsz, cid); S.estride = (size_t)2 * FF * RB;
        typedef pg8::EpiSwigluT<0, UPM_FP6 ? 2 : 1, true> ES;
        ES E{WSP(void, WS_HG), pg8::RowTbl{nullptr, nullptr}};
        if constexpr (UPM_FP6) pg8::gemm_phase6<ES, pg8::SchedMoe, true>(F.lds, g, S, E);
        else pg8::gemm_phase<ES, pg8::SchedMoe, true, true>(F.lds, g, S, E);
    } PH_END
    SEAM(15);
    PH_BEGIN(16) {
            Frame F = F0; asm volatile("" : "+v"(F.tid)); F.lane = F.tid & 63; F.wave = __builtin_amdgcn_readfirstlane(F.tid >> 6);
            int cid = F.c, gsz = F.G; asm volatile("" : "+s"(cid), "+s"(gsz)); const int gw = cid * NWAVES + F.wave, NGW = gsz * NWAVES; (void)gw; (void)NGW;
        unsigned char* ws = get_args()->ws; const int* moetab = WSP(int, SM_MOETAB);
        pg8::Gemm g{WSP(bf16_t, WS_HG), WSP(bf16_t, WS_WD1), FF / 2, FF / 2, FF / 2};
        pg8::SchedMoe S;
#pragma unroll
        for (int e = 0; e < 9; ++e) S.tb[e] = __builtin_amdgcn_readfirstlane(moetab[e]);
        const int nT = S.tb[8], nTa = nT < 128 ? nT : 128;
        S.o.init(nTa * 256, D, gsz, cid); S.estride = (size_t)D * FF;
        pg8::EpiY E{WSP(bf16_t, WS_XG)};
        pg8::gemm_phase<pg8::EpiY, pg8::SchedMoe, true, true>(F.lds, g, S, E);
        if (nT > 128) {
            pg8::Gemm g2{WSP(bf16_t, WS_HG), WSP(bf16_t, WS_WD1), FF / 2, FF / 2, 256};
            pg8::SchedMoeSplit S2;
#pragma unroll
            for (int e = 0; e < 9; ++e) S2.tb[e] = S.tb[e];
            S2.estride = (size_t)D * FF; S2.G = gsz; S2.c = cid; S2.n0 = 128; S2.nUnits = (nT - 128) * 4 * pg8::SchedMoeSplit::KS; S2.ksl = 256;
            pg8::EpiYs E2{WSP(bf16_t, WS_YP), 128, YP_ROWS};
            pg8::gemm_phase<pg8::EpiYs, pg8::SchedMoeSplit, true, true>(F.lds, g2, S2, E2);
        }
    } PH_END
    SEAM(16);
    PH_BEGIN(17) {
            Frame F = F0; asm volatile("" : "+v"(F.tid)); F.lane = F.tid & 63; F.wave = __builtin_amdgcn_readfirstlane(F.tid >> 6);
            int cid = F.c, gsz = F.G; asm volatile("" : "+s"(cid), "+s"(gsz)); const int gw = cid * NWAVES + F.wave, NGW = gsz * NWAVES; (void)gw; (void)NGW;
        ArgsP a = get_args(); unsigned char* ws = a->ws; float* out = a->out; const float* fn = a->final_norm;
        const int* slot = WSP(int, SM_SLOT); const float* tok_g = WSP(float, SM_TOKG); const bf16_t* YG = WSP(bf16_t, WS_XG); const bf16_t* YP = WSP(bf16_t, WS_YP);
        constexpr int NB = 4;
        f32x4 gnv[4];
        { const f32x4* gn = (const f32x4*)fn + F.lane;
#pragma unroll
          for (int j = 0; j < 4; ++j) gnv[j] = gn[64 * j]; }
        for (int t0 = gw; t0 < T; t0 += NB * NGW) {
            int tt[NB], rr[NB][2]; float gg[NB][2]; u32x2 xv[NB][4], yv[NB][2][4];
#pragma unroll
            for (int k = 0; k < NB; ++k) { tt[k] = (t0 + k * NGW < T) ? t0 + k * NGW : t0;
                rr[k][0] = slot[2 * tt[k]]; rr[k][1] = slot[2 * tt[k] + 1]; gg[k][0] = tok_g[2 * tt[k]] * (1.0f / (F8_SH * F8_SW)); gg[k][1] = tok_g[2 * tt[k] + 1] * (1.0f / (F8_SH * F8_SW)); }
#pragma unroll
            for (int k = 0; k < NB; ++k) {
                const u32x2* xr = (const u32x2*)(WSP(bf16_t, WS_XR) + (size_t)tt[k] * D) + F.lane;
#pragma unroll
                for (int j = 0; j < 4; ++j) xv[k][j] = xr[64 * j];
#pragma unroll
                for (int sl = 0; sl < 2; ++sl) { const int r = rr[k][sl];
                    const u32x2* y = (const u32x2*)((r < 128 * 256) ? YG + (size_t)r * D : YP + (size_t)(r - 128 * 256) * D) + F.lane;
#pragma unroll
                    for (int j = 0; j < 4; ++j) yv[k][sl][j] = y[64 * j]; }
            }
#pragma unroll
            for (int k = 0; k < NB; ++k) {
                f32x4 v[4]; float s = 0.f;
#pragma unroll
                for (int j = 0; j < 4; ++j) { const u32x2 p = xv[k][j]; v[j] = (f32x4){__uint_as_float(p.x << 16), __uint_as_float(p.x & 0xffff0000u), __uint_as_float(p.y << 16), __uint_as_float(p.y & 0xffff0000u)}; }
#pragma unroll
                for (int sl = 0; sl < 2; ++sl) {
                    const int r = rr[k][sl]; const float gt = gg[k][sl];
#pragma unroll
                    for (int j = 0; j < 4; ++j) { const u32x2 p = yv[k][sl][j];
                        v[j][0] += gt * __uint_as_float(p.x << 16); v[j][1] += gt * __uint_as_float(p.x & 0xffff0000u);
                        v[j][2] += gt * __uint_as_float(p.y << 16); v[j][3] += gt * __uint_as_float(p.y & 0xffff0000u); }
                    if (r >= 128 * 256) {
                        for (int ks = 1; ks < 7; ++ks) {
                            const u32x2* y = (const u32x2*)(YP + ((size_t)ks * YP_ROWS + (r - 128 * 256)) * D) + F.lane;
#pragma unroll
                            for (int j = 0; j < 4; ++j) { const u32x2 p = y[64 * j];
                                v[j][0] += gt * __uint_as_float(p.x << 16); v[j][1] += gt * __uint_as_float(p.x & 0xffff0000u);
                                v[j][2] += gt * __uint_as_float(p.y << 16); v[j][3] += gt * __uint_as_float(p.y & 0xffff0000u); }
                        }
                    }
                }
#pragma unroll
                for (int j = 0; j < 4; ++j) s += (v[j][0] * v[j][0] + v[j][1] * v[j][1]) + (v[j][2] * v[j][2] + v[j][3] * v[j][3]);
                s = wave_sum(s);
                const float rs = 1.0f / sqrtf(s * (1.0f / D) + EPS);
                if (t0 + k * NGW < T) { f32x4* o = (f32x4*)(out + (size_t)tt[k] * D) + F.lane;
#pragma unroll
                    for (int j = 0; j < 4; ++j) o[64 * j] = v[j] * rs * gnv[j]; }
            }
        }
    } PH_END
#undef IN
#undef SEAM
}

extern "C" void kernel_launch(void* const* d_in, const int* in_sizes, int n_in, void* d_out, int out_size, void* d_ws, size_t ws_size, hipStream_t stream) {
    static int grid = 0;
    if (grid == 0) {
        int dev = 0, cus = 0;
        if (n_in != 20 || ws_size < WS_END) { fprintf(stderr, "kernel_launch: unexpected inputs (n_in %d, ws %zu)\n", n_in, ws_size); grid = -1; return; }
        if (hipGetDevice(&dev) != hipSuccess || hipDeviceGetAttribute(&cus, hipDeviceAttributeMultiprocessorCount, dev) != hipSuccess) { grid = -1; return; }
        if (hipFuncSetAttribute((const void*)mega_fwd, hipFuncAttributeMaxDynamicSharedMemorySize, LDS_BYTES) != hipSuccess) { grid = -1; return; }
        int per_cu = 0;
        (void)hipOccupancyMaxActiveBlocksPerMultiprocessor(&per_cu, (const void*)mega_fwd, NWAVES * 64, LDS_BYTES);
        (void)hipGetLastError();
        grid = cus;
    }
    if (grid < 0) return;
    (void)hipMemsetAsync((char*)d_ws + WS_CTL, 0, CTL_ZERO_BYTES, stream);
    Args a{};
    a.x = (const float*)d_in[0]; a.pos = (const int*)d_in[1]; a.attn_norm = (const float*)d_in[2]; a.w_in = (const float*)d_in[3]; a.b_forget = (const float*)d_in[4];
    a.mla_q_norm = (const float*)d_in[5]; a.w_q_up = (const float*)d_in[6]; a.mla_kv_norm = (const float*)d_in[7]; a.w_kv_up = (const float*)d_in[8]; a.sinks = (const float*)d_in[9];
    a.w_out = (const float*)d_in[10]; a.ffn_norm = (const float*)d_in[11]; a.dense_w_gate = (const float*)d_in[12]; a.dense_w_up = (const float*)d_in[13]; a.dense_w_down = (const float*)d_in[14];
    a.router = (const float*)d_in[15]; a.moe_w_gate = (const float*)d_in[16]; a.moe_w_up = (const float*)d_in[17]; a.moe_w_down = (const float*)d_in[18]; a.final_norm = (const float*)d_in[19];
    a.out = (float*)d_out; a.ws = (unsigned char*)d_ws;
#if MK_ONE_LAUNCH
    a.ph_lo = 0; a.ph_hi = NPH;
    hipLaunchKernelGGL(mega_fwd, dim3(grid), dim3(NWAVES * 64), LDS_BYTES, stream, a);
#else
    for (int p = 0; p < NPH; ++p) { a.ph_lo = p; a.ph_hi = p + 1; hipLaunchKernelGGL(mega_fwd, dim3(grid), dim3(NWAVES * 64), LDS_BYTES, stream, a); }
#endif
}
```

```cpp
#include <hip/hip_runtime.h>
#include <cstdio>
#include <cstdint>

#ifndef PROBE_REP
#define PROBE_REP -1
#endif
#ifndef STAMP_MODE
#define STAMP_MODE 0
#endif
#ifndef MK_ONE_LAUNCH
#define MK_ONE_LAUNCH 1
#endif
#ifndef P4_FP8
#define P4_FP8 0
#endif
#ifndef YG_FP8
#define YG_FP8 1
#endif
#ifndef MLA_F8V
#define MLA_F8V 1
#endif
#ifndef UPM_FP6
#define UPM_FP6 1
#endif
#ifndef G1_MIX
#define G1_MIX 1
#endif
#ifndef G1_FP8
#define G1_FP8 2
#endif

#define GAS __attribute__((address_space(1)))
#define LAS __attribute__((address_space(3)))
typedef unsigned short bf16_t;
typedef short bf16x8 __attribute__((ext_vector_type(8)));
typedef short s16x4 __attribute__((ext_vector_type(4)));
typedef float f32x2 __attribute__((ext_vector_type(2)));
typedef float f32x4 __attribute__((ext_vector_type(4)));
typedef float f32x16 __attribute__((ext_vector_type(16)));
typedef unsigned u32x2 __attribute__((ext_vector_type(2)));
typedef unsigned u32x4 __attribute__((ext_vector_type(4)));
typedef __bf16 bf16x2_t __attribute__((ext_vector_type(2)));
typedef GAS unsigned gu32;
typedef int i32x4 __attribute__((ext_vector_type(4)));
typedef int i32x8 __attribute__((ext_vector_type(8)));
typedef int i32x6 __attribute__((ext_vector_type(6)));

constexpr int NB = 2, SEQ = 8192, T = NB * SEQ, D = 1024, NY = 2560, FF = 3584, NEXP = 8;
constexpr int NIN = 2468;
constexpr float EPS = 1e-6f;
constexpr float LOG2E = 1.4426950408889634f;
constexpr float C2_64 = 0.125f * LOG2E;
constexpr float C2_96 = 0.10206207261596575f * LOG2E;
constexpr int Y_FQ = 0, Y_FK = 256, Y_FV = 512, Y_SQ = 768, Y_SK = 1024, Y_SV = 1152, Y_CQ = 1280, Y_DQ = 1536, Y_DK = 1792, Y_DV = 2048,
              Y_CKV = 2304, Y_KR = 2432, Y_FF = 2464;
constexpr int MOE_MAX_TILES = 136, MOE_MAX_ROWS = MOE_MAX_TILES * 256;

constexpr size_t MiB = 1u << 20, KiB = 1u << 10;
constexpr size_t WS_CTL = 0, CTL_ZERO_BYTES = 1 * MiB;
constexpr size_t WS_SM = 1 * MiB;
constexpr size_t SM_RSTD0 = WS_SM, SM_PARTQ = WS_SM + 64 * KiB, SM_PARTKV = WS_SM + 320 * KiB, SM_FF = WS_SM + 576 * KiB, SM_CSL = WS_SM + 832 * KiB,
                 SM_PART = WS_SM + 1088 * KiB, SM_ROPE = WS_SM + 2112 * KiB, SM_TOKE = WS_SM + 4160 * KiB, SM_TOKG = WS_SM + 4288 * KiB,
                 SM_RSTDT = WS_SM + 4416 * KiB, SM_SLOT = WS_SM + 4480 * KiB, SM_RSTDG = WS_SM + 4608 * KiB, SM_HIST = WS_SM + 4800 * KiB, SM_MOETAB = WS_SM + 4808 * KiB;
constexpr size_t WS_WIN = 9 * MiB;
constexpr size_t WS_WIN8 = 88 * MiB;
constexpr size_t WS_WQUP = 19 * MiB;
constexpr size_t WS_WKVUP = 19 * MiB + 512 * KiB;
constexpr size_t WS_WOUT = 20 * MiB;
constexpr size_t WS_WGU0 = 24 * MiB;
constexpr size_t WS_WD0 = 38 * MiB;
constexpr size_t WS_WGU1 = 45 * MiB;
constexpr size_t WS_WD1 = 127 * MiB;
constexpr size_t WS_YP = 373 * MiB;
constexpr int YP_ROWS = 2048;
constexpr size_t WS_XB = 157 * MiB;
constexpr size_t WS_Y = 189 * MiB;
constexpr size_t WS_QM = 269 * MiB, WS_KM = 281 * MiB, WS_VM = 293 * MiB;
constexpr size_t WS_MIX = 301 * MiB;
constexpr size_t WS_DP = 333 * MiB;
constexpr size_t WS_DL = 357 * MiB;
constexpr size_t WS_MP = 360 * MiB;
constexpr size_t WS_ML = 392 * MiB;
constexpr size_t WS_HID = 189 * MiB;
constexpr size_t WS_XG = 157 * MiB;
constexpr size_t WS_HG = 253 * MiB;
constexpr size_t WS_XR = 402 * MiB;
constexpr size_t WS_XB8 = 434 * MiB;
constexpr size_t WS_END = 463 * MiB;
constexpr int CW_BAR = 4096;
constexpr int CW_QUEUE = 16384;
constexpr int CW_GCNT = 22528;
constexpr int XCAP = 16384;
constexpr int CW_FMAX = 20480;
constexpr float FOX_THRESH = 32.0f;

constexpr int RING_BYTES = 131072;
constexpr int LDSCTL_OFF = RING_BYTES, MISC_OFF = LDSCTL_OFF + 320;
constexpr int LDS_BYTES = 147456;
constexpr int ROWTBL_OFF = LDSCTL_OFF + 1024;
constexpr int NWAVES = 8;

#define LDS_WAIT() asm volatile("s_waitcnt lgkmcnt(0)" ::: "memory")
#define VM_WAIT() asm volatile("s_waitcnt vmcnt(0)" ::: "memory")
#define RLX_AGENT __ATOMIC_RELAXED, __HIP_MEMORY_SCOPE_AGENT

__device__ __forceinline__ unsigned cvtpk(float lo, float hi) { f32x2 v = {lo, hi}; bf16x2_t b = __builtin_convertvector(v, bf16x2_t); return __builtin_bit_cast(unsigned, b); }
constexpr unsigned G1_TILES_F8 = 0x1E0u, G1_TILES_BF = 0x21Fu;
constexpr float F8_SY = 16.0f;
constexpr float F8_SX = 8.0f, F8_SW = 256.0f, F8_SH = 16.0f, F8_SM = 32.0f;
__device__ __forceinline__ unsigned cvt4_fp8(float a, float b, float c, float d) {
    a = __builtin_amdgcn_fmed3f(a, -448.0f, 448.0f); b = __builtin_amdgcn_fmed3f(b, -448.0f, 448.0f); c = __builtin_amdgcn_fmed3f(c, -448.0f, 448.0f); d = __builtin_amdgcn_fmed3f(d, -448.0f, 448.0f);
    int p = __builtin_amdgcn_cvt_pk_fp8_f32(a, b, 0, false); p = __builtin_amdgcn_cvt_pk_fp8_f32(c, d, p, true); return (unsigned)p;
}
constexpr float F6_SX = 2.0f, F6_SW = 64.0f;
__device__ __forceinline__ i32x6 pack32_fp6(const float (&t)[32]) {
    f32x16 x, y;
#pragma unroll
    for (int i = 0; i < 16; ++i) { x[i] = __builtin_amdgcn_fmed3f(t[i], -7.5f, 7.5f); y[i] = __builtin_amdgcn_fmed3f(t[16 + i], -7.5f, 7.5f); }
    return __builtin_amdgcn_cvt_scalef32_2xpk16_fp6_f32(x, y, 1.0f);
}
__device__ __forceinline__ void fp6_tiled_offset(int r, int kq, int KT, bool perm, size_t& P, size_t& Q) {
    const int kt = kq >> 2, fq = kq & 3; int rl = r & 127;
    if (perm) { const int c = rl & 31; rl = (rl & ~31) + (((c >> 2) & 1) * 16 + (c >> 3) * 4 + (c & 3)); }
    const size_t tb = ((size_t)(r >> 7) * KT + kt) * 12288;
    const int ob = (rl & 15) * 64 + fq * 16;
    P = tb + (rl >> 4) * 1024 + (ob ^ (((ob >> 9) & 1) << 5));
    Q = tb + 8192 + rl * 32 + (((fq >> 1) ^ (rl >> 3)) & 1) * 16 + (fq & 1) * 8;
}
__host__ __device__ __forceinline__ int vt8_pos(int kappa) { return 32 * ((kappa >> 2) & 1) + (kappa & 3) + 4 * ((kappa & 31) >> 3) + 16 * (kappa >> 5); }
constexpr float F8_SV = 8.0f;
__device__ __forceinline__ i32x8 cat8(const bf16x8 a, const bf16x8 b) { const i32x4 x = __builtin_bit_cast(i32x4, a), y = __builtin_bit_cast(i32x4, b); return __builtin_shufflevector(x, y, 0, 1, 2, 3, 4, 5, 6, 7); }
__device__ __forceinline__ float bf2f(unsigned short h) { return __uint_as_float((unsigned)h << 16); }
__device__ __forceinline__ float wave_sum(float v) {
#pragma unroll
    for (int o = 1; o < 64; o <<= 1) v += __shfl_xor(v, o);
    return v;
}

namespace pg8 {
constexpr int BM = 256, BK = 64, HALF = 128, HTB = HALF * BK * 2, STAGE_BYTES = 8 * HTB, NXCD = 8, WGM = 8;
__host__ __device__ __forceinline__ int lds_byte(int r, int c) { const int st = (r >> 4) * 2 + (c >> 5), rr = r & 15, cc = c & 31, ob = rr * 64 + cc * 2; return st * 1024 + (ob ^ (((ob >> 9) & 1) << 5)); }
__host__ __device__ __forceinline__ void stage_rc(int b, int& R, int& C) { const int st = b / 1024, sb = b % 1024, swz = sb ^ (((sb >> 9) & 1) << 5); R = (st >> 1) * 16 + swz / 64; C = (st & 1) * 32 + (swz % 64) / 2; }
__host__ __device__ __forceinline__ int perm32(int rho) { const int n = rho >> 4, i = rho & 15; return 8 * (i >> 2) + 4 * n + (i & 3); }

struct Unit { int pm, pn, e, ks; };
struct Gemm { const bf16_t* A; const bf16_t* Bt; int lda, ldb, K; };

struct StaticOrder {
    int nM, nN, nwg, G, c;
    __device__ void init(int M, int N, int G_, int c_) { nM = M / BM; nN = N / BM; nwg = nM * nN; G = G_; c = c_; }
    __device__ bool next(int i, Unit& u) const {
        const long L = (long)i * G + c; if (L >= nwg) return false;
        int wgid = (int)L; { const int q = nwg / NXCD, r = nwg % NXCD, xcd = wgid % NXCD, off = wgid / NXCD; wgid = (xcd < r ? xcd * (q + 1) : r * (q + 1) + (xcd - r) * q) + off; }
        const int nig = WGM * nN, gid = wgid / nig, fm = gid * WGM, gsz = (nM - fm) < WGM ? (nM - fm) : WGM;
        u.pm = fm + ((wgid % nig) % gsz); u.pn = (wgid % nig) / gsz; u.e = 0; u.ks = 0; return true;
    }
};
struct SchedStatic {
    StaticOrder o;
    __device__ __forceinline__ bool next(int i, Unit& u) const { return o.next(i, u); }
    __device__ __forceinline__ const char* abase(const Gemm& g, const Unit& u) const { return (const char*)g.A + (size_t)u.pm * BM * g.lda * 2; }
    __device__ __forceinline__ const char* bbase(const Gemm& g, const Unit& u) const { return (const char*)g.Bt + (size_t)u.pn * BM * g.ldb * 2; }
};
struct SchedMoe {
    StaticOrder o; int tb[9]; size_t estride;
    __device__ __forceinline__ bool next(int i, Unit& u) const {
        if (!o.next(i, u)) return false; int e = 0;
#pragma unroll
        for (int j = 1; j < 8; ++j) e += (u.pm >= tb[j]) ? 1 : 0;
        u.e = e; return true;
    }
    __device__ __forceinline__ const char* abase(const Gemm& g, const Unit& u) const { return (const char*)g.A + (size_t)u.pm * BM * g.lda * 2; }
    __device__ __forceinline__ const char* bbase(const Gemm& g, const Unit& u) const { return (const char*)g.Bt + (size_t)u.e * estride + (size_t)u.pn * BM * g.ldb * 2; }
};
struct SchedTiles {
    static constexpr bool HALFM = false;
    int n, c0, cstep, cnt; unsigned tiles;
    __device__ __forceinline__ bool next(int i, Unit& u) const { const int L = c0 + i * cstep; if (i >= cnt || L >= n) return false;
        u.pm = L & 63; u.pn = (int)((tiles >> (4 * (L >> 6))) & 15u); u.e = 0; u.ks = 0; return true; }
    __device__ __forceinline__ const char* abase(const Gemm& g, const Unit& u) const { return (const char*)g.A + (size_t)u.pm * BM * g.lda * 2; }
    __device__ __forceinline__ const char* bbase(const Gemm& g, const Unit& u) const { return (const char*)g.Bt + (size_t)u.pn * BM * g.ldb * 2; }
};
struct SchedMoeL {
    static constexpr bool HALFM = false;
    StaticOrder o; int tb[9]; size_t estride;
    __device__ __forceinline__ bool next(int i, Unit& u) const {
        if (!o.next(i, u)) return false; int e = 0;
#pragma unroll
        for (int j = 1; j < 8; ++j) e += (u.pm >= tb[j]) ? 1 : 0;
        u.e = e; return true;
    }
    __device__ __forceinline__ const char* abase(const Gemm& g, const Unit& u) const { int t0 = 0;
#pragma unroll
        for (int j = 1; j < 8; ++j) t0 = (u.e >= j) ? tb[j] : t0;
        return (const char*)g.A + ((size_t)u.e * XCAP + (size_t)(u.pm - t0) * BM) * g.lda * 2; }
    __device__ __forceinline__ const char* bbase(const Gemm& g, const Unit& u) const { return (const char*)g.Bt + (size_t)u.e * estride + (size_t)u.pn * BM * g.ldb * 2; }
};
struct SchedMoeSplit {
    int tb[9]; size_t estride; int G, c, n0, nUnits, ksl;
    static constexpr int KS = 7;
    __device__ __forceinline__ bool next(int i, Unit& u) const {
        const int L = i * G + c; if (L >= nUnits) return false;
        u.ks = L % KS; u.pn = (L / KS) & 3; u.pm = n0 + L / (4 * KS); int e = 0;
#pragma unroll
        for (int j = 1; j < 8; ++j) e += (u.pm >= tb[j]) ? 1 : 0;
        u.e = e; return true;
    }
    __device__ __forceinline__ const char* abase(const Gemm& g, const Unit& u) const { return (const char*)g.A + (size_t)u.pm * BM * g.lda * 2 + (size_t)u.ks * ksl * 2; }
    __device__ __forceinline__ const char* bbase(const Gemm& g, const Unit& u) const { return (const char*)g.Bt + (size_t)u.e * estride + (size_t)u.pn * BM * g.ldb * 2 + (size_t)u.ks * ksl * 2; }
};
struct SchedOne {
    bool has; Unit un;
    __device__ __forceinline__ bool next(int i, Unit& u) const { if (i > 0 || !has) return false; u = un; return true; }
    __device__ __forceinline__ const char* abase(const Gemm& g, const Unit& u) const { return (const char*)g.A + (size_t)u.pm * BM * g.lda * 2; }
    __device__ __forceinline__ const char* bbase(const Gemm& g, const Unit& u) const { return (const char*)g.Bt + (size_t)u.pn * BM * g.ldb * 2; }
};

template <class Epi, class Sched, bool ALIGN_EPI, bool FP8 = false>
__device__ __forceinline__ void gemm_phase(LAS unsigned char* lds, const Gemm g_in, const Sched& S, const Epi& E) {
    Gemm g = g_in; asm volatile("" : "+s"(g.A), "+s"(g.Bt), "+s"(g.K));
    int tid_l = threadIdx.x; asm volatile("" : "+v"(tid_l));
    const int tid = tid_l, wid = __builtin_amdgcn_readfirstlane(tid >> 6), lane = tid & 63, wr = wid >> 2, wc = wid & 3, fr = lane & 15, fq = lane >> 4;
    const int K = g.K, nt = K / BK;
    unsigned voffA[2], voffB[2];
#pragma unroll
    for (int i = 0; i < 2; ++i) { int R, C; stage_rc(tid * 16 + i * 8192, R, C); const int Rb = Epi::PERM ? ((R & ~31) + perm32(R & 31)) : R;
        voffA[i] = (unsigned)(R * g.lda + C) * 2u; voffB[i] = (unsigned)(Rb * g.ldb + C) * 2u; }
    const size_t kstep = (size_t)(BK * 2);
    const size_t hstepA = (size_t)HALF * g.lda * 2, hstepB = (size_t)HALF * g.ldb * 2;
    const unsigned ldsw = (unsigned)wid * 1024u;
    const int aoff = lds_byte(wr * 64 + fr, fq * 8), boff = lds_byte(wc * 32 + fr, fq * 8);
#define PG8_SA(b, h) (((b) * 2 + (h)) * HTB)
#define PG8_SB(b, h) ((4 + (b) * 2 + (h)) * HTB)
#define PG8_STAGE(bufoff, gbase, voff) do { _Pragma("unroll") for (int _i = 0; _i < 2; ++_i) \
        __builtin_amdgcn_global_load_lds((const unsigned*)((const char*)(gbase) + (voff)[_i]), (LAS unsigned*)(lds + (bufoff) + ldsw + _i * 8192), 16, 0, 0); } while (0)
#define PG8_LDA(dst, b, h) do { _Pragma("unroll") for (int m = 0; m < 4; ++m) _Pragma("unroll") for (int k = 0; k < 2; ++k) dst[m][k] = *(const LAS bf16x8*)(lds + PG8_SA(b, h) + aoff + m * 2048 + k * 1024); } while (0)
#define PG8_LDB(dst, b, h) do { _Pragma("unroll") for (int n = 0; n < 2; ++n) _Pragma("unroll") for (int k = 0; k < 2; ++k) dst[n][k] = *(const LAS bf16x8*)(lds + PG8_SB(b, h) + boff + n * 2048 + k * 1024); } while (0)
#define PG8_MMA(ai, bj, At, Bt) do { __builtin_amdgcn_s_setprio(1); \
        if constexpr (FP8) { _Pragma("unroll") for (int m = 0; m < 4; ++m) _Pragma("unroll") for (int n = 0; n < 2; ++n) \
            asm volatile("v_mfma_f32_16x16x128_f8f6f4 %0, %1, %2, %0" : "+v"(acc[ai][bj][m][n]) : "v"(cat8(Bt[n][0], Bt[n][1])), "v"(cat8(At[m][0], At[m][1]))); } \
        else { _Pragma("unroll") for (int m = 0; m < 4; ++m) _Pragma("unroll") for (int n = 0; n < 2; ++n) _Pragma("unroll") for (int k = 0; k < 2; ++k) \
            acc[ai][bj][m][n] = __builtin_amdgcn_mfma_f32_16x16x32_bf16(Bt[n][k], At[m][k], acc[ai][bj][m][n], 0, 0, 0); } \
        __builtin_amdgcn_s_setprio(0); } while (0)
#define PG8_WAIT_V(n) asm volatile("s_waitcnt vmcnt(" #n ")" ::: "memory")
#define PG8_WAIT_L(n) asm volatile("s_waitcnt lgkmcnt(" #n ")" ::: "memory")
#define PG8_BAR __builtin_amdgcn_s_barrier()
#define PG8_SCHED __builtin_amdgcn_sched_barrier(0)
    Unit cur, nxt; int ui = 0;
    if (!S.next(0, cur)) return;
    if constexpr (Epi::SCALE == 1) { f32x4 pv0[4]; rowtbl_issue(E.rt, cur.pm, tid, pv0); rowtbl_commit(E.rt, 0, tid, pv0); }
    f32x4 acc[2][2][4][2];
#pragma unroll
    for (int a = 0; a < 2; ++a)
#pragma unroll
        for (int b = 0; b < 2; ++b)
#pragma unroll
            for (int m = 0; m < 4; ++m)
#pragma unroll
                for (int n = 0; n < 2; ++n) acc[a][b][m][n] = (f32x4){0.f, 0.f, 0.f, 0.f};
    bf16x8 At[4][2], B0[2][2], B1[2][2];
    const char* cA = S.abase(g, cur); const char* cB = S.bbase(g, cur);
    PG8_STAGE(PG8_SB(0, 0), cB, voffB); PG8_STAGE(PG8_SB(0, 1), cB + hstepB, voffB); PG8_STAGE(PG8_SA(0, 0), cA, voffA); PG8_STAGE(PG8_SA(0, 1), cA + hstepA, voffA);
    if (wr == 1) PG8_BAR;
    PG8_WAIT_V(2); PG8_BAR;
    PG8_STAGE(PG8_SB(1, 0), cB + kstep, voffB); PG8_STAGE(PG8_SA(1, 0), cA + kstep, voffA); PG8_STAGE(PG8_SB(1, 1), cB + hstepB + kstep, voffB);
    PG8_WAIT_V(6); PG8_BAR;
    for (;;) {
        const bool has_next = S.next(ui + 1, nxt);
        const char* nA = has_next ? S.abase(g, nxt) : cA; const char* nB = has_next ? S.bbase(g, nxt) : cB;
        for (int t = 0; t < nt; t += 2) {
            const bool last = (t == nt - 2);
            const char* a1 = cA + (size_t)(t + 1) * kstep;
            const char* a2 = last ? nA : cA + (size_t)(t + 2) * kstep; const char* b2 = last ? nB : cB + (size_t)(t + 2) * kstep;
            const char* a3 = a2 + kstep; const char* b3 = b2 + kstep;
            PG8_LDB(B0, 0, 0); PG8_LDB(B1, 0, 1); PG8_SCHED; PG8_LDA(At, 0, 0); PG8_STAGE(PG8_SA(1, 1), a1 + hstepA, voffA);
            PG8_WAIT_V(8); PG8_WAIT_L(0); PG8_BAR; PG8_MMA(0, 0, At, B0); PG8_MMA(0, 1, At, B1); PG8_BAR; PG8_SCHED;
            PG8_LDA(At, 0, 1); PG8_STAGE(PG8_SB(0, 0), b2, voffB); PG8_STAGE(PG8_SB(0, 1), b2 + hstepB, voffB); PG8_STAGE(PG8_SA(0, 0), a2, voffA);
            PG8_WAIT_V(8); PG8_WAIT_L(0); PG8_BAR; PG8_MMA(1, 0, At, B0); PG8_MMA(1, 1, At, B1); PG8_BAR; PG8_SCHED;
            PG8_LDB(B0, 1, 0); PG8_LDB(B1, 1, 1); PG8_SCHED; PG8_LDA(At, 1, 0); PG8_STAGE(PG8_SA(0, 1), a2 + hstepA, voffA);
            PG8_WAIT_V(8); PG8_WAIT_L(0); PG8_BAR; PG8_MMA(0, 0, At, B0); PG8_MMA(0, 1, At, B1); PG8_BAR; PG8_SCHED;
            PG8_LDA(At, 1, 1); PG8_STAGE(PG8_SB(1, 0), b3, voffB); PG8_STAGE(PG8_SB(1, 1), b3 + hstepB, voffB); PG8_STAGE(PG8_SA(1, 0), a3, voffA);
            PG8_WAIT_V(8); PG8_WAIT_L(0); PG8_BAR; PG8_MMA(1, 0, At, B0); PG8_MMA(1, 1, At, B1); PG8_BAR; PG8_SCHED;
        }
        if constexpr (ALIGN_EPI) { if (wr == 0) PG8_BAR; }
        if constexpr (FP8) asm volatile("s_nop 15\n\ts_nop 15" ::: "memory");
        f32x4 pvn[4];
        if constexpr (Epi::SCALE == 1) { if (has_next) rowtbl_issue(E.rt, nxt.pm, tid, pvn); }
        E(acc, cur, wr, wc, fr, fq, ui & 1);
        if constexpr (Epi::SCALE == 1) { if (has_next) rowtbl_commit(E.rt, (ui + 1) & 1, tid, pvn); }
        if (!has_next) break;
#pragma unroll
        for (int a = 0; a < 2; ++a)
#pragma unroll
            for (int b = 0; b < 2; ++b)
#pragma unroll
                for (int m = 0; m < 4; ++m)
#pragma unroll
                    for (int n = 0; n < 2; ++n) acc[a][b][m][n] = (f32x4){0.f, 0.f, 0.f, 0.f};
        cur = nxt; cA = nA; cB = nB; ++ui;
        if constexpr (ALIGN_EPI) { if (wr == 1) PG8_BAR; }
    }
    PG8_WAIT_V(0);
    if constexpr (!ALIGN_EPI) { if (wr == 0) PG8_BAR; }
    PG8_BAR;
#undef PG8_SA
#undef PG8_SB
#undef PG8_STAGE
#undef PG8_LDA
#undef PG8_LDB
#undef PG8_MMA
#undef PG8_WAIT_V
#undef PG8_WAIT_L
#undef PG8_BAR
#undef PG8_SCHED
}

template <class Epi, class Sched, bool ALIGN_EPI>
__device__ __forceinline__ void gemm_phase6(LAS unsigned char* lds, const Gemm g_in, const Sched& S, const Epi& E) {
    Gemm g = g_in; asm volatile("" : "+s"(g.A), "+s"(g.Bt), "+s"(g.K));
    int tid_l = threadIdx.x; asm volatile("" : "+v"(tid_l));
    const int tid = tid_l, wid = __builtin_amdgcn_readfirstlane(tid >> 6), lane = tid & 63, wr = wid >> 2, wc = wid & 3, fr = lane & 15, fq = lane >> 4;
    const int K = g.K, nt = K / 48;
    unsigned voffA[2], voffB[2];
    voffA[0] = voffB[0] = (unsigned)tid * 16u; voffA[1] = voffB[1] = (tid < 256) ? 8192u + (unsigned)tid * 16u : 0u;
    const size_t kstep = 12288;
    const size_t hstepA = (size_t)HALF * g.lda * 2, hstepB = (size_t)HALF * g.ldb * 2;
    const unsigned ldsw = (unsigned)wid * 1024u;
    const int pob = fr * 64 + fq * 16, pof = pob ^ (((pob >> 9) & 1) << 5), qof = fr * 32 + (((fq >> 1) ^ (fr >> 3)) & 1) * 16 + (fq & 1) * 8;
    const int aoffP = wr * 4096 + pof, aoffQ = 8192 + wr * 2048 + qof, boffP = wc * 2048 + pof, boffQ = 8192 + wc * 1024 + qof;
#define P6_SA(b, h) (((b) * 2 + (h)) * HTB)
#define P6_SB(b, h) ((4 + (b) * 2 + (h)) * HTB)
#define P6_STAGE(bufoff, gbase, voff) do { _Pragma("unroll") for (int _i = 0; _i < 2; ++_i) \
        __builtin_amdgcn_global_load_lds((const unsigned*)((const char*)(gbase) + (voff)[_i]), (LAS unsigned*)(lds + (bufoff) + ldsw + _i * 8192), 16, 0, 0); } while (0)
#define P6_RD(dst, pp, qq) do { const u32x4 _a = *(const LAS u32x4*)(pp); const u32x2 _c = *(const LAS u32x2*)(qq); \
        dst = (i32x6){(int)_a.x, (int)_a.y, (int)_a.z, (int)_a.w, (int)_c.x, (int)_c.y}; } while (0)
#define P6_LDA(dst, b, h) do { _Pragma("unroll") for (int m = 0; m < 4; ++m) P6_RD(dst[m], lds + P6_SA(b, h) + aoffP + m * 1024, lds + P6_SA(b, h) + aoffQ + m * 512); } while (0)
#define P6_LDB(dst, b, h) do { _Pragma("unroll") for (int n = 0; n < 2; ++n) P6_RD(dst[n], lds + P6_SB(b, h) + boffP + n * 1024, lds + P6_SB(b, h) + boffQ + n * 512); } while (0)
#define P6_MMA(ai, bj, At, Bt) do { __builtin_amdgcn_s_setprio(1); _Pragma("unroll") for (int m = 0; m < 4; ++m) _Pragma("unroll") for (int n = 0; n < 2; ++n) \
        asm volatile("v_mfma_f32_16x16x128_f8f6f4 %0, %1, %2, %0 cbsz:2 blgp:2" : "+v"(acc[ai][bj][m][n]) : "v"(Bt[n]), "v"(At[m])); \
        __builtin_amdgcn_s_setprio(0); } while (0)
#define P6_WAIT_V(n) asm volatile("s_waitcnt vmcnt(" #n ")" ::: "memory")
#define P6_WAIT_L(n) asm volatile("s_waitcnt lgkmcnt(" #n ")" ::: "memory")
#define P6_BAR __builtin_amdgcn_s_barrier()
#define P6_SCHED __builtin_amdgcn_sched_barrier(0)
    Unit cur, nxt; int ui = 0;
    if (!S.next(0, cur)) return;
    if constexpr (Epi::SCALE == 1) { f32x4 pv0[4]; rowtbl_issue(E.rt, cur.pm, tid, pv0); rowtbl_commit(E.rt, 0, tid, pv0); }
    f32x4 acc[2][2][4][2];
#pragma unroll
    for (int a = 0; a < 2; ++a)
#pragma unroll
        for (int b = 0; b < 2; ++b)
#pragma unroll
            for (int m = 0; m < 4; ++m)
#pragma unroll
                for (int n = 0; n < 2; ++n) acc[a][b][m][n] = (f32x4){0.f, 0.f, 0.f, 0.f};
    i32x6 At[4], B0[2], B1[2];
    const char* cA = S.abase(g, cur); const char* cB = S.bbase(g, cur);
    P6_STAGE(P6_SB(0, 0), cB, voffB); P6_STAGE(P6_SB(0, 1), cB + hstepB, voffB); P6_STAGE(P6_SA(0, 0), cA, voffA); P6_STAGE(P6_SA(0, 1), cA + hstepA, voffA);
    if (wr == 1) P6_BAR;
    P6_WAIT_V(2); P6_BAR;
    P6_STAGE(P6_SB(1, 0), cB + kstep, voffB); P6_STAGE(P6_SA(1, 0), cA + kstep, voffA); P6_STAGE(P6_SB(1, 1), cB + hstepB + kstep, voffB);
    P6_WAIT_V(6); P6_BAR;
    for (;;) {
        const bool has_next = S.next(ui + 1, nxt);
        const char* nA = has_next ? S.abase(g, nxt) : cA; const char* nB = has_next ? S.bbase(g, nxt) : cB;
        for (int t = 0; t < nt; t += 2) {
            const bool last = (t == nt - 2);
            const char* a1 = cA + (size_t)(t + 1) * kstep;
            const char* a2 = last ? nA : cA + (size_t)(t + 2) * kstep; const char* b2 = last ? nB : cB + (size_t)(t + 2) * kstep;
            const char* a3 = a2 + kstep; const char* b3 = b2 + kstep;
            P6_LDB(B0, 0, 0); P6_LDB(B1, 0, 1); P6_SCHED; P6_LDA(At, 0, 0); P6_STAGE(P6_SA(1, 1), a1 + hstepA, voffA);
            P6_WAIT_V(8); P6_WAIT_L(0); P6_BAR; P6_MMA(0, 0, At, B0); P6_MMA(0, 1, At, B1); P6_BAR; P6_SCHED;
            P6_LDA(At, 0, 1); P6_STAGE(P6_SB(0, 0), b2, voffB); P6_STAGE(P6_SB(0, 1), b2 + hstepB, voffB); P6_STAGE(P6_SA(0, 0), a2, voffA);
            P6_WAIT_V(8); P6_WAIT_L(0); P6_BAR; P6_MMA(1, 0, At, B0); P6_MMA(1, 1, At, B1); P6_BAR; P6_SCHED;
            P6_LDB(B0, 1, 0); P6_LDB(B1, 1, 1); P6_SCHED; P6_LDA(At, 1, 0); P6_STAGE(P6_SA(0, 1), a2 + hstepA, voffA);
            P6_WAIT_V(8); P6_WAIT_L(0); P6_BAR; P6_MMA(0, 0, At, B0); P6_MMA(0, 1, At, B1); P6_BAR; P6_SCHED;
            P6_LDA(At, 1, 1); P6_STAGE(P6_SB(1, 0), b3, voffB); P6_STAGE(P6_SB(1, 1), b3 + hstepB, voffB); P6_STAGE(P6_SA(1, 0), a3, voffA);
            P6_WAIT_V(8); P6_WAIT_L(0); P6_BAR; P6_MMA(1, 0, At, B0); P6_MMA(1, 1, At, B1); P6_BAR; P6_SCHED;
        }
        if constexpr (ALIGN_EPI) { if (wr == 0) P6_BAR; }
        asm volatile("s_nop 15\n\ts_nop 15" ::: "memory");
        f32x4 pvn[4];
        if constexpr (Epi::SCALE == 1) { if (has_next) rowtbl_issue(E.rt, nxt.pm, tid, pvn); }
        E(acc, cur, wr, wc, fr, fq, ui & 1);
        if constexpr (Epi::SCALE == 1) { if (has_next) rowtbl_commit(E.rt, (ui + 1) & 1, tid, pvn); }
        if (!has_next) break;
#pragma unroll
        for (int a = 0; a < 2; ++a)
#pragma unroll
            for (int b = 0; b < 2; ++b)
#pragma unroll
                for (int m = 0; m < 4; ++m)
#pragma unroll
                    for (int n = 0; n < 2; ++n) acc[a][b][m][n] = (f32x4){0.f, 0.f, 0.f, 0.f};
        cur = nxt; cA = nA; cB = nB; ++ui;
        if constexpr (ALIGN_EPI) { if (wr == 1) P6_BAR; }
    }
    P6_WAIT_V(0);
    if constexpr (!ALIGN_EPI) { if (wr == 0) P6_BAR; }
    P6_BAR;
#undef P6_SA
#undef P6_SB
#undef P6_STAGE
#undef P6_RD
#undef P6_LDA
#undef P6_LDB
#undef P6_MMA
#undef P6_WAIT_V
#undef P6_WAIT_L
#undef P6_BAR
#undef P6_SCHED
}

__device__ __forceinline__ float rstd_part(const float* part, int row) {
    const f32x4* p = (const f32x4*)(part + (size_t)row * 16);
    const f32x4 a = p[0], b = p[1], c = p[2], d = p[3];
    const float s = ((a[0] + a[1]) + (a[2] + a[3])) + ((b[0] + b[1]) + (b[2] + b[3])) + ((c[0] + c[1]) + (c[2] + c[3])) + ((d[0] + d[1]) + (d[2] + d[3]));
    return __builtin_amdgcn_rsqf(s * (1.0f / D) + EPS);
}
struct RowTbl { const float* part; LAS float* tbl; };
__device__ __forceinline__ void rowtbl_issue(const RowTbl& R, int pm, int tid, f32x4 (&pv)[4]) {
    if (tid < 256) { const f32x4* p = (const f32x4*)(R.part + ((size_t)pm * BM + tid) * 16); pv[0] = p[0]; pv[1] = p[1]; pv[2] = p[2]; pv[3] = p[3]; }
}
__device__ __forceinline__ void rowtbl_commit(const RowTbl& R, int parity, int tid, const f32x4 (&pv)[4]) {
    if (tid < 256) { const float s = ((pv[0][0] + pv[0][1]) + (pv[0][2] + pv[0][3])) + ((pv[1][0] + pv[1][1]) + (pv[1][2] + pv[1][3])) + ((pv[2][0] + pv[2][1]) + (pv[2][2] + pv[2][3])) + ((pv[3][0] + pv[3][1]) + (pv[3][2] + pv[3][3]));
        R.tbl[parity * 256 + tid] = __builtin_amdgcn_rsqf(s * (1.0f / D) + EPS); }
}
__device__ __forceinline__ u32x4 pack8(const f32x4 v0, const f32x4 v1) { u32x4 w; w.x = cvtpk(v0[0], v0[1]); w.y = cvtpk(v0[2], v0[3]); w.z = cvtpk(v1[0], v1[1]); w.w = cvtpk(v1[2], v1[3]); return w; }

template <int SCALE_, bool F8 = false>
struct EpiG1 {
    static constexpr int SCALE = SCALE_; static constexpr bool PERM = true;
    bf16_t* Y; RowTbl rt; float* partq; float* partkv; float* ff; bf16_t* Km; const float* rope;
    __device__ __forceinline__ void operator()(const f32x4 (&acc)[2][2][4][2], const Unit& u, int wr, int wc, int fr, int fq, int par) const {
#pragma unroll
        for (int ai = 0; ai < 2; ++ai)
#pragma unroll
            for (int m = 0; m < 4; ++m) {
                asm volatile("" ::: "memory");
                const int row = u.pm * BM + ai * HALF + wr * 64 + m * 16 + fr;
                const float rs = (SCALE ? rt.tbl[par * 256 + ai * HALF + wr * 64 + m * 16 + fr] : 1.0f) * (F8 ? 1.0f / (F8_SX * F8_SW) : 1.0f);
                f32x4 v[2][2];
#pragma unroll
                for (int bj = 0; bj < 2; ++bj) { v[bj][0] = acc[ai][bj][m][0] * rs; v[bj][1] = acc[ai][bj][m][1] * rs;
                    *(u32x4*)(Y + (size_t)row * NY + u.pn * BM + bj * HALF + wc * 32 + 8 * fq) = pack8(v[bj][0], v[bj][1]); }
                if (u.pn == Y_CQ / 256) {
                    float s = 0.f;
#pragma unroll
                    for (int bj = 0; bj < 2; ++bj)
#pragma unroll
                        for (int n = 0; n < 2; ++n) { const f32x4 x = v[bj][n]; s += (x[0] * x[0] + x[1] * x[1]) + (x[2] * x[2] + x[3] * x[3]); }
                    s += __shfl_xor(s, 16); s += __shfl_xor(s, 32);
                    if (fq == 0) partq[row * 4 + wc] = s;
                }
                if (u.pn == Y_CKV / 256) {
                    float s = 0.f;
#pragma unroll
                    for (int n = 0; n < 2; ++n) { const f32x4 x = v[0][n]; s += (x[0] * x[0] + x[1] * x[1]) + (x[2] * x[2] + x[3] * x[3]); }
                    s += __shfl_xor(s, 16); s += __shfl_xor(s, 32);
                    if (fq == 0) partkv[row * 4 + wc] = s;
                    if (wc == 0) {
                        const f32x4* rp = (const f32x4*)(rope + (size_t)row * 32 + 8 * fq);
                        const f32x4 cs0 = rp[0], cs1 = rp[1];
                        const f32x4 t1 = v[1][0], t2 = v[1][1];
                        f32x4 o1, o2;
                        o1[0] = t1[0] * cs0[0] - t2[0] * cs0[1]; o2[0] = t2[0] * cs0[0] + t1[0] * cs0[1];
                        o1[1] = t1[1] * cs0[2] - t2[1] * cs0[3]; o2[1] = t2[1] * cs0[2] + t1[1] * cs0[3];
                        o1[2] = t1[2] * cs1[0] - t2[2] * cs1[1]; o2[2] = t2[2] * cs1[0] + t1[2] * cs1[1];
                        o1[3] = t1[3] * cs1[2] - t2[3] * cs1[3]; o2[3] = t2[3] * cs1[2] + t1[3] * cs1[3];
                        const u32x4 w = pack8(o1, o2);
#pragma unroll
                        for (int h = 0; h < 4; ++h) *(u32x4*)(Km + (size_t)row * 384 + h * 96 + 64 + 8 * fq) = w;
                    }
                    if (wc == 1 && fq == 0) *(f32x4*)(ff + (size_t)row * 4) = v[1][0];
                }
            }
    }
};
struct EpiQup {
    static constexpr int SCALE = 0; static constexpr bool PERM = true;
    bf16_t* Qm; const float* partq; const float* rope;
    __device__ __forceinline__ void operator()(const f32x4 (&acc)[2][2][4][2], const Unit& u, int wr, int wc, int fr, int fq, int par) const {
        int col[2], cm[2];
#pragma unroll
        for (int bj = 0; bj < 2; ++bj) { col[bj] = u.pn * BM + bj * HALF + wc * 32 + 8 * fq; cm[bj] = col[bj] % 96; }
#pragma unroll
        for (int ai = 0; ai < 2; ++ai) {
            asm volatile("" ::: "memory");
            f32x4 pq[4], cs[4][2][2];
#pragma unroll
            for (int m = 0; m < 4; ++m) { const int row = u.pm * BM + ai * HALF + wr * 64 + m * 16 + fr;
                pq[m] = *(const f32x4*)(partq + (size_t)row * 4);
#pragma unroll
                for (int bj = 0; bj < 2; ++bj) if (col[bj] < 384 && cm[bj] >= 64) { const f32x4* rp = (const f32x4*)(rope + (size_t)row * 32 + (cm[bj] - 64)); cs[m][bj][0] = rp[0]; cs[m][bj][1] = rp[1]; } }
#pragma unroll
            for (int m = 0; m < 4; ++m) {
                const int row = u.pm * BM + ai * HALF + wr * 64 + m * 16 + fr;
                const float rs = __builtin_amdgcn_rsqf(((pq[m][0] + pq[m][1]) + (pq[m][2] + pq[m][3])) * (1.0f / 256.0f) + EPS);
#pragma unroll
                for (int bj = 0; bj < 2; ++bj) {
                    if (col[bj] < 384) {
                        f32x4 v0 = acc[ai][bj][m][0] * rs, v1 = acc[ai][bj][m][1] * rs;
                        if (cm[bj] >= 64) {
                            const f32x4 cs0 = cs[m][bj][0], cs1 = cs[m][bj][1];
                            const f32x4 t1 = v0, t2 = v1;
                            v0[0] = t1[0] * cs0[0] - t2[0] * cs0[1]; v1[0] = t2[0] * cs0[0] + t1[0] * cs0[1];
                            v0[1] = t1[1] * cs0[2] - t2[1] * cs0[3]; v1[1] = t2[1] * cs0[2] + t1[1] * cs0[3];
                            v0[2] = t1[2] * cs1[0] - t2[2] * cs1[1]; v1[2] = t2[2] * cs1[0] + t1[2] * cs1[1];
                            v0[3] = t1[3] * cs1[2] - t2[3] * cs1[3]; v1[3] = t2[3] * cs1[2] + t1[3] * cs1[3];
                        }
                        *(u32x4*)(Qm + (size_t)row * 384 + col[bj]) = pack8(v0, v1);
                    }
                }
            }
        }
    }
};
struct EpiKVup {
    static constexpr int SCALE = 0; static constexpr bool PERM = true;
    bf16_t* Km; bf16_t* Vm; const float* partkv; unsigned char* VT8;
    __device__ __forceinline__ void operator()(const f32x4 (&acc)[2][2][4][2], const Unit& u, int wr, int wc, int fr, int fq, int par) const {
#pragma unroll
        for (int ai = 0; ai < 2; ++ai) {
            asm volatile("" ::: "memory");
            f32x4 pqv[4];
#pragma unroll
            for (int m = 0; m < 4; ++m) pqv[m] = *(const f32x4*)(partkv + (size_t)(u.pm * BM + ai * HALF + wr * 64 + m * 16 + fr) * 4);
#pragma unroll
            for (int m = 0; m < 4; ++m) {
                const int row = u.pm * BM + ai * HALF + wr * 64 + m * 16 + fr;
                const f32x4 pq = pqv[m];
                const float rs = __builtin_amdgcn_rsqf(((pq[0] + pq[1]) + (pq[2] + pq[3])) * (1.0f / 128.0f) + EPS);
#pragma unroll
                for (int bj = 0; bj < 2; ++bj) {
                    const int col = u.pn * BM + bj * HALF + wc * 32 + 8 * fq;
                    const int h = col >> 7, c = col & 127;
                    const u32x4 w = pack8(acc[ai][bj][m][0] * rs, acc[ai][bj][m][1] * rs);
                    if (c < 64) *(u32x4*)(Km + (size_t)row * 384 + h * 96 + c) = w;
                    else if (VT8) { const int b_ = row / SEQ, s_ = row % SEQ;
                        unsigned char* vt = VT8 + ((size_t)(b_ * 4 + h) * 64 + (c - 64)) * SEQ + (s_ & ~63) + vt8_pos(s_ & 63);
                        const f32x4 x0 = acc[ai][bj][m][0] * (rs * F8_SV), x1 = acc[ai][bj][m][1] * (rs * F8_SV);
                        const unsigned p0_ = cvt4_fp8(x0[0], x0[1], x0[2], x0[3]), p1_ = cvt4_fp8(x1[0], x1[1], x1[2], x1[3]);
#pragma unroll
                        for (int e = 0; e < 4; ++e) { vt[(size_t)e * SEQ] = (unsigned char)(p0_ >> (8 * e)); vt[(size_t)(4 + e) * SEQ] = (unsigned char)(p1_ >> (8 * e)); } }
                    else *(u32x4*)(Vm + (size_t)row * 256 + h * 64 + (c - 64)) = w;
                }
            }
        }
    }
};
template <bool BASE16>
struct EpiRes {
    static constexpr int SCALE = 0; static constexpr bool PERM = true;
    const void* base; bf16_t* xo; float* part; unsigned char* x8; float dsc;
    __device__ __forceinline__ void operator()(const f32x4 (&acc)[2][2][4][2], const Unit& u, int wr, int wc, int fr, int fq, int par) const {
#pragma unroll
        for (int ai = 0; ai < 2; ++ai) {
            asm volatile("" ::: "memory");
            f32x4 pre[4][2][2];
            u32x4 pre16[4][2];
#pragma unroll
            for (int m = 0; m < 4; ++m) { const size_t roff = (size_t)(u.pm * BM + ai * HALF + wr * 64 + m * 16 + fr) * D + u.pn * BM + wc * 32 + 8 * fq;
#pragma unroll
                for (int bj = 0; bj < 2; ++bj) {
                    if constexpr (BASE16) pre16[m][bj] = *(const u32x4*)((const bf16_t*)base + roff + bj * HALF);
                    else { pre[m][bj][0] = *(const f32x4*)((const float*)base + roff + bj * HALF); pre[m][bj][1] = *(const f32x4*)((const float*)base + roff + bj * HALF + 4); } } }
#pragma unroll
            for (int m = 0; m < 4; ++m) {
                const int row = u.pm * BM + ai * HALF + wr * 64 + m * 16 + fr;
                float s = 0.f;
#pragma unroll
                for (int bj = 0; bj < 2; ++bj) {
                    f32x4 x0, x1;
                    if constexpr (BASE16) { const u32x4 w = pre16[m][bj];
                        x0 = (f32x4){__uint_as_float(w.x << 16), __uint_as_float(w.x & 0xffff0000u), __uint_as_float(w.y << 16), __uint_as_float(w.y & 0xffff0000u)};
                        x1 = (f32x4){__uint_as_float(w.z << 16), __uint_as_float(w.z & 0xffff0000u), __uint_as_float(w.w << 16), __uint_as_float(w.w & 0xffff0000u)}; }
                    else { x0 = pre[m][bj][0]; x1 = pre[m][bj][1]; }
                    x0 += acc[ai][bj][m][0] * dsc; x1 += acc[ai][bj][m][1] * dsc;
                    *(u32x4*)(xo + (size_t)row * D + u.pn * BM + bj * HALF + wc * 32 + 8 * fq) = pack8(x0, x1);
                    if (x8) { u32x2 w8; w8.x = cvt4_fp8(x0[0] * F8_SX, x0[1] * F8_SX, x0[2] * F8_SX, x0[3] * F8_SX); w8.y = cvt4_fp8(x1[0] * F8_SX, x1[1] * F8_SX, x1[2] * F8_SX, x1[3] * F8_SX);
                        *(u32x2*)(x8 + (size_t)row * D + u.pn * BM + bj * HALF + wc * 32 + 8 * fq) = w8; }
                    s += ((x0[0] * x0[0] + x0[1] * x0[1]) + (x0[2] * x0[2] + x0[3] * x0[3])) + ((x1[0] * x1[0] + x1[1] * x1[1]) + (x1[2] * x1[2] + x1[3] * x1[3]));
                }
                s += __shfl_xor(s, 16); s += __shfl_xor(s, 32);
                if (fq == 0) part[(size_t)row * 16 + u.pn * 4 + wc] = s;
            }
        }
    }
};
template <int SCALE_, int F8IN, bool F8OUT>
struct EpiSwigluT {
    static constexpr int SCALE = SCALE_; static constexpr bool PERM = true;
    void* H; RowTbl rt;
    __device__ __forceinline__ void operator()(const f32x4 (&acc)[2][2][4][2], const Unit& u, int wr, int wc, int fr, int fq, int par) const {
#pragma unroll
        for (int ai = 0; ai < 2; ++ai)
#pragma unroll
            for (int m = 0; m < 4; ++m) {
                asm volatile("" ::: "memory");
                const int row = u.pm * BM + ai * HALF + wr * 64 + m * 16 + fr;
                const float rs = (SCALE ? rt.tbl[par * 256 + ai * HALF + wr * 64 + m * 16 + fr] : 1.0f) * (F8IN == 1 ? 1.0f / (F8_SX * F8_SW) : F8IN == 2 ? 1.0f / (F6_SX * F6_SW) : 1.0f);
                f32x4 hv[2];
                const float rl = -rs * LOG2E, rr = rs * rs * (F8OUT ? F8_SH : 1.0f);
#pragma unroll
                for (int n = 0; n < 2; ++n) {
                    const f32x4 a0 = acc[ai][0][m][n], a1 = acc[ai][1][m][n];
#pragma unroll
                    for (int e = 0; e < 4; ++e) { const float sg = __builtin_amdgcn_rcpf(1.0f + __builtin_amdgcn_exp2f(a0[e] * rl)); hv[n][e] = (a0[e] * a1[e]) * (rr * sg); }
                }
                if constexpr (F8OUT) { u32x2 w; w.x = cvt4_fp8(hv[0][0], hv[0][1], hv[0][2], hv[0][3]); w.y = cvt4_fp8(hv[1][0], hv[1][1], hv[1][2], hv[1][3]);
                    *(u32x2*)((unsigned char*)H + (size_t)row * FF + u.pn * HALF + wc * 32 + 8 * fq) = w; }
                else *(u32x4*)((bf16_t*)H + (size_t)row * FF + u.pn * HALF + wc * 32 + 8 * fq) = pack8(hv[0], hv[1]);
            }
    }
};
struct EpiY {
    static constexpr int SCALE = 0; static constexpr bool PERM = true;
    bf16_t* O;
    __device__ __forceinline__ void operator()(const f32x4 (&acc)[2][2][4][2], const Unit& u, int wr, int wc, int fr, int fq, int par) const {
#pragma unroll
        for (int ai = 0; ai < 2; ++ai)
#pragma unroll
            for (int m = 0; m < 4; ++m) {
                asm volatile("" ::: "memory");
                const int row = u.pm * BM + ai * HALF + wr * 64 + m * 16 + fr;
#pragma unroll
                for (int bj = 0; bj < 2; ++bj) {
                    if (YG_FP8) { const f32x4 y0 = acc[ai][bj][m][0] * (F8_SY / (F8_SH * F8_SW)), y1 = acc[ai][bj][m][1] * (F8_SY / (F8_SH * F8_SW));
                        u32x2 w; w.x = cvt4_fp8(y0[0], y0[1], y0[2], y0[3]); w.y = cvt4_fp8(y1[0], y1[1], y1[2], y1[3]);
                        *(u32x2*)((unsigned char*)O + (size_t)row * D + u.pn * BM + bj * HALF + wc * 32 + 8 * fq) = w; }
                    else *(u32x4*)(O + (size_t)row * D + u.pn * BM + bj * HALF + wc * 32 + 8 * fq) = pack8(acc[ai][bj][m][0], acc[ai][bj][m][1]); }
            }
    }
};
struct EpiYs {
    static constexpr int SCALE = 0; static constexpr bool PERM = true;
    bf16_t* O; int n0, prow;
    __device__ __forceinline__ void operator()(const f32x4 (&acc)[2][2][4][2], const Unit& u, int wr, int wc, int fr, int fq, int par) const {
#pragma unroll
        for (int ai = 0; ai < 2; ++ai)
#pragma unroll
            for (int m = 0; m < 4; ++m) {
                const int row = u.ks * prow + (u.pm - n0) * BM + ai * HALF + wr * 64 + m * 16 + fr;
#pragma unroll
                for (int bj = 0; bj < 2; ++bj) *(u32x4*)(O + (size_t)row * D + u.pn * BM + bj * HALF + wc * 32 + 8 * fq) = pack8(acc[ai][bj][m][0], acc[ai][bj][m][1]);
            }
    }
};
}

namespace att {
constexpr int VSLOT = 8192;
template <int NDK, int MODE, int NSL> struct Lay {
    static constexpr int KSLOT = NDK * 2048, LDS_K = 0, LDS_V = NSL * KSLOT, LDS_WS = LDS_V + NSL * VSLOT, LDS_CB = LDS_WS + 8 * 256, LDS_OST = 0,
                         LDS_TOTAL = LDS_CB + (MODE == 1 ? 32768 : 0);
    static_assert(LDS_TOTAL <= RING_BYTES && 8 * 4096 <= LDS_WS, "attention LDS");
};
struct AU {
    const bf16_t* Q; const bf16_t* K; const bf16_t* V; bf16_t* O; float* lse; const float* colb;
    int qpitch, kpitch, vpitch, opitch, lpitch;
    unsigned char* O8; int o8pitch;
    int q0, kt0, kt1, span; float alibi, sink2, xthr;
    unsigned long long* stamp;
};
__device__ __forceinline__ int crow(int r, int hi) { return (r & 3) + 8 * (r >> 2) + 4 * hi; }
__device__ __forceinline__ void glds16(const void* gsrc, unsigned lds_dst) { unsigned keep;
    asm volatile("s_mov_b32 %0, m0\n\ts_mov_b32 m0, %2\n\ts_nop 0\n\tglobal_load_lds_dwordx4 %1, off\n\ts_mov_b32 m0, %0" : "=&s"(keep) : "v"(gsrc), "s"(lds_dst) : "memory"); }
__device__ __forceinline__ void glds16s(unsigned voff, const void* sbase, unsigned lds_dst) { unsigned keep;
    asm volatile("s_mov_b32 %0, m0\n\ts_mov_b32 m0, %3\n\ts_nop 0\n\tglobal_load_lds_dwordx4 %1, %2\n\ts_mov_b32 m0, %0" : "=&s"(keep) : "v"(voff), "s"(sbase), "s"(lds_dst) : "memory"); }
#define ATT_WAIT_BAR() asm volatile("s_waitcnt vmcnt(0) lgkmcnt(0)\n\ts_barrier" ::: "memory")
#define ATT_WAITV_BAR(N) asm volatile("s_waitcnt vmcnt(%0) lgkmcnt(0)\n\ts_barrier" :: "n"(N) : "memory")
__device__ __forceinline__ float permswap_max(float m) { auto rr = __builtin_amdgcn_permlane32_swap(__float_as_uint(m), __float_as_uint(m), false, false); return fmaxf(__uint_as_float(rr[0]), __uint_as_float(rr[1])); }
__device__ __forceinline__ float permswap_sum(float m) { auto rr = __builtin_amdgcn_permlane32_swap(__float_as_uint(m), __float_as_uint(m), false, false); return __uint_as_float(rr[0]) + __uint_as_float(rr[1]); }

#if STAMP_MODE
__device__ __forceinline__ unsigned long long stamp_now() { unsigned long long t; asm volatile("s_memtime %0\n\ts_waitcnt lgkmcnt(0)" : "=s"(t) :: "memory"); return t; }
#endif
#define ATT_PIN() __builtin_amdgcn_sched_barrier(0)
#define KHOFF(d0) (((d0) < 4) ? 4096 : 2048)
#define KA(d0) (((d0) < 4) ? (ka[0] ^ (unsigned)((d0) << 5)) : (ka[1] ^ (unsigned)(((d0) - 4) << 5)))
template <int NDK>
__device__ __forceinline__ void k_issue(bf16x8 (&kf)[2 * NDK], const LAS unsigned char* kslot, const unsigned (&ka)[2]) {
#pragma unroll
    for (int d0 = 0; d0 < NDK; ++d0) { kf[2 * d0] = *(const LAS bf16x8*)(kslot + KA(d0)); kf[2 * d0 + 1] = *(const LAS bf16x8*)(kslot + KA(d0) + KHOFF(d0)); }
}
template <int NDK>
__device__ __forceinline__ void qk_mma_c(f32x16& p0, f32x16& p1, const bf16x8 (&kf)[2 * NDK], const bf16x8 (&qr)[NDK], const f32x16& cin) {
    p0 = __builtin_amdgcn_mfma_f32_32x32x16_bf16(kf[0], qr[0], cin, 0, 0, 0);
    p1 = __builtin_amdgcn_mfma_f32_32x32x16_bf16(kf[1], qr[0], cin, 0, 0, 0);
#pragma unroll
    for (int d0 = 1; d0 < NDK; ++d0) {
        p0 = __builtin_amdgcn_mfma_f32_32x32x16_bf16(kf[2 * d0], qr[d0], p0, 0, 0, 0);
        p1 = __builtin_amdgcn_mfma_f32_32x32x16_bf16(kf[2 * d0 + 1], qr[d0], p1, 0, 0, 0);
    }
}
template <int NDK>
__device__ __forceinline__ void qk_mma(f32x16& p0, f32x16& p1, const bf16x8 (&kf)[2 * NDK], const bf16x8 (&qr)[NDK]) {
    p0 = (f32x16){}; p1 = (f32x16){};
#pragma unroll
    for (int d0 = 0; d0 < NDK; ++d0) {
        p0 = __builtin_amdgcn_mfma_f32_32x32x16_bf16(kf[2 * d0], qr[d0], p0, 0, 0, 0);
        p1 = __builtin_amdgcn_mfma_f32_32x32x16_bf16(kf[2 * d0 + 1], qr[d0], p1, 0, 0, 0);
    }
}
__device__ __forceinline__ void v_issue(s16x4 (&vlo)[8], s16x4 (&vhi)[8], const LAS unsigned char* vp) {
#pragma unroll
    for (int i = 0; i < 8; ++i) {
        vlo[i] = __builtin_bit_cast(s16x4, __builtin_amdgcn_ds_read_tr16_b64_v4i16((LAS s16x4*)(vp + (i >> 2) * 4096 + (i & 3) * 1024)));
        vhi[i] = __builtin_bit_cast(s16x4, __builtin_amdgcn_ds_read_tr16_b64_v4i16((LAS s16x4*)(vp + (i >> 2) * 4096 + (i & 3) * 1024 + 512)));
    }
}
__device__ __forceinline__ void pv_mma(f32x16& o0, f32x16& o1, f32x16& lacc, const s16x4 (&vlo)[8], const s16x4 (&vhi)[8], const u32x4 pw0, const u32x4 pw1, const u32x4 pw2, const u32x4 pw3) {
    const bf16x8 ones = {0x3F80, 0x3F80, 0x3F80, 0x3F80, 0x3F80, 0x3F80, 0x3F80, 0x3F80};
#define ATT_VF(i) (bf16x8){vlo[i][0], vlo[i][1], vlo[i][2], vlo[i][3], vhi[i][0], vhi[i][1], vhi[i][2], vhi[i][3]}
    o0 = __builtin_amdgcn_mfma_f32_32x32x16_bf16(__builtin_bit_cast(bf16x8, pw0), ATT_VF(0), o0, 0, 0, 0);
    o1 = __builtin_amdgcn_mfma_f32_32x32x16_bf16(__builtin_bit_cast(bf16x8, pw0), ATT_VF(4), o1, 0, 0, 0);
    lacc = __builtin_amdgcn_mfma_f32_32x32x16_bf16(__builtin_bit_cast(bf16x8, pw0), ones, lacc, 0, 0, 0);
    o0 = __builtin_amdgcn_mfma_f32_32x32x16_bf16(__builtin_bit_cast(bf16x8, pw1), ATT_VF(1), o0, 0, 0, 0);
    o1 = __builtin_amdgcn_mfma_f32_32x32x16_bf16(__builtin_bit_cast(bf16x8, pw1), ATT_VF(5), o1, 0, 0, 0);
    lacc = __builtin_amdgcn_mfma_f32_32x32x16_bf16(__builtin_bit_cast(bf16x8, pw1), ones, lacc, 0, 0, 0);
    o0 = __builtin_amdgcn_mfma_f32_32x32x16_bf16(__builtin_bit_cast(bf16x8, pw2), ATT_VF(2), o0, 0, 0, 0);
    o1 = __builtin_amdgcn_mfma_f32_32x32x16_bf16(__builtin_bit_cast(bf16x8, pw2), ATT_VF(6), o1, 0, 0, 0);
    lacc = __builtin_amdgcn_mfma_f32_32x32x16_bf16(__builtin_bit_cast(bf16x8, pw2), ones, lacc, 0, 0, 0);
    o0 = __builtin_amdgcn_mfma_f32_32x32x16_bf16(__builtin_bit_cast(bf16x8, pw3), ATT_VF(3), o0, 0, 0, 0);
    o1 = __builtin_amdgcn_mfma_f32_32x32x16_bf16(__builtin_bit_cast(bf16x8, pw3), ATT_VF(7), o1, 0, 0, 0);
    lacc = __builtin_amdgcn_mfma_f32_32x32x16_bf16(__builtin_bit_cast(bf16x8, pw3), ones, lacc, 0, 0, 0);
#undef ATT_VF
}
__device__ __forceinline__ void v_issue8(u32x4 (&vf)[4], const LAS unsigned char* vp, int o0_, int o1_) {
    vf[0] = *(const LAS u32x4*)(vp + o0_); vf[1] = *(const LAS u32x4*)(vp + o1_); vf[2] = *(const LAS u32x4*)(vp + 2048 + o0_); vf[3] = *(const LAS u32x4*)(vp + 2048 + o1_);
}
__device__ __forceinline__ void pv_mma8(f32x16& o0, f32x16& o1, f32x16& lacc, const u32x4 (&vf)[4], const u32x4 pw0, const u32x4 pw1) {
    const i32x8 P = {(int)pw0.x, (int)pw0.y, (int)pw0.z, (int)pw0.w, (int)pw1.x, (int)pw1.y, (int)pw1.z, (int)pw1.w};
    const i32x8 V0 = {(int)vf[0].x, (int)vf[0].y, (int)vf[0].z, (int)vf[0].w, (int)vf[1].x, (int)vf[1].y, (int)vf[1].z, (int)vf[1].w};
    const i32x8 V1 = {(int)vf[2].x, (int)vf[2].y, (int)vf[2].z, (int)vf[2].w, (int)vf[3].x, (int)vf[3].y, (int)vf[3].z, (int)vf[3].w};
    const i32x8 ones = {0x38383838, 0x38383838, 0x38383838, 0x38383838, 0x38383838, 0x38383838, 0x38383838, 0x38383838};
    asm volatile("s_nop 1\n\tv_mfma_f32_32x32x64_f8f6f4 %0, %1, %2, %0" : "+v"(o0) : "v"(P), "v"(V0));
    asm volatile("v_mfma_f32_32x32x64_f8f6f4 %0, %1, %2, %0" : "+v"(o1) : "v"(P), "v"(V1));
    asm volatile("v_mfma_f32_32x32x64_f8f6f4 %0, %1, %2, %0" : "+v"(lacc) : "v"(P), "v"(ones));
}
__device__ __forceinline__ float max3f(float a, float b, float c) { float r; asm("v_max3_f32 %0, %1, %2, %3" : "=v"(r) : "v"(a), "v"(b), "v"(c)); return r; }

template <int I>
__device__ __forceinline__ void gap_a(f32x16& C0, f32x16& C1, bf16x8 (&kw)[3], const LAS unsigned char* kp, const unsigned (&ka)[2], const bf16x8 (&qr)[6],
                                      const f32x16& P0, const f32x16& P1, u32x4 (&pw)[4], s16x4 (&vlo)[8], s16x4 (&vhi)[8], const LAS unsigned char* vp) {
    const f32x16 zero = {};
    if (I & 1) C1 = __builtin_amdgcn_mfma_f32_32x32x16_bf16(kw[I % 3], qr[I >> 1], (I < 2) ? zero : C1, 0, 0, 0);
    else       C0 = __builtin_amdgcn_mfma_f32_32x32x16_bf16(kw[I % 3], qr[I >> 1], (I < 2) ? zero : C0, 0, 0, 0);
    if (I + 2 < 12) kw[(I + 2) % 3] = *(const LAS bf16x8*)(kp + KA((I + 2) >> 1) + ((I + 2) & 1) * KHOFF((I + 2) >> 1));
    if (I < 8) {
        const f32x16& Ps = (I < 4) ? P0 : P1; constexpr int b = (I & 3) * 4;
        pw[I >> 1][2 * (I & 1)] = cvtpk(Ps[b], Ps[b + 1]); pw[I >> 1][2 * (I & 1) + 1] = cvtpk(Ps[b + 2], Ps[b + 3]);
        asm volatile("" : "+v"(pw[I >> 1]));
        vlo[I] = __builtin_bit_cast(s16x4, __builtin_amdgcn_ds_read_tr16_b64_v4i16((LAS s16x4*)(vp + (I >> 2) * 4096 + (I & 3) * 1024)));
        vhi[I] = __builtin_bit_cast(s16x4, __builtin_amdgcn_ds_read_tr16_b64_v4i16((LAS s16x4*)(vp + (I >> 2) * 4096 + (I & 3) * 1024 + 512)));
    }
    __builtin_amdgcn_sched_barrier(0);
}
template <int J>
__device__ __forceinline__ void gap_b(f32x16& o0, f32x16& o1, f32x16& lacc, const u32x4 (&pw)[4], const s16x4 (&vlo)[8], const s16x4 (&vhi)[8], f32x16& C0, f32x16& C1, float mn) {
    constexpr int g = J / 3, w = J % 3;
    const bf16x8 pa = __builtin_bit_cast(bf16x8, pw[g]);
    if (w == 0)      o0 = __builtin_amdgcn_mfma_f32_32x32x16_bf16(pa, (bf16x8){vlo[g][0], vlo[g][1], vlo[g][2], vlo[g][3], vhi[g][0], vhi[g][1], vhi[g][2], vhi[g][3]}, o0, 0, 0, 0);
    else if (w == 1) o1 = __builtin_amdgcn_mfma_f32_32x32x16_bf16(pa, (bf16x8){vlo[g + 4][0], vlo[g + 4][1], vlo[g + 4][2], vlo[g + 4][3], vhi[g + 4][0], vhi[g + 4][1], vhi[g + 4][2], vhi[g + 4][3]}, o1, 0, 0, 0);
    else             lacc = __builtin_amdgcn_mfma_f32_32x32x16_bf16(pa, (bf16x8){0x3F80, 0x3F80, 0x3F80, 0x3F80, 0x3F80, 0x3F80, 0x3F80, 0x3F80}, lacc, 0, 0, 0);
    constexpr int e0 = (J < 8) ? 3 * J : 24 + 2 * (J - 8), ne = (J < 8) ? 3 : 2;
#pragma unroll
    for (int e = e0; e < e0 + ne; ++e) { if (e < 16) C0[e] = __builtin_amdgcn_exp2f(C0[e] - mn); else C1[e - 16] = __builtin_amdgcn_exp2f(C1[e - 16] - mn); }
    if (e0 < 16) asm volatile("" : "+v"(C0)); if (e0 + ne > 16) asm volatile("" : "+v"(C1));
    __builtin_amdgcn_sched_barrier(0);
}

template <int NDK, int MODE, int NSL, bool F8V = false>
__device__ __forceinline__ void attn_unit(const AU& u, LAS unsigned char* shm) {
    typedef Lay<NDK, MODE, NSL> L; constexpr int KSLOT = L::KSLOT, LDS_K = L::LDS_K, LDS_V = L::LDS_V, LDS_WS = L::LDS_WS, LDS_CB = L::LDS_CB, LDS_OST = L::LDS_OST, DF = NSL - 2;
    int tid_l = threadIdx.x; asm volatile("" : "+v"(tid_l));
    const int tid = tid_l, lane = tid & 63, r32 = lane & 31, hi = lane >> 5; const int wid = __builtin_amdgcn_readfirstlane(tid >> 6);
    const unsigned lds0 = (unsigned)(uintptr_t)shm;
    LAS float* wsf = (LAS float*)(shm + LDS_WS) + wid * 64;
    LAS float* cb = (LAS float*)(shm + LDS_CB);
    const int q = u.q0 + wid * 32 + r32;
    const int qmin = u.q0 + wid * 32, qmax = qmin + 31;
    float cq = 0.f;
    int ukt0 = u.kt0;
    if (MODE == 1) {
        LAS int* red = (LAS int*)cb;
        if (tid == 0) *red = u.kt1 - 1;
        ATT_WAIT_BAR();
        const float thr = u.colb[u.q0] + u.xthr;
        for (int j = tid; j < u.kt1; j += 512) if (u.colb[64 * j + 63] <= thr) atomicMin((int*)red, j);
        ATT_WAIT_BAR();
        ukt0 = __builtin_amdgcn_readfirstlane(*red);
        ATT_WAIT_BAR();
        const int nk = (u.kt1 - ukt0) * 64;
        for (int i = tid; i < nk; i += 512) cb[i] = u.colb[ukt0 * 64 + i];
        cq = u.colb[q];
    }
    bf16x8 qr[NDK];
    { const bf16_t* qp = u.Q + (size_t)q * u.qpitch + hi * 8;
#pragma unroll
      for (int d0 = 0; d0 < NDK; ++d0) qr[d0] = *(const bf16x8*)(qp + d0 * 16); }
    const unsigned dk_off = (unsigned)(8 * wid + (lane >> 3)) * (unsigned)u.kpitch * 2u + (unsigned)(((lane & 7) ^ (((8 * wid + (lane >> 3)) >> 1) & 7)) * 16);
    const unsigned dk_off2 = (unsigned)(16 * (wid & 3) + (lane >> 2)) * (unsigned)u.kpitch * 2u + 128u + (unsigned)(((lane & 3) ^ (((16 * (wid & 3) + (lane >> 2)) >> 2) & 3)) * 16);
    const unsigned dv_off = F8V ? (unsigned)(16 * (wid & 3) + (lane >> 2)) * (unsigned)u.vpitch + (unsigned)(((lane & 3) ^ (((16 * (wid & 3) + (lane >> 2)) >> 2) & 3)) * 16)
                              : (unsigned)(16 * (wid & 3) + (lane >> 2)) * (unsigned)u.vpitch * 2u + (unsigned)(wid >> 2) * 64u + (unsigned)(lane & 3) * 16u;
#define ATT_ISSUE(kt_, s_) do { \
        const char* kb_ = (const char*)u.K + (size_t)(kt_) * 64 * u.kpitch * 2; const char* vb_ = (const char*)u.V + (F8V ? (size_t)(kt_) * 64 : (size_t)(kt_) * 64 * u.vpitch * 2); \
        glds16s(dk_off, kb_, (unsigned)__builtin_amdgcn_readfirstlane(lds0 + LDS_K + (s_) * KSLOT + wid * 1024)); \
        if (NDK == 6) { if (wid < 4) glds16s(dk_off2, kb_, (unsigned)__builtin_amdgcn_readfirstlane(lds0 + LDS_K + (s_) * KSLOT + (wid + 8) * 1024)); } \
        if (!F8V || wid < 4) glds16s(dv_off, vb_, (unsigned)__builtin_amdgcn_readfirstlane(lds0 + LDS_V + (s_) * VSLOT + wid * 1024)); } while (0)
    float mrun = -3.0e38f;
    f32x16 o0 = {}, o1 = {}, lacc = {};
    const int nT = u.kt1 - ukt0;
    int whi = qmax >> 6; if (whi > u.kt1 - 1) whi = u.kt1 - 1;
    int wlo = ukt0; if (MODE == 2) { const int l_ = (qmin - u.span) >> 6; if (l_ > wlo) wlo = l_; }
    const int mask_from = qmin >> 6;
    u32x4 pw0, pw1, pw2, pw3;
#define ATT_SOFT(p0, p1, kt_) do { \
        const int kmin_ = (kt_) * 64; \
        if (MODE == 1) { \
            const LAS f32x4* cp_ = (const LAS f32x4*)(cb + ((kt_) - ukt0) * 64 + 4 * hi); \
            _Pragma("unroll") for (int j = 0; j < 4; ++j) { const f32x4 c0_ = cp_[2 * j], c1_ = cp_[2 * j + 8]; \
                _Pragma("unroll") for (int e = 0; e < 4; ++e) { p0[4 * j + e] += cq - c0_[e]; p1[4 * j + e] += cq - c1_[e]; } } \
        } \
        if (MODE == 2) { \
            _Pragma("unroll") for (int r = 0; r < 16; ++r) { const int d0_ = q - (kmin_ + crow(r, hi)), d1_ = d0_ - 32; \
                p0[r] = ((unsigned)d0_ <= (unsigned)u.span) ? p0[r] - u.alibi * (float)d0_ : -INFINITY; \
                p1[r] = ((unsigned)d1_ <= (unsigned)u.span) ? p1[r] - u.alibi * (float)d1_ : -INFINITY; } \
        } else if ((kt_) >= mask_from) { \
            _Pragma("unroll") for (int r = 0; r < 16; ++r) { const int kj_ = kmin_ + crow(r, hi); if (kj_ > q) p0[r] = -INFINITY; if (kj_ + 32 > q) p1[r] = -INFINITY; } \
        } \
        float ra_ = max3f(p0[0], p0[1], p1[0]), rb_ = max3f(p0[2], p0[3], p1[1]); ra_ = max3f(ra_, p1[2], p1[3]); \
        _Pragma("unroll") for (int r = 4; r < 16; r += 4) { ra_ = max3f(ra_, p0[r], p0[r + 1]); rb_ = max3f(rb_, p0[r + 2], p0[r + 3]); ra_ = max3f(ra_, p1[r], p1[r + 1]); rb_ = max3f(rb_, p1[r + 2], p1[r + 3]); } \
        float rm_ = max3f(ra_, rb_, mrun); \
        { auto rr_ = __builtin_amdgcn_permlane32_swap(__float_as_uint(rm_), __float_as_uint(rm_), false, false); rm_ = max3f(__uint_as_float(rr_[0]), __uint_as_float(rr_[1]), mrun); } \
        const bool grow_ = __any(rm_ > mrun + 8.0f);                        \
        const float mn_ = grow_ ? rm_ : mrun, alpha_ = __builtin_amdgcn_exp2f(mrun - mn_); \
        mrun = mn_; \
        _Pragma("unroll") for (int r = 0; r < 16; ++r) { p0[r] = __builtin_amdgcn_exp2f(p0[r] - mn_); p1[r] = __builtin_amdgcn_exp2f(p1[r] - mn_); } \
        if (!__all(alpha_ == 1.0f)) { \
            if (hi == 0) wsf[r32] = alpha_; \
            LDS_WAIT(); \
            _Pragma("unroll") for (int j = 0; j < 4; ++j) { const f32x4 f_ = *(const LAS f32x4*)(wsf + 8 * j + 4 * hi); \
                _Pragma("unroll") for (int e = 0; e < 4; ++e) { o0[4 * j + e] *= f_[e]; o1[4 * j + e] *= f_[e]; lacc[4 * j + e] *= f_[e]; } } \
        } \
        pw0 = (u32x4){cvtpk(p0[0], p0[1]), cvtpk(p0[2], p0[3]), cvtpk(p0[4], p0[5]), cvtpk(p0[6], p0[7])}; \
        pw1 = (u32x4){cvtpk(p0[8], p0[9]), cvtpk(p0[10], p0[11]), cvtpk(p0[12], p0[13]), cvtpk(p0[14], p0[15])}; \
        pw2 = (u32x4){cvtpk(p1[0], p1[1]), cvtpk(p1[2], p1[3]), cvtpk(p1[4], p1[5]), cvtpk(p1[6], p1[7])}; \
        pw3 = (u32x4){cvtpk(p1[8], p1[9]), cvtpk(p1[10], p1[11]), cvtpk(p1[12], p1[13]), cvtpk(p1[14], p1[15])}; \
    } while (0)
    f32x16 negm = {}; bool first = true;
#define ATT_THR 8.0f
#define ATT_SOFT_N(p0, p1, kt_) do { \
        const int kmin_ = (kt_) * 64; \
        if (MODE == 1) { \
            const LAS f32x4* cp_ = (const LAS f32x4*)(cb + ((kt_) - ukt0) * 64 + 4 * hi); \
            _Pragma("unroll") for (int j = 0; j < 4; ++j) { const f32x4 c0_ = cp_[2 * j], c1_ = cp_[2 * j + 8]; \
                _Pragma("unroll") for (int e = 0; e < 4; ++e) { p0[4 * j + e] += cq - c0_[e]; p1[4 * j + e] += cq - c1_[e]; } } \
        } \
        if ((kt_) >= mask_from) { \
            _Pragma("unroll") for (int r = 0; r < 16; ++r) { const int kj_ = kmin_ + crow(r, hi); if (kj_ > q) p0[r] = -INFINITY; if (kj_ + 32 > q) p1[r] = -INFINITY; } \
        } \
        float ra_ = max3f(p0[0], p0[1], p1[0]), rb_ = max3f(p0[2], p0[3], p1[1]); ra_ = max3f(ra_, p1[2], p1[3]); \
        _Pragma("unroll") for (int r = 4; r < 16; r += 4) { ra_ = max3f(ra_, p0[r], p0[r + 1]); rb_ = max3f(rb_, p0[r + 2], p0[r + 3]); ra_ = max3f(ra_, p1[r], p1[r + 1]); rb_ = max3f(rb_, p1[r + 2], p1[r + 3]); } \
        float rm_ = fmaxf(ra_, rb_); \
        { auto rr_ = __builtin_amdgcn_permlane32_swap(__float_as_uint(rm_), __float_as_uint(rm_), false, false); rm_ = fmaxf(__uint_as_float(rr_[0]), __uint_as_float(rr_[1])); } \
        const float dl_ = first ? rm_ : fmaxf(rm_, 0.f);                   \
        if (first || __any(rm_ > ATT_THR)) {                                \
            mrun = first ? dl_ : mrun + dl_; \
            _Pragma("unroll") for (int r = 0; r < 16; ++r) { p0[r] -= dl_; p1[r] -= dl_; negm[r] = -mrun; } \
            if (!first) { \
                if (hi == 0) wsf[r32] = __builtin_amdgcn_exp2f(-dl_); \
                LDS_WAIT(); \
                _Pragma("unroll") for (int j = 0; j < 4; ++j) { const f32x4 f_ = *(const LAS f32x4*)(wsf + 8 * j + 4 * hi); \
                    _Pragma("unroll") for (int e = 0; e < 4; ++e) { o0[4 * j + e] *= f_[e]; o1[4 * j + e] *= f_[e]; lacc[4 * j + e] *= f_[e]; } } \
            } \
            first = false; \
        } \
        _Pragma("unroll") for (int r = 0; r < 16; ++r) { p0[r] = __builtin_amdgcn_exp2f(p0[r]); p1[r] = __builtin_amdgcn_exp2f(p1[r]); } \
        if constexpr (F8V) {        \
            _Pragma("unroll") for (int i_ = 0; i_ < 4; ++i_) { \
                int a_ = __builtin_amdgcn_cvt_pk_fp8_f32(p0[4 * i_], p0[4 * i_ + 1], 0, false); a_ = __builtin_amdgcn_cvt_pk_fp8_f32(p0[4 * i_ + 2], p0[4 * i_ + 3], a_, true); pw0[i_] = (unsigned)a_; \
                int b_ = __builtin_amdgcn_cvt_pk_fp8_f32(p1[4 * i_], p1[4 * i_ + 1], 0, false); b_ = __builtin_amdgcn_cvt_pk_fp8_f32(p1[4 * i_ + 2], p1[4 * i_ + 3], b_, true); pw1[i_] = (unsigned)b_; } \
        } else { \
        pw0 = (u32x4){cvtpk(p0[0], p0[1]), cvtpk(p0[2], p0[3]), cvtpk(p0[4], p0[5]), cvtpk(p0[6], p0[7])}; \
        pw1 = (u32x4){cvtpk(p0[8], p0[9]), cvtpk(p0[10], p0[11]), cvtpk(p0[12], p0[13]), cvtpk(p0[14], p0[15])}; \
        pw2 = (u32x4){cvtpk(p1[0], p1[1]), cvtpk(p1[2], p1[3]), cvtpk(p1[4], p1[5]), cvtpk(p1[6], p1[7])}; \
        pw3 = (u32x4){cvtpk(p1[8], p1[9]), cvtpk(p1[10], p1[11]), cvtpk(p1[12], p1[13]), cvtpk(p1[14], p1[15])}; } \
    } while (0)
#pragma unroll
    for (int j = 0; j < (MODE == 2 ? NSL : DF + 1); ++j) if (j < nT) ATT_ISSUE(ukt0 + j, j);
    const LAS unsigned char* kaddr0 = shm + LDS_K;
    const unsigned ka[2] = {(unsigned)(r32 * 128 + ((hi ^ ((r32 >> 1) & 7)) * 16)), (unsigned)(8192 + r32 * 64 + ((hi ^ ((r32 >> 2) & 3)) * 16))};
    const LAS unsigned char* vaddr0 = F8V ? shm + LDS_V + r32 * 64 : shm + LDS_V + ((lane >> 4) & 1) * 32 + (lane & 3) * 8 + (4 * hi + ((lane & 15) >> 2)) * 64;
    const int v8o0 = ((2 * hi) ^ ((r32 >> 2) & 3)) * 16, v8o1 = v8o0 ^ 16;
#define ATT_VIS(sc_) do { if constexpr (F8V) v_issue8(vf8, vaddr0 + (sc_) * VSLOT, v8o0, v8o1); else v_issue(vlo, vhi, vaddr0 + (sc_) * VSLOT); } while (0)
#define ATT_PV() do { if constexpr (F8V) pv_mma8(o0, o1, lacc, vf8, pw0, pw1); else pv_mma(o0, o1, lacc, vlo, vhi, pw0, pw1, pw2, pw3); } while (0)
#define ATT_LOOP(HB) do { \
    constexpr int PER = F8V ? ((HB) ? 1 : 3) : ((NDK == 6 && !(HB)) ? 3 : 2); \
    if (ukt0 + DF < u.kt1) ATT_WAITV_BAR((DF - 1) * PER); else ATT_WAIT_BAR(); \
    f32x16 p0 = {}, p1 = {}; bf16x8 kf[2 * NDK]; s16x4 vlo[8], vhi[8]; u32x4 vf8[4]; \
    if (wlo <= ukt0 && ukt0 <= whi) { k_issue<NDK>(kf, kaddr0, ka); if (HB) { qk_mma_c<NDK>(p0, p1, kf, qr, negm); } } \
    int sc = 0; bool pend = false;                   \
    for (int i = 0; i < nT; ++i) { \
        const int kt = ukt0 + i; \
        ATT_STAMP_PRE(); \
        if (i > 0) { if (kt + DF < u.kt1) ATT_WAITV_BAR((DF - 1) * PER); else ATT_WAIT_BAR(); } \
        ATT_STAMP_POST(); \
        const int sn = (sc + 1 == NSL) ? 0 : sc + 1; \
        if (kt + DF + 1 < u.kt1) { const int sf_ = (sc == 0) ? NSL - 1 : sc - 1; ATT_ISSUE(kt + DF + 1, sf_); } \
        const bool actc = (wlo <= kt) && (kt <= whi), actn = (kt + 1 < u.kt1) && (wlo <= kt + 1) && (kt + 1 <= whi); \
        if (!(HB)) {                                  \
            if (pend) { ATT_PV(); pend = false; } \
            if (actc) { \
                qk_mma_c<NDK>(p0, p1, kf, qr, negm); ATT_PIN(); \
                ATT_VIS(sc); ATT_PIN(); \
                ATT_SOFT_N(p0, p1, kt); \
                ATT_PIN(); \
                pend = true; \
            } \
            if (actn) { k_issue<NDK>(kf, kaddr0 + sn * KSLOT, ka); ATT_PIN(); } \
        } else {                                      \
            if (actc) { \
                ATT_VIS(sc); ATT_PIN(); \
                ATT_SOFT_N(p0, p1, kt); \
                ATT_PIN(); \
                if (actn) { k_issue<NDK>(kf, kaddr0 + sn * KSLOT, ka); ATT_PIN(); } \
                ATT_PV(); \
                if (actn) qk_mma_c<NDK>(p0, p1, kf, qr, negm); \
            } else if (actn) { k_issue<NDK>(kf, kaddr0 + sn * KSLOT, ka); qk_mma_c<NDK>(p0, p1, kf, qr, negm); } \
        } \
        sc = sn; \
    } \
    if (!(HB)) { if (pend) ATT_PV(); } \
    } while (0)
#if STAMP_MODE
    const bool stamper = (NDK == 6) && u.stamp && (wid == ((STAMP_MODE == 2) ? 4 : 0));
    unsigned long long st_wait = 0, st_t0 = 0, st_pre = 0; if (stamper) st_t0 = stamp_now();
#define ATT_STAMP_PRE() do { if (stamper) st_pre = stamp_now(); } while (0)
#define ATT_STAMP_POST() do { if (stamper) st_wait += stamp_now() - st_pre; } while (0)
#else
#define ATT_STAMP_PRE() do { } while (0)
#define ATT_STAMP_POST() do { } while (0)
#endif
#define ATT_IL_MID(C0, C1, kt_) do { \
        if ((kt_) >= mask_from) { const int kmin_ = (kt_) * 64; \
            _Pragma("unroll") for (int r = 0; r < 16; ++r) { const int kj_ = kmin_ + crow(r, hi); if (kj_ > q) C0[r] = -INFINITY; if (kj_ + 32 > q) C1[r] = -INFINITY; } } \
        float ra_ = max3f(C0[0], C0[1], C1[0]), rb_ = max3f(C0[2], C0[3], C1[1]); ra_ = max3f(ra_, C1[2], C1[3]); \
        _Pragma("unroll") for (int r = 4; r < 16; r += 4) { ra_ = max3f(ra_, C0[r], C0[r + 1]); rb_ = max3f(rb_, C0[r + 2], C0[r + 3]); ra_ = max3f(ra_, C1[r], C1[r + 1]); rb_ = max3f(rb_, C1[r + 2], C1[r + 3]); } \
        float rm_ = max3f(ra_, rb_, mrun); \
        { auto rr_ = __builtin_amdgcn_permlane32_swap(__float_as_uint(rm_), __float_as_uint(rm_), false, false); rm_ = max3f(__uint_as_float(rr_[0]), __uint_as_float(rr_[1]), mrun); } \
        alpha = __builtin_amdgcn_exp2f(mrun - rm_); mrun = rm_; \
        __builtin_amdgcn_sched_barrier(0); \
    } while (0)
#define ATT_IL_RESC() do { \
        if (!__all(alpha == 1.0f)) { \
            if (hi == 0) wsf[r32] = alpha; \
            LDS_WAIT(); \
            _Pragma("unroll") for (int j = 0; j < 4; ++j) { const f32x4 f_ = *(const LAS f32x4*)(wsf + 8 * j + 4 * hi); \
                _Pragma("unroll") for (int e = 0; e < 4; ++e) { o0[4 * j + e] *= f_[e]; o1[4 * j + e] *= f_[e]; lacc[4 * j + e] *= f_[e]; } } \
        } } while (0)
#define ATT_IL_WAIT(need_, PER) do { if ((need_) + (NSL - 3) <= last_iss) ATT_WAITV_BAR((NSL - 3) * PER); else ATT_WAIT_BAR(); } while (0)
#define ATT_IL_STEP(C0, C1, P0, P1, PER) do { \
        ATT_IL_WAIT(kt, PER); \
        if (last_iss + 1 < u.kt1) { ++last_iss; ATT_ISSUE(last_iss, (last_iss - ukt0) % NSL); } \
        const LAS unsigned char* kp_ = kaddr0 + ((kt - ukt0) % NSL) * KSLOT; const LAS unsigned char* vp_ = vaddr0 + ((kt - 1 - ukt0) % NSL) * VSLOT; \
        kw[0] = *(const LAS bf16x8*)(kp_ + KA(0)); kw[1] = *(const LAS bf16x8*)(kp_ + KA(0) + KHOFF(0)); __builtin_amdgcn_sched_barrier(0); \
        gap_a<0>(C0, C1, kw, kp_, ka, qr, P0, P1, pw, vlo, vhi, vp_); gap_a<1>(C0, C1, kw, kp_, ka, qr, P0, P1, pw, vlo, vhi, vp_); gap_a<2>(C0, C1, kw, kp_, ka, qr, P0, P1, pw, vlo, vhi, vp_); \
        gap_a<3>(C0, C1, kw, kp_, ka, qr, P0, P1, pw, vlo, vhi, vp_); gap_a<4>(C0, C1, kw, kp_, ka, qr, P0, P1, pw, vlo, vhi, vp_); gap_a<5>(C0, C1, kw, kp_, ka, qr, P0, P1, pw, vlo, vhi, vp_); \
        gap_a<6>(C0, C1, kw, kp_, ka, qr, P0, P1, pw, vlo, vhi, vp_); gap_a<7>(C0, C1, kw, kp_, ka, qr, P0, P1, pw, vlo, vhi, vp_); gap_a<8>(C0, C1, kw, kp_, ka, qr, P0, P1, pw, vlo, vhi, vp_); \
        gap_a<9>(C0, C1, kw, kp_, ka, qr, P0, P1, pw, vlo, vhi, vp_); gap_a<10>(C0, C1, kw, kp_, ka, qr, P0, P1, pw, vlo, vhi, vp_); gap_a<11>(C0, C1, kw, kp_, ka, qr, P0, P1, pw, vlo, vhi, vp_); \
        float alpha; ATT_IL_MID(C0, C1, kt); \
        gap_b<0>(o0, o1, lacc, pw, vlo, vhi, C0, C1, mrun); gap_b<1>(o0, o1, lacc, pw, vlo, vhi, C0, C1, mrun); gap_b<2>(o0, o1, lacc, pw, vlo, vhi, C0, C1, mrun); \
        gap_b<3>(o0, o1, lacc, pw, vlo, vhi, C0, C1, mrun); gap_b<4>(o0, o1, lacc, pw, vlo, vhi, C0, C1, mrun); gap_b<5>(o0, o1, lacc, pw, vlo, vhi, C0, C1, mrun); \
        gap_b<6>(o0, o1, lacc, pw, vlo, vhi, C0, C1, mrun); gap_b<7>(o0, o1, lacc, pw, vlo, vhi, C0, C1, mrun); gap_b<8>(o0, o1, lacc, pw, vlo, vhi, C0, C1, mrun); \
        gap_b<9>(o0, o1, lacc, pw, vlo, vhi, C0, C1, mrun); gap_b<10>(o0, o1, lacc, pw, vlo, vhi, C0, C1, mrun); gap_b<11>(o0, o1, lacc, pw, vlo, vhi, C0, C1, mrun); \
        ATT_IL_RESC(); \
    } while (0)
#define ATT_IL(PER) do { \
    int last_iss = ukt0 - 1; \
    _Pragma("unroll") for (int j = 0; j < NSL - 1; ++j) if (j < nT) { ATT_ISSUE(ukt0 + j, j); last_iss = ukt0 + j; } \
    f32x16 pA0, pA1, pB0, pB1; bf16x8 kw[3]; s16x4 vlo[8], vhi[8]; u32x4 pw[4]; \
    ATT_IL_WAIT(ukt0, PER); \
    { int kt = ukt0; { bf16x8 kf0_[2 * NDK]; k_issue<NDK>(kf0_, kaddr0, ka); qk_mma<NDK>(pA0, pA1, kf0_, qr); } float alpha; ATT_IL_MID(pA0, pA1, kt); (void)alpha; \
      _Pragma("unroll") for (int r = 0; r < 16; ++r) { pA0[r] = __builtin_amdgcn_exp2f(pA0[r] - mrun); pA1[r] = __builtin_amdgcn_exp2f(pA1[r] - mrun); } } \
    int kt = ukt0 + 1; \
    for (; kt + 1 < u.kt1; kt += 2) { ATT_IL_STEP(pB0, pB1, pA0, pA1, PER); ++kt; ATT_IL_STEP(pA0, pA1, pB0, pB1, PER); --kt; } \
    bool lastB = false; \
    if (kt < u.kt1) { ATT_IL_STEP(pB0, pB1, pA0, pA1, PER); ++kt; lastB = true; } \
      \
    { const LAS unsigned char* vp_ = vaddr0 + ((u.kt1 - 1 - ukt0) % NSL) * VSLOT; u32x4 q0_, q1_, q2_, q3_; \
      if (lastB) { q0_ = (u32x4){cvtpk(pB0[0], pB0[1]), cvtpk(pB0[2], pB0[3]), cvtpk(pB0[4], pB0[5]), cvtpk(pB0[6], pB0[7])}; q1_ = (u32x4){cvtpk(pB0[8], pB0[9]), cvtpk(pB0[10], pB0[11]), cvtpk(pB0[12], pB0[13]), cvtpk(pB0[14], pB0[15])}; \
                    q2_ = (u32x4){cvtpk(pB1[0], pB1[1]), cvtpk(pB1[2], pB1[3]), cvtpk(pB1[4], pB1[5]), cvtpk(pB1[6], pB1[7])}; q3_ = (u32x4){cvtpk(pB1[8], pB1[9]), cvtpk(pB1[10], pB1[11]), cvtpk(pB1[12], pB1[13]), cvtpk(pB1[14], pB1[15])}; } \
      else       { q0_ = (u32x4){cvtpk(pA0[0], pA0[1]), cvtpk(pA0[2], pA0[3]), cvtpk(pA0[4], pA0[5]), cvtpk(pA0[6], pA0[7])}; q1_ = (u32x4){cvtpk(pA0[8], pA0[9]), cvtpk(pA0[10], pA0[11]), cvtpk(pA0[12], pA0[13]), cvtpk(pA0[14], pA0[15])}; \
                    q2_ = (u32x4){cvtpk(pA1[0], pA1[1]), cvtpk(pA1[2], pA1[3]), cvtpk(pA1[4], pA1[5]), cvtpk(pA1[6], pA1[7])}; q3_ = (u32x4){cvtpk(pA1[8], pA1[9]), cvtpk(pA1[10], pA1[11]), cvtpk(pA1[12], pA1[13]), cvtpk(pA1[14], pA1[15])}; } \
      v_issue(vlo, vhi, vp_); pv_mma(o0, o1, lacc, vlo, vhi, q0_, q1_, q2_, q3_); } \
    } while (0)
    if constexpr (false && MODE == 0 && NDK == 6) { if (wid < 4) ATT_IL(3); else ATT_IL(2); }
    else if constexpr (MODE == 2) {
        ATT_WAIT_BAR();
        f32x16 p0 = {}, p1 = {}; bf16x8 kf[2 * NDK]; s16x4 vlo[8], vhi[8];
        const int t0 = wlo - ukt0, t1 = whi - ukt0;
        if (t0 <= t1) k_issue<NDK>(kf, kaddr0 + t0 * KSLOT, ka);
        if (wid >= 4) __builtin_amdgcn_s_setprio(1);
        for (int sc = t0; sc <= t1; ++sc) {
            const int kt = ukt0 + sc;
            qk_mma<NDK>(p0, p1, kf, qr); ATT_PIN();
            v_issue(vlo, vhi, vaddr0 + sc * VSLOT); ATT_PIN();
            ATT_SOFT(p0, p1, kt);
            ATT_PIN();
            if (sc < t1) { k_issue<NDK>(kf, kaddr0 + (sc + 1) * KSLOT, ka); ATT_PIN(); }
            pv_mma(o0, o1, lacc, vlo, vhi, pw0, pw1, pw2, pw3);
        }
        if (wid >= 4) __builtin_amdgcn_s_setprio(0);
    }
    else { if (wid < 4) ATT_LOOP(false); else { __builtin_amdgcn_s_setprio(1); ATT_LOOP(true); __builtin_amdgcn_s_setprio(0); } }
#undef ATT_IL
#undef ATT_IL_STEP
#undef ATT_IL_WAIT
#undef ATT_IL_RESC
#undef ATT_IL_MID
#if STAMP_MODE
    if (stamper && lane == 0) { u.stamp[0] += st_wait; u.stamp[1] += stamp_now() - st_t0; u.stamp[2] += (unsigned long long)nT; }
#endif
#undef ATT_LOOP
#undef ATT_VIS
#undef ATT_PV
    if constexpr (F8V) asm volatile("s_nop 15\n\ts_nop 15\n\ts_nop 15" ::: "memory");
    asm volatile("s_waitcnt lgkmcnt(0)\n\ts_barrier" ::: "memory");
    if (u.lse) {
        if ((lane & 31) == 0) {
#pragma unroll
            for (int j = 0; j < 4; ++j) *(LAS f32x4*)(wsf + 8 * j + 4 * hi) = (f32x4){lacc[4 * j], lacc[4 * j + 1], lacc[4 * j + 2], lacc[4 * j + 3]};
        }
        LDS_WAIT();
        const float lrow = wsf[r32];
        if (hi == 0) u.lse[(size_t)q * u.lpitch] = mrun + __builtin_amdgcn_logf(lrow);
    }
    float rli[16];
    if (MODE == 2) {
        LDS_WAIT();
        if (hi == 0) wsf[32 + r32] = __builtin_amdgcn_exp2f(u.sink2 - mrun);
        LDS_WAIT();
#pragma unroll
        for (int j = 0; j < 4; ++j) { const f32x4 f = *(const LAS f32x4*)(wsf + 32 + 8 * j + 4 * hi);
#pragma unroll
            for (int e = 0; e < 4; ++e) rli[4 * j + e] = __builtin_amdgcn_rcpf(lacc[4 * j + e] + f[e]); }
    } else {
#pragma unroll
        for (int r = 0; r < 16; ++r) rli[r] = __builtin_amdgcn_rcpf(lacc[r]) * (F8V ? 1.0f / F8_SV : 1.0f);
    }
    { LAS bf16_t* stg = (LAS bf16_t*)(shm + LDS_OST) + wid * 2048;
#pragma unroll
      for (int r = 0; r < 16; ++r) { const int orow = crow(r, hi);
          stg[orow * 64 + r32] = (bf16_t)(cvtpk(o0[r] * rli[r], 0.f) & 0xffffu);
          stg[orow * 64 + 32 + r32] = (bf16_t)(cvtpk(o1[r] * rli[r], 0.f) & 0xffffu); }
      LDS_WAIT();
      bf16_t* Ow = u.O + (size_t)(u.q0 + wid * 32) * u.opitch;
#pragma unroll
      for (int i = 0; i < 4; ++i) { const int row = i * 8 + (lane >> 3), ch = lane & 7; const u32x4 v = *(const LAS u32x4*)(stg + row * 64 + ch * 8);
          if (u.O8) { u32x2 w8;
              w8.x = cvt4_fp8(__uint_as_float(v.x << 16) * F8_SM, __uint_as_float(v.x & 0xffff0000u) * F8_SM, __uint_as_float(v.y << 16) * F8_SM, __uint_as_float(v.y & 0xffff0000u) * F8_SM);
              w8.y = cvt4_fp8(__uint_as_float(v.z << 16) * F8_SM, __uint_as_float(v.z & 0xffff0000u) * F8_SM, __uint_as_float(v.w << 16) * F8_SM, __uint_as_float(v.w & 0xffff0000u) * F8_SM);
              *(u32x2*)(u.O8 + (size_t)(u.q0 + wid * 32 + row) * u.o8pitch + ch * 8) = w8; }
          else *(u32x4*)(Ow + (size_t)row * u.opitch + ch * 8) = v; } }
    ATT_WAIT_BAR();
#undef ATT_ISSUE
#undef ATT_SOFT
}
}

#define XB_TMO      128
#define XB_XCNT(j)  (256  + 64 * (j))
#define XB_XSUB(j)  (1280 + 64 * (j))
#define XB_XGEN(j)  (2304 + 64 * (j))
#define XB_TOP      3328
#define XB_TOPGEN   3392
#define XCD_BAR_WORDS 3456
#define XB_SPIN_CAP (1u << 18)
__device__ __forceinline__ unsigned xb_ld(unsigned* p)              { return __hip_atomic_load(p, __ATOMIC_RELAXED, __HIP_MEMORY_SCOPE_AGENT); }
__device__ __forceinline__ unsigned xb_add(unsigned* p, unsigned v) { return __hip_atomic_fetch_add(p, v, __ATOMIC_RELAXED, __HIP_MEMORY_SCOPE_AGENT); }
__device__ __forceinline__ unsigned xb_xcc_id() { return (unsigned)__builtin_amdgcn_s_getreg((3 << 11) | 20) & 0xFu; }
#define XB_SPIN(cond, bar) do { unsigned _sp = 0; while (cond) { __builtin_amdgcn_s_sleep(1); \
    if ((++_sp & 255u) == 0u) { if (xb_ld(&(bar)[XB_TMO])) break; if (_sp > XB_SPIN_CAP) { atomicAdd(&(bar)[XB_TMO], 1u); break; } } } } while (0)
struct XcdBarrier { unsigned* bar; unsigned x; volatile LAS unsigned* st; };
__device__ __forceinline__ XcdBarrier xcd_barrier_post(unsigned* bar, volatile LAS unsigned* st) {
    XcdBarrier b; b.bar = bar; b.x = xb_xcc_id(); b.st = st;
    if (threadIdx.x == 0) (void)xb_add(&bar[XB_XCNT(b.x)], 1u);
    return b;
}
__device__ __forceinline__ void xcd_barrier_complete(unsigned* bar, unsigned x, unsigned& nloc, unsigned& nx) {
    const unsigned G = gridDim.x * gridDim.y * gridDim.z;
    unsigned sum, cnt, mine, sp = 0u;
    for (;;) {
        sum = 0u; cnt = 0u; mine = 0u;
#pragma unroll
        for (unsigned j = 0; j < 16; ++j) { const unsigned c = xb_ld(&bar[XB_XCNT(j)]); sum += c; cnt += (c > 0u) ? 1u : 0u; mine = (j == x) ? c : mine; }
        if (sum == G) break;
        __builtin_amdgcn_s_sleep(1);
        if ((++sp & 255u) == 0u) { if (xb_ld(&bar[XB_TMO])) break; if (sp > XB_SPIN_CAP) { atomicAdd(&bar[XB_TMO], 1u); break; } }
    }
    nloc = mine > 0u ? mine : 1u; nx = cnt > 0u ? cnt : 1u;
}
__device__ __forceinline__ void xcd_barrier(const XcdBarrier& b) {
    asm volatile("s_waitcnt vmcnt(0)" ::: "memory");
    __syncthreads();
    if (threadIdx.x == 0) {
        unsigned* bar = b.bar;
        __builtin_amdgcn_s_waitcnt(0);
        unsigned nloc = b.st[0], nx = b.st[1];
        if (nloc == 0u) { xcd_barrier_complete(bar, b.x, nloc, nx); b.st[0] = nloc; b.st[1] = nx; }
        const unsigned old = xb_add(&bar[XB_XSUB(b.x)], 1u);
        const unsigned gen = old / nloc;
        if (old + 1u == (gen + 1u) * nloc) {
            __builtin_amdgcn_fence(__ATOMIC_RELEASE, "agent");
            asm volatile("s_waitcnt vmcnt(0)" ::: "memory");
            const unsigned og = xb_add(&bar[XB_TOP], 1u);
            const unsigned tg = og / nx;
            if (og + 1u == (tg + 1u) * nx) xb_add(&bar[XB_TOPGEN], 1u);
            else XB_SPIN(xb_ld(&bar[XB_TOPGEN]) == tg, bar);
            __builtin_amdgcn_fence(__ATOMIC_ACQUIRE, "agent");
            xb_add(&bar[XB_XGEN(b.x)], 1u);
            asm volatile("s_waitcnt vmcnt(0)" ::: "memory");
        } else {
            XB_SPIN(xb_ld(&bar[XB_XGEN(b.x)]) == gen, bar);
            __builtin_amdgcn_fence(__ATOMIC_ACQUIRE, "agent");
            asm volatile("s_waitcnt vmcnt(0)" ::: "memory");
        }
    }
    __syncthreads();
}

struct Args {
    const float* x; const int* pos; const float* attn_norm; const float* w_in; const float* b_forget; const float* mla_q_norm; const float* w_q_up;
    const float* mla_kv_norm; const float* w_kv_up; const float* sinks; const float* w_out; const float* ffn_norm; const float* dense_w_gate; const float* dense_w_up;
    const float* dense_w_down; const float* router; const float* moe_w_gate; const float* moe_w_up; const float* moe_w_down; const float* final_norm;
    float* out; unsigned char* ws; int ph_lo, ph_hi;
};
struct Frame {
    LAS unsigned char* lds; int tid, lane, wave, G, c;
};

__device__ __forceinline__ int rope_perm(int j) { const int i = j & 15, t2 = j >> 4; return 8 * (i >> 2) + 4 * t2 + (i & 3); }
__device__ __forceinline__ int map_col(int kind, int n, float& sc) {
    sc = 1.0f;
    if (kind == 0) return n;
    if (kind == 1) {
        if (n < 256) { sc = C2_64; return Y_FQ + n; }
        if (n < 512) return Y_FK + (n - 256);
        if (n < 768) return Y_FV + (n - 512);
        if (n < 772) return Y_FF + (n - 768);
        if (n < 1028) { sc = C2_64; return Y_SQ + (n - 772); }
        if (n < 1156) return Y_SK + (n - 1028);
        if (n < 1284) return Y_SV + (n - 1156);
        if (n < 1540) return Y_CQ + (n - 1284);
        if (n < 1668) return Y_CKV + (n - 1540);
        if (n < 1700) return Y_KR + rope_perm(n - 1668);
        if (n < 1956) { sc = C2_64; return Y_DQ + (n - 1700); }
        if (n < 2212) return Y_DK + (n - 1956);
        if (n < 2468) return Y_DV + (n - 2212);
        return -1;
    }
    if (kind == 2) { sc = C2_96; const int h = n / 96, c = n % 96; return h * 96 + (c < 64 ? c : 64 + rope_perm(c - 64)); }
    if (kind == 3) return 256 * (n >> 7) + (n & 127);
    return 256 * (n >> 7) + 128 + (n & 127);
}
__device__ __forceinline__ void transpose_item(const float* W, int K, int N, bf16_t* WT, const float* gain, int kind, LAS float* scr, int item, int lane, unsigned tilemask = 0xffffffffu) {
    (void)scr;
    const int nblk = (N + 31) / 32, kblk = item / nblk, nb = item % nblk, kb = lane >> 3, ng = lane & 7;
    const int k0 = 64 * kblk + 8 * kb, n0 = 32 * nb + 4 * ng;
    if (n0 >= N) return;
    if (tilemask != 0xffffffffu) { bool any = false;
#pragma unroll
        for (int j = 0; j < 4; ++j) { float sc_; const int dr_ = map_col(kind, n0 + j, sc_); any = any || (dr_ >= 0 && ((tilemask >> (dr_ >> 8)) & 1u)); }
        if (!any) return; }
    const float* src = W + (size_t)k0 * N + n0;
    f32x4 v[8];
#pragma unroll
    for (int e = 0; e < 8; ++e) v[e] = __builtin_nontemporal_load((const f32x4*)(src + (size_t)e * N));
    f32x4 g0 = {1.f, 1.f, 1.f, 1.f}, g1 = {1.f, 1.f, 1.f, 1.f};
    if (gain) { g0 = *(const f32x4*)(gain + k0); g1 = *(const f32x4*)(gain + k0 + 4); }
#pragma unroll
    for (int j = 0; j < 4; ++j) {
        float sc; const int dr = map_col(kind, n0 + j, sc);
        if (dr >= 0 && ((tilemask >> (dr >> 8)) & 1u)) {
            u32x4 o;
            o.x = cvtpk(v[0][j] * g0[0] * sc, v[1][j] * g0[1] * sc); o.y = cvtpk(v[2][j] * g0[2] * sc, v[3][j] * g0[3] * sc);
            o.z = cvtpk(v[4][j] * g1[0] * sc, v[5][j] * g1[1] * sc); o.w = cvtpk(v[6][j] * g1[2] * sc, v[7][j] * g1[3] * sc);
            *(u32x4*)(WT + (size_t)dr * K + k0) = o;
        }
    }
}
__device__ __forceinline__ void transpose_item8(const float* W, int K, int N, unsigned char* WT, const float* gain, int kind, int item, int lane, unsigned tilemask = 0xffffffffu) {
    const int nblk = (N + 31) / 32, kblk = item / nblk, nb = item % nblk, kb = lane >> 3, ng = lane & 7;
    const int k0 = 128 * kblk + 16 * kb, n0 = 32 * nb + 4 * ng;
    if (n0 >= N) return;
    if (tilemask != 0xffffffffu) { bool any = false;
#pragma unroll
        for (int j = 0; j < 4; ++j) { float sc_; const int dr_ = map_col(kind, n0 + j, sc_); any = any || (dr_ >= 0 && ((tilemask >> (dr_ >> 8)) & 1u)); }
        if (!any) return; }
    const float* src = W + (size_t)k0 * N + n0;
    f32x4 v[16];
#pragma unroll
    for (int e = 0; e < 16; ++e) v[e] = __builtin_nontemporal_load((const f32x4*)(src + (size_t)e * N));
    f32x4 g[4];
#pragma unroll
    for (int i = 0; i < 4; ++i) g[i] = gain ? *(const f32x4*)(gain + k0 + 4 * i) : (f32x4){1.f, 1.f, 1.f, 1.f};
#pragma unroll
    for (int j = 0; j < 4; ++j) {
        float sc; const int dr = map_col(kind, n0 + j, sc); sc *= F8_SW;
        if (dr >= 0 && ((tilemask >> (dr >> 8)) & 1u)) {
            u32x4 o;
#pragma unroll
            for (int i = 0; i < 4; ++i) o[i] = cvt4_fp8(v[4 * i][j] * g[i][0] * sc, v[4 * i + 1][j] * g[i][1] * sc, v[4 * i + 2][j] * g[i][2] * sc, v[4 * i + 3][j] * g[i][3] * sc);
            *(u32x4*)(WT + (size_t)dr * K + k0) = o;
        }
    }
}
__device__ __forceinline__ void transpose_pair8(const float* W, int K, int N, unsigned char* WT, const float* gain, int kind, int item, int lane) {
    const int nblk = N / 32, kblk = item / nblk, nb = item % nblk, kb = lane >> 3, ng = lane & 7;
    const int k0 = 128 * kblk + 16 * kb, n0 = 32 * nb + 4 * ng;
    const float* src = W + (size_t)k0 * N + n0;
    f32x4 v[2][16];
#pragma unroll
    for (int e = 0; e < 16; ++e) { v[0][e] = __builtin_nontemporal_load((const f32x4*)(src + (size_t)e * N)); v[1][e] = __builtin_nontemporal_load((const f32x4*)(src + (size_t)e * N + 32)); }
    f32x4 g[4];
#pragma unroll
    for (int i = 0; i < 4; ++i) g[i] = gain ? *(const f32x4*)(gain + k0 + 4 * i) : (f32x4){1.f, 1.f, 1.f, 1.f};
#pragma unroll
    for (int q = 0; q < 2; ++q)
#pragma unroll
        for (int j = 0; j < 4; ++j) {
            float sc; const int dr = map_col(kind, n0 + 32 * q + j, sc); sc *= F8_SW;
            u32x4 o;
#pragma unroll
            for (int i = 0; i < 4; ++i) o[i] = cvt4_fp8(v[q][4 * i][j] * g[i][0] * sc, v[q][4 * i + 1][j] * g[i][1] * sc, v[q][4 * i + 2][j] * g[i][2] * sc, v[q][4 * i + 3][j] * g[i][3] * sc);
            *(u32x4*)(WT + (size_t)dr * K + k0) = o;
        }
}
__device__ __forceinline__ void transpose_item6(const float* W, int K, int N, unsigned char* WT6, const float* gain, int kind, int item, int lane) {
    const int nblk = N / 32, kblk = item / nblk, nb = item % nblk, kb = lane >> 3, ng = lane & 7;
    const int k0 = 256 * kblk + 32 * kb, n0 = 32 * nb + 4 * ng, pitch = K / 128 * 96;
    const float* src = W + (size_t)k0 * N + n0;
    f32x4 v[32];
#pragma unroll
    for (int e = 0; e < 32; ++e) v[e] = __builtin_nontemporal_load((const f32x4*)(src + (size_t)e * N));
    f32x4 g[8];
#pragma unroll
    for (int i = 0; i < 8; ++i) g[i] = gain ? *(const f32x4*)(gain + k0 + 4 * i) : (f32x4){1.f, 1.f, 1.f, 1.f};
#pragma unroll
    for (int j = 0; j < 4; ++j) {
        float sc; const int dr = map_col(kind, n0 + j, sc); sc *= F6_SW;
        float t[32];
#pragma unroll
        for (int e = 0; e < 32; ++e) t[e] = v[e][j] * g[e >> 2][e & 3] * sc;
        const i32x6 pk = pack32_fp6(t);
        size_t oP, oQ; fp6_tiled_offset(dr, k0 >> 5, K / 128, true, oP, oQ); (void)pitch;
        *(u32x4*)(WT6 + oP) = (u32x4){(unsigned)pk[0], (unsigned)pk[1], (unsigned)pk[2], (unsigned)pk[3]};
        *(u32x2*)(WT6 + oQ) = (u32x2){(unsigned)pk[4], (unsigned)pk[5]};
    }
}
__device__ __forceinline__ void sincos_acc(double a, float& s, float& c) {
    const double n = rint(a * 0.63661977236758134308);
    double r = fma(-n, 1.5707963267948966192, a); r = fma(-n, 6.123233995736766e-17, r);
    const int qd = (int)((long long)n & 3);
    const float x = (float)r, x2 = x * x;
    const float sp = x + x * x2 * (-1.6666667163e-1f + x2 * (8.3333337680e-3f + x2 * (-1.9841270114e-4f + x2 * 2.7557314297e-6f)));
    const float cp = 1.0f + x2 * (-0.5f + x2 * (4.1666667908e-2f + x2 * (-1.3888889225e-3f + x2 * 2.4801587642e-5f)));
    s = (qd == 0) ? sp : (qd == 1) ? cp : (qd == 2) ? -sp : -cp;
    c = (qd == 0) ? cp : (qd == 1) ? -sp : (qd == 2) ? -cp : sp;
}

constexpr int NPH = 17;
typedef __attribute__((address_space(4))) const Args* ArgsP;
__device__ __forceinline__ ArgsP get_args() { ArgsP p = (ArgsP)__builtin_amdgcn_kernarg_segment_ptr(); asm volatile("" : "+s"(p)); return p; }
#define WSP(T_, off) ((T_*)(ws + (off)))

#if MK_ONE_LAUNCH
#define GRID_BAR() do { bar.bar = (unsigned*)(get_args()->ws + WS_CTL) + CW_BAR; xcd_barrier(bar); } while (0)
#else
#define GRID_BAR() do { } while (0)
#endif
#ifndef PHMASK
#define PHMASK 0x1ffff
#endif
#define IN(k) ((((PHMASK) >> (k)) & 1) && lo <= (k) && (k) < hi)
#define SEAM(k) do { if (IN(k) && IN((k) + 1)) GRID_BAR(); } while (0)
#if PROBE_REP >= 0
#define PH_BEGIN(k) if (IN(k)) for (int rep_ = 0; rep_ < (((k) == PROBE_REP) ? 2 : 1); ++rep_) { if (rep_) GRID_BAR();
#define PH_END }
#else
#define PH_BEGIN(k) if (IN(k)) {
#define PH_END }
#endif
#ifndef P2MASK
#define P2MASK 15
#endif

constexpr int NCV0 = 896 + 168, NCV1 = 448;
template <int l>
__device__ __forceinline__ void moe_convert_unit(int cvi, int wave, int lane) {
    ArgsP a = get_args(); unsigned char* ws = a->ws;
    if (l == 0 && cvi >= 896) {
#pragma unroll 1
        for (int j = 0; j < 4; ++j) { const int it = (cvi - 896) * 32 + wave * 4 + j;
            if (it < 1792) transpose_item(a->dense_w_gate, D, FF, WSP(bf16_t, WS_WGU0), a->ffn_norm, 3, nullptr, it, lane);
            else if (it < 3584) transpose_item(a->dense_w_up, D, FF, WSP(bf16_t, WS_WGU0), a->ffn_norm, 4, nullptr, it - 1792, lane);
            else transpose_item(a->dense_w_down, FF, D, WSP(bf16_t, WS_WD0), nullptr, 0, nullptr, it - 3584, lane); }
        return;
    }
    const int pr = cvi * 8 + wave, mat = pr / 448, item = (pr % 448) * 2;
    if (l == 0) { const int e = mat >> 1, up = mat & 1;
        if (UPM_FP6) transpose_item6((up ? a->moe_w_up : a->moe_w_gate) + (size_t)e * D * FF, D, FF, WSP(unsigned char, WS_WGU1) + (size_t)e * 2 * FF * 768, a->ffn_norm + D, up ? 4 : 3, pr % 448, lane);
        else transpose_pair8((up ? a->moe_w_up : a->moe_w_gate) + (size_t)e * D * FF, D, FF, WSP(unsigned char, WS_WGU1) + (size_t)e * 2 * FF * D, a->ffn_norm + D, up ? 4 : 3, item, lane); }
    else transpose_pair8(a->moe_w_down + (size_t)mat * FF * D, FF, D, WSP(unsigned char, WS_WD1) + (size_t)mat * D * FF, nullptr, 0, item, lane);
}
__device__ __forceinline__ void moe_tb(unsigned char* ws, int (&tb)[9]) {
    const gu32* gc = (const gu32*)(ws + WS_CTL) + CW_GCNT; tb[0] = 0;
#pragma unroll
    for (int e = 0; e < 8; ++e) tb[e + 1] = tb[e] + (__builtin_amdgcn_readfirstlane((int)gc[16 * e]) + 255) / 256;
}
template <int l>
__device__ __forceinline__ void layer_fwd(const Frame& F0, const int lo, const int hi, XcdBarrier& bar) {
        constexpr int pb = 1 + 7 * l;
        PH_BEGIN(pb) {
            Frame F = F0; asm volatile("" : "+v"(F.tid)); F.lane = F.tid & 63; F.wave = __builtin_amdgcn_readfirstlane(F.tid >> 6);
            int cid = F.c, gsz = F.G; asm volatile("" : "+s"(cid), "+s"(gsz)); const int gw = cid * NWAVES + F.wave, NGW = gsz * NWAVES; (void)gw; (void)NGW;
            unsigned char* ws = get_args()->ws;
            if constexpr (G1_MIX) {
                pg8::RowTbl rt{WSP(float, SM_PART), (LAS float*)(F.lds + ROWTBL_OFF)};
                { pg8::Gemm g{WSP(bf16_t, WS_XB), WSP(bf16_t, WS_WIN) + (size_t)l * NY * D, D, D, D};
                  pg8::SchedTiles S; S.n = 384; S.tiles = 0x943210u; S.c0 = cid; S.cstep = gsz; S.cnt = 1 << 20;
                  typedef pg8::EpiG1<1, false> EG1;
                  EG1 E{WSP(bf16_t, WS_Y), rt, WSP(float, SM_PARTQ), WSP(float, SM_PARTKV), WSP(float, SM_FF), WSP(bf16_t, WS_KM), WSP(float, SM_ROPE)};
                  pg8::gemm_phase<EG1, pg8::SchedTiles, true, false>(F.lds, g, S, E); }
                __syncthreads();
                { pg8::Gemm g{WSP(bf16_t, WS_XB8), (const bf16_t*)(ws + WS_WIN8 + (size_t)l * NY * D), D / 2, D / 2, D / 2};
                  pg8::SchedTiles S; S.n = 256; S.tiles = 0x8765u;
                  if (gsz == 256) { S.c0 = cid - 128; S.cstep = 128; S.cnt = cid >= 128 ? 2 : 0; } else { S.c0 = cid; S.cstep = gsz; S.cnt = 1 << 20; }
                  typedef pg8::EpiG1<1, true> EG8;
                  EG8 E{WSP(bf16_t, WS_Y), rt, WSP(float, SM_PARTQ), WSP(float, SM_PARTKV), WSP(float, SM_FF), WSP(bf16_t, WS_KM), WSP(float, SM_ROPE)};
                  pg8::gemm_phase<EG8, pg8::SchedTiles, true, true>(F.lds, g, S, E); }
            } else {
            constexpr bool F8 = ((G1_FP8 >> l) & 1) != 0; constexpr int KD = F8 ? D / 2 : D;
            pg8::Gemm g{F8 ? WSP(bf16_t, WS_XB8) : WSP(bf16_t, WS_XB), WSP(bf16_t, WS_WIN) + (size_t)l * NY * D, KD, KD, KD};
            pg8::SchedStatic S; S.o.init(T, NY, gsz, cid);
            typedef pg8::EpiG1<1, F8> EG1;
            EG1 E{WSP(bf16_t, WS_Y), pg8::RowTbl{WSP(float, SM_PART), (LAS float*)(F.lds + ROWTBL_OFF)}, WSP(float, SM_PARTQ), WSP(float, SM_PARTKV), WSP(float, SM_FF), WSP(bf16_t, WS_KM), WSP(float, SM_ROPE)};
            pg8::gemm_phase<EG1, pg8::SchedStatic, true, F8>(F.lds, g, S, E);
#ifndef G1_CONV
#define G1_CONV 1
#endif
            if (G1_CONV && gsz == 256 && cid >= 128) {
                LAS unsigned* qslot = (LAS unsigned*)(F.lds + LDSCTL_OFF + 64);
                for (int k = 0; k < (l == 0 ? 2 : 1); ++k) {
                    if (F.tid == 0) qslot[1] = __hip_atomic_fetch_add((gu32*)(get_args()->ws + WS_CTL) + CW_QUEUE + 64 * (4 + l), 1u, RLX_AGENT);
                    __syncthreads();
                    const int cvi = (int)qslot[1];
                    __syncthreads();
                    if (cvi < (l == 0 ? NCV0 : NCV1)) moe_convert_unit<l>(cvi, F.wave, F.lane);
                }
            }
            }
        } PH_END
        SEAM(pb);
        PH_BEGIN(pb + 1) {
            Frame F = F0; asm volatile("" : "+v"(F.tid)); F.lane = F.tid & 63; F.wave = __builtin_amdgcn_readfirstlane(F.tid >> 6);
            int cid = F.c, gsz = F.G; asm volatile("" : "+s"(cid), "+s"(gsz)); const int gw = cid * NWAVES + F.wave, NGW = gsz * NWAVES; (void)gw; (void)NGW;
            if ((P2MASK & 1) && cid < 128) {
                unsigned char* ws = get_args()->ws;
                pg8::Gemm g{WSP(bf16_t, WS_Y) + Y_CQ, WSP(bf16_t, WS_WQUP) + (size_t)l * 512 * 256, NY, 256, 256};
                pg8::SchedOne S; S.has = true; S.un.pm = cid >> 1; S.un.pn = cid & 1; S.un.e = 0; S.un.ks = 0;
                pg8::EpiQup E{WSP(bf16_t, WS_QM), WSP(float, SM_PARTQ), WSP(float, SM_ROPE)};
                pg8::gemm_phase<pg8::EpiQup, pg8::SchedOne, false>(F.lds, g, S, E);
            } else if (P2MASK & 2) {
                unsigned char* ws = get_args()->ws;
                pg8::Gemm g{WSP(bf16_t, WS_Y) + Y_CKV, WSP(bf16_t, WS_WKVUP) + (size_t)l * 512 * 128, NY, 128, 128};
                pg8::SchedOne S; S.has = cid < 256; S.un.pm = (cid - 128) >> 1; S.un.pn = cid & 1; S.un.e = 0; S.un.ks = 0;
                pg8::EpiKVup E{WSP(bf16_t, WS_KM), WSP(bf16_t, WS_VM), WSP(float, SM_PARTKV), MLA_F8V ? WSP(unsigned char, WS_VM) : nullptr};
                pg8::gemm_phase<pg8::EpiKVup, pg8::SchedOne, false>(F.lds, g, S, E);
            }
            __syncthreads();
            const int lt0 = (gsz >= 256) ? 128 : 0;
            if (P2MASK & 4) for (int sq = cid - lt0; sq >= 0 && sq < 8; sq += gsz) {
                ArgsP a = get_args(); unsigned char* ws = a->ws; const float* ffb = WSP(float, SM_FF); float* csl = WSP(float, SM_CSL);
                const int b = sq >> 2, h = sq & 3; const float bfv = a->b_forget[l * 4 + h];
                LAS double* sd = (LAS double*)F.lds;
                double loc[16]; double run = 0.0;
#pragma unroll
                for (int i = 0; i < 16; ++i) { const float z = ffb[(size_t)(b * SEQ + F.tid * 16 + i) * 4 + h] + bfv;
                    const float ls = fminf(z, 0.f) - 0.6931471805599453f * __builtin_amdgcn_logf(1.0f + __builtin_amdgcn_exp2f(-fabsf(z) * LOG2E)); run += (double)ls; loc[i] = run; }
                double incl = run;
#pragma unroll
                for (int o = 1; o < 64; o <<= 1) { const double t = __shfl_up(incl, o); if (F.lane >= o) incl += t; }
                if (F.lane == 63) sd[F.wave] = incl;
                __syncthreads();
                double base = 0.0;
                for (int w = 0; w < F.wave; ++w) base += sd[w];
                const double excl = base + incl - run;
#pragma unroll
                for (int i = 0; i < 16; ++i) csl[(size_t)sq * SEQ + F.tid * 16 + i] = (float)((excl + loc[i]) * (double)LOG2E);
                __syncthreads();
            }
            if (cid >= lt0) {
                unsigned char* ws = get_args()->ws; const bf16_t* Y = WSP(bf16_t, WS_Y);
                float mq[2] = {0.f, 0.f}, mk[2] = {0.f, 0.f};
                for (int m = gw - lt0 * NWAVES; m < T; m += NGW - lt0 * NWAVES) {
                    const u32x2 qv = *(const u32x2*)(Y + (size_t)m * NY + Y_FQ + 4 * F.lane), kv = *(const u32x2*)(Y + (size_t)m * NY + Y_FK + 4 * F.lane);
                    float a0 = __uint_as_float(qv.x << 16), a1 = __uint_as_float(qv.x & 0xffff0000u), a2 = __uint_as_float(qv.y << 16), a3 = __uint_as_float(qv.y & 0xffff0000u);
                    float b0 = __uint_as_float(kv.x << 16), b1 = __uint_as_float(kv.x & 0xffff0000u), b2 = __uint_as_float(kv.y << 16), b3 = __uint_as_float(kv.y & 0xffff0000u);
                    float sq = (a0 * a0 + a1 * a1) + (a2 * a2 + a3 * a3), sk = (b0 * b0 + b1 * b1) + (b2 * b2 + b3 * b3);
#pragma unroll
                    for (int o = 1; o < 16; o <<= 1) { sq += __shfl_xor(sq, o); sk += __shfl_xor(sk, o); }
                    const int bb = m >= SEQ ? 1 : 0;
                    mq[0] = fmaxf(mq[0], bb ? 0.f : sq); mq[1] = fmaxf(mq[1], bb ? sq : 0.f); mk[0] = fmaxf(mk[0], bb ? 0.f : sk); mk[1] = fmaxf(mk[1], bb ? sk : 0.f);
                }
                LAS float* red = (LAS float*)F.lds;
                if ((F.lane & 15) == 0) { const int h = F.lane >> 4; LAS float* r = red + (F.wave * 4 + h) * 4; r[0] = mq[0]; r[1] = mk[0]; r[2] = mq[1]; r[3] = mk[1]; }
                __syncthreads();
                if (F.tid < 16) { const int h = F.tid >> 2, j = F.tid & 3; float v = 0.f;
                    for (int w = 0; w < 8; ++w) v = fmaxf(v, red[(w * 4 + h) * 4 + j]);
                    const int b = j >> 1, qk = j & 1;
                    atomicMax((unsigned*)((gu32*)(ws + WS_CTL) + CW_FMAX + ((l * 8 + b * 4 + h) * 2 + qk)), __float_as_uint(v)); }
                __syncthreads();
            }
            if (P2MASK & 8) for (int idx = cid; idx < 1024; idx += gsz) {
                ArgsP a = get_args(); unsigned char* ws = a->ws; const bf16_t* Y = WSP(bf16_t, WS_Y);
                att::AU u; u.stamp = nullptr; u.O8 = nullptr; u.o8pitch = 0;
                if (idx < 256) {
                    const int b = idx >> 7, hq = (idx >> 5) & 3, qb = idx & 31;
                    const bf16_t* yb = Y + (size_t)b * SEQ * NY;
                    u.Q = yb + Y_SQ + hq * 64; u.K = yb + Y_SK + (hq >> 1) * 64; u.V = yb + Y_SV + (hq >> 1) * 64; u.qpitch = u.kpitch = u.vpitch = NY;
                    u.O = WSP(bf16_t, WS_MIX) + (size_t)b * SEQ * D + 256 + hq * 64; u.opitch = D; u.lse = nullptr; u.lpitch = 0; u.colb = nullptr;
                    if (P4_FP8) { u.O8 = WSP(unsigned char, WS_MIX) + (size_t)b * SEQ * D + 256 + hq * 64; u.o8pitch = D; }
                    u.q0 = qb * 256; u.span = 127; u.alibi = exp2f(-(float)(hq + 1)) * LOG2E; u.sink2 = a->sinks[l * 4 + hq] * LOG2E;
                } else {
                    const int p = (idx - 256) >> 8, rem = (idx - 256) & 255, b = rem >> 7, h = (rem >> 5) & 3, j = rem & 31;
                    const int dil = (p == 0) ? 1 : (p == 1) ? 4 : 16, nqb = (SEQ / dil) / 256, r = j / nqb, qb = j % nqb;
                    const bf16_t* yb = Y + (size_t)(b * SEQ + r) * NY;
                    u.Q = yb + Y_DQ + h * 64; u.K = yb + Y_DK + h * 64; u.V = yb + Y_DV + h * 64; u.qpitch = u.kpitch = u.vpitch = dil * NY;
                    u.O = WSP(bf16_t, WS_DP) + (size_t)p * T * 256 + (size_t)(b * SEQ + r) * 256 + h * 64; u.opitch = dil * 256;
                    u.lse = WSP(float, WS_DL) + (size_t)p * T * 4 + (size_t)(b * SEQ + r) * 4 + h; u.lpitch = dil * 4; u.colb = nullptr;
                    u.q0 = qb * 256; u.span = 128; u.alibi = exp2f(-(float)(h + 5)) * (float)dil * LOG2E; u.sink2 = -INFINITY;
                }
                u.kt0 = u.q0 / 64 - 2; if (u.kt0 < 0) u.kt0 = 0; u.kt1 = u.q0 / 64 + 4;
                att::attn_unit<4, 2, 6>(u, F.lds);
            }
        } PH_END
        SEAM(pb + 1);
        PH_BEGIN(pb + 2) {
            Frame F = F0; asm volatile("" : "+v"(F.tid)); F.lane = F.tid & 63; F.wave = __builtin_amdgcn_readfirstlane(F.tid >> 6);
            int cid = F.c, gsz = F.G; asm volatile("" : "+s"(cid), "+s"(gsz)); const int gw = cid * NWAVES + F.wave, NGW = gsz * NWAVES; (void)gw; (void)NGW;
            LAS unsigned* qslot = (LAS unsigned*)(F.lds + LDSCTL_OFF + 64);
            for (;;) {
                unsigned char* ws = get_args()->ws;
#if PROBE_REP >= 0
                const int qrep = rep_;
#else
                const int qrep = 0;
#endif
                if (F.tid == 0) { qslot[0] = __hip_atomic_fetch_add((gu32*)(ws + WS_CTL) + CW_QUEUE + 64 * (l + 2 * qrep), 1u, RLX_AGENT);
                                  qslot[1] = __hip_atomic_fetch_add((gu32*)(ws + WS_CTL) + CW_QUEUE + 64 * (4 + l + 2 * qrep), 1u, RLX_AGENT); }
                __syncthreads();
                const int idx = __builtin_amdgcn_readfirstlane((int)qslot[0]), cvi = __builtin_amdgcn_readfirstlane((int)qslot[1]);
                __syncthreads();
                const bool cv_ok = cvi < (l == 0 ? NCV0 : NCV1), cv_after = (cid & 1) && idx < 896;
                if (cv_ok && !cv_after) moe_convert_unit<l>(cvi, F.wave, F.lane);
                if (idx >= 896) { if (cv_ok) continue; break; }
                att::AU u; u.O8 = nullptr; u.o8pitch = 0; u.span = 1 << 30; u.alibi = 0.f; u.sink2 = -INFINITY; u.xthr = 0.f; u.stamp = (cid == 0) ? (unsigned long long*)(ws + WS_CTL + 512 * 1024) : nullptr;
                if (idx < 512 || idx >= 768) {
                    int bh, qb, c;
                    if (idx < 192) { bh = idx & 7; const int r = idx >> 3; c = r % 3; qb = 24 + r / 3; }
                    else if (idx < 320) { const int n = idx - 192; bh = n & 7; const int r = n >> 3; c = r & 1; qb = 16 + (r >> 1); }
                    else if (idx < 384) { const int n = idx - 320; bh = n & 7; qb = 8 + (n >> 3); c = 0; }
                    else { const int n = (idx < 512) ? idx - 384 : idx - 640, sz = n >> 5, m = n & 31; bh = m & 7; c = m >> 3; qb = 8 * c + (7 - sz); }
                    const int b = bh >> 2, h = bh & 3;
                    u.q0 = qb * 256; u.kt0 = 32 * c; u.kt1 = 4 * qb + 4 < 32 * c + 32 ? 4 * qb + 4 : 32 * c + 32;
                    u.Q = WSP(bf16_t, WS_QM) + (size_t)b * SEQ * 384 + h * 96; u.K = WSP(bf16_t, WS_KM) + (size_t)b * SEQ * 384 + h * 96; u.V = WSP(bf16_t, WS_VM) + (size_t)b * SEQ * 256 + h * 64;
                    u.qpitch = 384; u.kpitch = 384; u.vpitch = 256; u.colb = nullptr;
                    if (MLA_F8V) { u.V = (const bf16_t*)(ws + WS_VM + (size_t)(b * 4 + h) * 64 * SEQ); u.vpitch = SEQ; }
                    u.O = WSP(bf16_t, WS_MP) + (size_t)c * T * 256 + (size_t)b * SEQ * 256 + h * 64; u.opitch = 256;
                    u.lse = WSP(float, WS_ML) + (size_t)c * T * 4 + (size_t)b * SEQ * 4 + h; u.lpitch = 4;
                    att::attn_unit<6, 0, 6, MLA_F8V != 0>(u, F.lds);
                } else {
                    const int n = idx - 512, qb = 31 - (n >> 3), bh = n & 7, b = bh >> 2, h = bh & 3;
                    const bf16_t* yb = WSP(bf16_t, WS_Y) + (size_t)b * SEQ * NY;
                    u.lse = nullptr; u.lpitch = 0; u.q0 = qb * 256; u.kt0 = 0; u.kt1 = 4 * qb + 4; u.opitch = D;
                    u.Q = yb + Y_FQ + h * 64; u.K = yb + Y_FK + h * 64; u.V = yb + Y_FV + h * 64; u.qpitch = u.kpitch = u.vpitch = NY;
                    u.O = WSP(bf16_t, WS_MIX) + (size_t)b * SEQ * D + h * 64; u.colb = WSP(float, SM_CSL) + (size_t)bh * SEQ;
                    if (P4_FP8) { u.O8 = WSP(unsigned char, WS_MIX) + (size_t)b * SEQ * D + h * 64; u.o8pitch = D; }
                    const gu32* fm = (const gu32*)(ws + WS_CTL) + CW_FMAX + (l * 8 + bh) * 2;
                    u.xthr = FOX_THRESH + 2.0f * sqrtf(__uint_as_float(fm[0]) * __uint_as_float(fm[1])) * 1.0001f + 1.0f;
                    att::attn_unit<4, 1, 5>(u, F.lds);
                }
                if (cv_ok && cv_after) { int t2 = F0.tid; asm volatile("" : "+v"(t2)); moe_convert_unit<l>(cvi, __builtin_amdgcn_readfirstlane(t2 >> 6), t2 & 63); }
            }
        } PH_END
        SEAM(pb + 2);
        PH_BEGIN(pb + 3) {
            Frame F = F0; asm volatile("" : "+v"(F.tid)); F.lane = F.tid & 63; F.wave = __builtin_amdgcn_readfirstlane(F.tid >> 6);
            int cid = F.c, gsz = F.G; asm volatile("" : "+s"(cid), "+s"(gsz)); const int gw = cid * NWAVES + F.wave, NGW = gsz * NWAVES; (void)gw; (void)NGW;
            unsigned char* ws = get_args()->ws;
            const bf16_t* Dp = WSP(bf16_t, WS_DP); const float* Dl = WSP(float, WS_DL); const bf16_t* Mp = WSP(bf16_t, WS_MP); const float* Ml = WSP(float, WS_ML); bf16_t* MIX = WSP(bf16_t, WS_MIX);
            for (int blk = cid; blk < T / 64; blk += gsz) {
                const int t = blk * 64 + (F.tid >> 3), dc = F.tid & 7;
                const int np = (((t & (SEQ - 1)) >> 8) >> 3) + 1;
                f32x4 dl[3], ml[4];
#pragma unroll
                for (int p = 0; p < 3; ++p) dl[p] = *(const f32x4*)(Dl + (size_t)(p * T + t) * 4);
#pragma unroll
                for (int p = 0; p < 4; ++p) ml[p] = (p < np) ? *(const f32x4*)(Ml + (size_t)(p * T + t) * 4) : (f32x4){-INFINITY, -INFINITY, -INFINITY, -INFINITY};
                u32x4 dvv[4][3], mvv[4][4];
#pragma unroll
                for (int h = 0; h < 4; ++h) {
#pragma unroll
                    for (int p = 0; p < 3; ++p) dvv[h][p] = *(const u32x4*)(Dp + (size_t)(p * T + t) * 256 + h * 64 + dc * 8);
#pragma unroll
                    for (int p = 0; p < 4; ++p) mvv[h][p] = (p < np) ? *(const u32x4*)(Mp + (size_t)(p * T + t) * 256 + h * 64 + dc * 8) : (u32x4){0u, 0u, 0u, 0u};
                }
#pragma unroll
                for (int h = 0; h < 4; ++h) {
                    u32x4 dv[3], mv[4];
#pragma unroll
                    for (int p = 0; p < 3; ++p) dv[p] = dvv[h][p];
#pragma unroll
                    for (int p = 0; p < 4; ++p) mv[p] = mvv[h][p];
                    {
                        const float mx = fmaxf(dl[0][h], fmaxf(dl[1][h], dl[2][h]));
                        float w0 = __builtin_amdgcn_exp2f(dl[0][h] - mx), w1 = __builtin_amdgcn_exp2f(dl[1][h] - mx), w2 = __builtin_amdgcn_exp2f(dl[2][h] - mx);
                        const float inv = __builtin_amdgcn_rcpf(w0 + w1 + w2); w0 *= inv; w1 *= inv; w2 *= inv;
                        u32x4 o;
#pragma unroll
                        for (int e = 0; e < 4; ++e) {
                            const float lo_ = w0 * __uint_as_float(dv[0][e] << 16) + w1 * __uint_as_float(dv[1][e] << 16) + w2 * __uint_as_float(dv[2][e] << 16);
                            const float hi_ = w0 * __uint_as_float(dv[0][e] & 0xffff0000u) + w1 * __uint_as_float(dv[1][e] & 0xffff0000u) + w2 * __uint_as_float(dv[2][e] & 0xffff0000u);
                            o[e] = cvtpk(lo_, hi_);
                        }
                        if (P4_FP8) { float f[8];
#pragma unroll
                            for (int e = 0; e < 4; ++e) { f[2 * e] = __uint_as_float(o[e] << 16) * F8_SM; f[2 * e + 1] = __uint_as_float(o[e] & 0xffff0000u) * F8_SM; }
                            u32x2 w8; w8.x = cvt4_fp8(f[0], f[1], f[2], f[3]); w8.y = cvt4_fp8(f[4], f[5], f[6], f[7]);
                            *(u32x2*)((unsigned char*)MIX + (size_t)t * D + 768 + h * 64 + dc * 8) = w8; }
                        else *(u32x4*)(MIX + (size_t)t * D + 768 + h * 64 + dc * 8) = o;
                    }
                    {
                        const float mx = fmaxf(fmaxf(ml[0][h], ml[1][h]), fmaxf(ml[2][h], ml[3][h]));
                        float w[4]; float sw = 0.f;
#pragma unroll
                        for (int p = 0; p < 4; ++p) { w[p] = __builtin_amdgcn_exp2f(ml[p][h] - mx); sw += w[p]; }
                        const float inv = __builtin_amdgcn_rcpf(sw);
                        float acc[8] = {0.f, 0.f, 0.f, 0.f, 0.f, 0.f, 0.f, 0.f};
#pragma unroll
                        for (int p = 0; p < 4; ++p) { const float wp = w[p] * inv;
#pragma unroll
                            for (int e = 0; e < 4; ++e) { acc[2 * e] += wp * __uint_as_float(mv[p][e] << 16); acc[2 * e + 1] += wp * __uint_as_float(mv[p][e] & 0xffff0000u); } }
                        if (P4_FP8) { u32x2 w8; w8.x = cvt4_fp8(acc[0] * F8_SM, acc[1] * F8_SM, acc[2] * F8_SM, acc[3] * F8_SM); w8.y = cvt4_fp8(acc[4] * F8_SM, acc[5] * F8_SM, acc[6] * F8_SM, acc[7] * F8_SM);
                            *(u32x2*)((unsigned char*)MIX + (size_t)t * D + 512 + h * 64 + dc * 8) = w8; }
                        else { u32x4 o; o.x = cvtpk(acc[0], acc[1]); o.y = cvtpk(acc[2], acc[3]); o.z = cvtpk(acc[4], acc[5]); o.w = cvtpk(acc[6], acc[7]);
                            *(u32x4*)(MIX + (size_t)t * D + 512 + h * 64 + dc * 8) = o; }
                    }
                }
            }
        } PH_END
        SEAM(pb + 3);
        PH_BEGIN(pb + 4) {
            Frame F = F0; asm volatile("" : "+v"(F.tid)); F.lane = F.tid & 63; F.wave = __builtin_amdgcn_readfirstlane(F.tid >> 6);
            int cid = F.c, gsz = F.G; asm volatile("" : "+s"(cid), "+s"(gsz)); const int gw = cid * NWAVES + F.wave, NGW = gsz * NWAVES; (void)gw; (void)NGW;
            ArgsP a = get_args(); unsigned char* ws = a->ws;
            constexpr int KD = P4_FP8 ? D / 2 : D;
            pg8::Gemm g{WSP(bf16_t, WS_MIX), WSP(bf16_t, WS_WOUT) + (size_t)l * D * D, KD, KD, KD};
            pg8::SchedStatic S; S.o.init(T, D, gsz, cid);
            typedef pg8::EpiRes<true> ER;
            ER E{(const void*)WSP(bf16_t, WS_XB), l == 0 ? WSP(bf16_t, WS_XB) : WSP(bf16_t, WS_XR), WSP(float, SM_PART), nullptr, P4_FP8 ? 1.0f / (F8_SM * F8_SW) : 1.0f};
            pg8::gemm_phase<ER, pg8::SchedStatic, true, P4_FP8 != 0>(F.lds, g, S, E);
        } PH_END
        SEAM(pb + 4);
        if (l == 0) {
            PH_BEGIN(6) {
            Frame F = F0; asm volatile("" : "+v"(F.tid)); F.lane = F.tid & 63; F.wave = __builtin_amdgcn_readfirstlane(F.tid >> 6);
            int cid = F.c, gsz = F.G; asm volatile("" : "+s"(cid), "+s"(gsz)); const int gw = cid * NWAVES + F.wave, NGW = gsz * NWAVES; (void)gw; (void)NGW;
                unsigned char* ws = get_args()->ws;
                pg8::Gemm g{WSP(bf16_t, WS_XB), WSP(bf16_t, WS_WGU0), D, D, D};
                pg8::SchedStatic S; S.o.init(T, 2 * FF, gsz, cid);
                typedef pg8::EpiSwigluT<1, 0, false> ES;
                ES E{WSP(void, WS_HID), pg8::RowTbl{WSP(float, SM_PART), (LAS float*)(F.lds + ROWTBL_OFF)}};
                pg8::gemm_phase<ES, pg8::SchedStatic, true>(F.lds, g, S, E);
            } PH_END
            SEAM(6);
            PH_BEGIN(7) {
            Frame F = F0; asm volatile("" : "+v"(F.tid)); F.lane = F.tid & 63; F.wave = __builtin_amdgcn_readfirstlane(F.tid >> 6);
            int cid = F.c, gsz = F.G; asm volatile("" : "+s"(cid), "+s"(gsz)); const int gw = cid * NWAVES + F.wave, NGW = gsz * NWAVES; (void)gw; (void)NGW;
                ArgsP a = get_args(); unsigned char* ws = a->ws;
                pg8::Gemm g{WSP(bf16_t, WS_HID), WSP(bf16_t, WS_WD0), FF, FF, FF};
                pg8::SchedStatic S; S.o.init(T, D, gsz, cid);
                pg8::EpiRes<true> E{WSP(bf16_t, WS_XB), WSP(bf16_t, WS_XB), WSP(float, SM_PART), (G1_MIX || (G1_FP8 & 2)) ? WSP(unsigned char, WS_XB8) : nullptr, 1.0f};
                pg8::gemm_phase<pg8::EpiRes<true>, pg8::SchedStatic, true>(F.lds, g, S, E);
            } PH_END
            SEAM(7);
        }
}

__global__ void __launch_bounds__(NWAVES * 64, 2) mega_fwd(Args a_unused) {
    extern __shared__ __attribute__((aligned(16))) unsigned char lds_raw[];
    Frame F0;
    F0.lds = (LAS unsigned char*)lds_raw;
    F0.tid = threadIdx.x; F0.lane = F0.tid & 63; F0.wave = __builtin_amdgcn_readfirstlane(F0.tid >> 6);
    F0.G = gridDim.x; F0.c = blockIdx.x;
    volatile LAS unsigned* MISC = (volatile LAS unsigned*)(F0.lds + MISC_OFF);
    for (int u = F0.tid; u < (LDS_BYTES - LDSCTL_OFF) / 4; u += NWAVES * 64) ((LAS unsigned*)(F0.lds + LDSCTL_OFF))[u] = 0u;
    __syncthreads();
#if MK_ONE_LAUNCH
    XcdBarrier bar = xcd_barrier_post((unsigned*)(get_args()->ws + WS_CTL) + CW_BAR, MISC + 8);
#else
    XcdBarrier bar; bar.bar = nullptr; bar.x = 0; bar.st = MISC + 8;
#endif
    const int lo = get_args()->ph_lo, hi = get_args()->ph_hi;

    PH_BEGIN(0) {
            Frame F = F0; asm volatile("" : "+v"(F.tid)); F.lane = F.tid & 63; F.wave = __builtin_amdgcn_readfirstlane(F.tid >> 6);
            int cid = F.c, gsz = F.G; asm volatile("" : "+s"(cid), "+s"(gsz)); const int gw = cid * NWAVES + F.wave, NGW = gsz * NWAVES; (void)gw; (void)NGW;
        ArgsP a = get_args(); unsigned char* ws = a->ws;
        LAS float* scr = (LAS float*)(F.lds + F.wave * 16384);
        bf16_t* Win_t = WSP(bf16_t, WS_WIN); bf16_t* Wqup_t = WSP(bf16_t, WS_WQUP); bf16_t* Wkvup_t = WSP(bf16_t, WS_WKVUP); bf16_t* Wout_t = WSP(bf16_t, WS_WOUT);
        bf16_t* Wgu0_t = WSP(bf16_t, WS_WGU0); bf16_t* Wd0_t = WSP(bf16_t, WS_WD0);
        constexpr int I_IN = 16 * 78, I_QU = 4 * 12, I_KV = 2 * 16, I_WO = 16 * 32, I_GU = 16 * 112, I_DN = 56 * 32;
        constexpr int I_IN8 = 8 * 78, I_WO8 = 8 * 32;
        constexpr int NIT = (G1_MIX ? 2 * (I_IN + I_IN8) : ((G1_FP8 & 1) ? I_IN8 : I_IN) + ((G1_FP8 & 2) ? I_IN8 : I_IN)) + 2 * I_QU + 2 * I_KV + 2 * (P4_FP8 ? I_WO8 : I_WO);
        for (int it = gw; it < NIT; it += NGW) {
            int r = it;
            bool done = false;
            if constexpr (G1_MIX) {
#pragma unroll
                for (int l = 0; l < 2; ++l) if (!done) {
                    if (r < I_IN) { transpose_item(a->w_in + (size_t)l * D * NIN, D, NIN, Win_t + (size_t)l * NY * D, a->attn_norm + l * D, 1, scr, r, F.lane, G1_TILES_BF); done = true; } else r -= I_IN;
                    if (!done) { if (r < I_IN8) { transpose_item8(a->w_in + (size_t)l * D * NIN, D, NIN, ws + WS_WIN8 + (size_t)l * NY * D, a->attn_norm + l * D, 1, r, F.lane, G1_TILES_F8); done = true; } else r -= I_IN8; }
                }
            } else
#pragma unroll
            for (int l = 0; l < 2; ++l) if (!done) {
                if ((G1_FP8 >> l) & 1) { if (r < I_IN8) { transpose_item8(a->w_in + (size_t)l * D * NIN, D, NIN, (unsigned char*)(Win_t + (size_t)l * NY * D), a->attn_norm + l * D, 1, r, F.lane); done = true; } else r -= I_IN8; }
                else { if (r < I_IN) { transpose_item(a->w_in + (size_t)l * D * NIN, D, NIN, Win_t + (size_t)l * NY * D, a->attn_norm + l * D, 1, scr, r, F.lane); done = true; } else r -= I_IN; }
            }
            if (done) continue;
            if (r < 2 * I_QU) { const int l = r / I_QU; transpose_item(a->w_q_up + (size_t)l * 256 * 384, 256, 384, Wqup_t + (size_t)l * 512 * 256, a->mla_q_norm + l * 256, 2, scr, r % I_QU, F.lane); continue; } r -= 2 * I_QU;
            if (r < 2 * I_KV) { const int l = r / I_KV; transpose_item(a->w_kv_up + (size_t)l * 128 * 512, 128, 512, Wkvup_t + (size_t)l * 512 * 128, a->mla_kv_norm + l * 128, 0, scr, r % I_KV, F.lane); continue; } r -= 2 * I_KV;
            if (P4_FP8) { if (r < 2 * I_WO8) { const int l = r / I_WO8; transpose_item8(a->w_out + (size_t)l * D * D, D, D, (unsigned char*)(Wout_t + (size_t)l * D * D), nullptr, 0, r % I_WO8, F.lane); continue; } r -= 2 * I_WO8; }
            else { if (r < 2 * I_WO) { const int l = r / I_WO; transpose_item(a->w_out + (size_t)l * D * D, D, D, Wout_t + (size_t)l * D * D, nullptr, 0, scr, r % I_WO, F.lane); continue; } r -= 2 * I_WO; }
        }
        const float* x = a->x; const int* pos = a->pos; bf16_t* XB = WSP(bf16_t, WS_XB); float* part0 = WSP(float, SM_PART); float* rope = WSP(float, SM_ROPE);
        const float invf = powf(10000.0f, -(float)(F.lane & 15) / 16.0f);
        constexpr int NBR = 4;
        for (int m0 = gw; m0 < T; m0 += NBR * NGW) {
            f32x4 v[NBR][4]; int mm[NBR], pp[NBR];
#pragma unroll
            for (int k = 0; k < NBR; ++k) { mm[k] = (m0 + k * NGW < T) ? m0 + k * NGW : m0;
                const f32x4* xr = (const f32x4*)(x + (size_t)mm[k] * D) + F.lane;
#pragma unroll
                for (int j = 0; j < 4; ++j) v[k][j] = xr[64 * j];
                pp[k] = pos[mm[k]]; }
#pragma unroll
            for (int k = 0; k < NBR; ++k) if (m0 + k * NGW < T) {
                const int m = mm[k];
                float s = 0.f;
                u32x2* o8 = (u32x2*)(XB + (size_t)m * D) + F.lane;
#pragma unroll
                for (int j = 0; j < 4; ++j) { s += (v[k][j][0] * v[k][j][0] + v[k][j][1] * v[k][j][1]) + (v[k][j][2] * v[k][j][2] + v[k][j][3] * v[k][j][3]);
                    u32x2 w; w.x = cvtpk(v[k][j][0], v[k][j][1]); w.y = cvtpk(v[k][j][2], v[k][j][3]); o8[64 * j] = w;
                    if (G1_MIX) ((unsigned*)(ws + WS_XB8 + (size_t)m * D))[F.lane + 64 * j] = cvt4_fp8(v[k][j][0] * F8_SX, v[k][j][1] * F8_SX, v[k][j][2] * F8_SX, v[k][j][3] * F8_SX); }
                s = wave_sum(s);
                if (F.lane < 16) part0[(size_t)m * 16 + F.lane] = (F.lane == 0) ? s : 0.f;
                if (F.lane < 16) {
                    const float ang = (float)pp[k] * invf;
                    float sn, cs; sincos_acc((double)ang, sn, cs);
                    *(f32x2*)(rope + (size_t)m * 32 + 2 * F.lane) = (f32x2){cs, sn};
                }
            }
        }
    } PH_END
    SEAM(0);

    layer_fwd<0>(F0, lo, hi, bar);
    layer_fwd<1>(F0, lo, hi, bar);
    PH_BEGIN(13) {
            Frame F = F0; asm volatile("" : "+v"(F.tid)); F.lane = F.tid & 63; F.wave = __builtin_amdgcn_readfirstlane(F.tid >> 6);
            int cid = F.c, gsz = F.G; asm volatile("" : "+s"(cid), "+s"(gsz)); const int gw = cid * NWAVES + F.wave, NGW = gsz * NWAVES; (void)gw; (void)NGW;
        ArgsP a = get_args(); unsigned char* ws = a->ws; const bf16_t* xres = WSP(bf16_t, WS_XR);
        float* tok_g = WSP(float, SM_TOKG); int* slot = WSP(int, SM_SLOT); unsigned char* XG = WSP(unsigned char, WS_XG);
        LAS float* Rg = (LAS float*)F.lds;
        LAS int* hist = (LAS int*)(F.lds + 40960); LAS int* pre = hist + 8; LAS int* le = hist + 16; LAS float* lrs = (LAS float*)(hist + 144); LAS int* rows = hist + 208;
        for (int i = F.tid; i < D * 8; i += 512) { const int k = i >> 3; Rg[k * 8 + (k >> 2) * 4 + (i & 7)] = a->router[i] * a->ffn_norm[D + k]; }
        for (int ch = cid; ch < 256; ch += gsz) {
            if (F.tid < 8) hist[F.tid] = 0;
            __syncthreads();
            {
                const int j = F.lane >> 3, g = F.lane & 7, tl = F.wave * 8 + j, t = ch * 64 + tl;
                const u32x2* xr = (const u32x2*)(xres + (size_t)t * D) + g;
                float acc[8] = {0.f, 0.f, 0.f, 0.f, 0.f, 0.f, 0.f, 0.f}; float ss = 0.f;
                u32x2 xw[32];
#pragma unroll
                for (int i = 0; i < 32; ++i) xw[i] = xr[8 * i];
#pragma unroll
                for (int ib = 0; ib < 32; ib += 8) {
                    f32x4 v[8];
#pragma unroll
                    for (int ii = 0; ii < 8; ++ii) { const u32x2 w = xw[ib + ii];
                        v[ii] = (f32x4){__uint_as_float(w.x << 16), __uint_as_float(w.x & 0xffff0000u), __uint_as_float(w.y << 16), __uint_as_float(w.y & 0xffff0000u)}; }
#pragma unroll
                    for (int ii = 0; ii < 8; ++ii)
#pragma unroll
                        for (int e4 = 0; e4 < 4; ++e4) { const int k = 4 * g + 32 * (ib + ii) + e4; const float xv = v[ii][e4]; ss += xv * xv;
                            const LAS float* rp = Rg + k * 8 + (k >> 2) * 4;
                            const f32x4 r0 = *(const LAS f32x4*)rp, r1 = *(const LAS f32x4*)(rp + 4);
#pragma unroll
                            for (int e = 0; e < 4; ++e) { acc[e] += xv * r0[e]; acc[4 + e] += xv * r1[e]; } }
                }
#pragma unroll
                for (int o = 1; o < 8; o <<= 1) { ss += __shfl_xor(ss, o);
#pragma unroll
                    for (int e = 0; e < 8; ++e) acc[e] += __shfl_xor(acc[e], o); }
                const float rs = __builtin_amdgcn_rsqf(ss * (1.0f / D) + EPS);
                float v1 = -INFINITY; int e1 = 0;
#pragma unroll
                for (int e = 0; e < 8; ++e) { const float lg = acc[e] * rs; if (lg > v1) { v1 = lg; e1 = e; } }
                float v2 = -INFINITY; int e2 = 0;
#pragma unroll
                for (int e = 0; e < 8; ++e) { const float lg = acc[e] * rs; if (e != e1 && lg > v2) { v2 = lg; e2 = e; } }
                const float g1 = 1.0f / (1.0f + expf(v2 - v1));
                if (g == 0) { tok_g[2 * t] = g1; tok_g[2 * t + 1] = 1.0f - g1; le[2 * tl] = e1; le[2 * tl + 1] = e2; lrs[tl] = rs;
                    atomicAdd((int*)&hist[e1], 1); atomicAdd((int*)&hist[e2], 1); }
            }
            u32x4 xv6[4][4];
#pragma unroll
            for (int j = 0; j < 4; ++j) { const int t = ch * 64 + F.wave * 8 + 2 * j + (F.lane >> 5); const u32x4* xr = (const u32x4*)(xres + (size_t)t * D + (F.lane & 31) * 32);
#pragma unroll
                for (int c = 0; c < 4; ++c) xv6[j][c] = xr[c]; }
            __syncthreads();
            if (F.tid < 8) pre[F.tid] = (int)__hip_atomic_fetch_add((gu32*)(ws + WS_CTL) + CW_GCNT + 16 * F.tid, (unsigned)hist[F.tid], RLX_AGENT);
            __syncthreads();
            if (F.wave == 0) {
                const int t = ch * 64 + F.lane; const int e1 = le[2 * F.lane], e2 = le[2 * F.lane + 1];
                int r1 = 0, r2 = 0;
#pragma unroll
                for (int e = 0; e < 8; ++e) {
                    const unsigned long long mk = __ballot(e1 == e || e2 == e);
                    const int rank = __popcll(mk & ((1ull << F.lane) - 1ull));
                    const int row = e * XCAP + pre[e] + rank;
                    if (e1 == e) r1 = row; if (e2 == e) r2 = row;
                }
                slot[2 * t] = r1; slot[2 * t + 1] = r2; rows[2 * F.lane] = r1; rows[2 * F.lane + 1] = r2;
            }
            __syncthreads();
#pragma unroll
            for (int j = 0; j < 4; ++j) {
                const int tl = F.wave * 8 + 2 * j + (F.lane >> 5); const int r1 = rows[2 * tl], r2 = rows[2 * tl + 1];
                const float rsx = lrs[tl] * F6_SX;
                float t[32];
#pragma unroll
                for (int c = 0; c < 4; ++c) { const u32x4 p = xv6[j][c];
#pragma unroll
                    for (int e = 0; e < 4; ++e) { t[8 * c + 2 * e] = __uint_as_float(p[e] << 16) * rsx; t[8 * c + 2 * e + 1] = __uint_as_float(p[e] & 0xffff0000u) * rsx; } }
                const i32x6 pk = pack32_fp6(t);
                const int blk = F.lane & 31;
                size_t p1, q1, p2, q2; fp6_tiled_offset(r1, blk, 8, false, p1, q1); fp6_tiled_offset(r2, blk, 8, false, p2, q2);
                const u32x4 w0 = {(unsigned)pk[0], (unsigned)pk[1], (unsigned)pk[2], (unsigned)pk[3]}; const u32x2 w1 = {(unsigned)pk[4], (unsigned)pk[5]};
                *(u32x4*)(XG + p1) = w0; *(u32x2*)(XG + q1) = w1; *(u32x4*)(XG + p2) = w0; *(u32x2*)(XG + q2) = w1;
            }
            __syncthreads();
        }
    } PH_END
    SEAM(13);
    PH_BEGIN(14) {
            Frame F = F0; asm volatile("" : "+v"(F.tid)); F.lane = F.tid & 63; F.wave = __builtin_amdgcn_readfirstlane(F.tid >> 6);
            int cid = F.c, gsz = F.G; asm volatile("" : "+s"(cid), "+s"(gsz)); const int gw = cid * NWAVES + F.wave, NGW = gsz * NWAVES; (void)gw; (void)NGW;
        unsigned char* ws = get_args()->ws;
        static_assert(UPM_FP6 == 1, "the gathered rows are fp6, stored by expert region");
        constexpr int RB = UPM_FP6 ? 768 : D;
        pg8::Gemm g{WSP(bf16_t, WS_XG), WSP(bf16_t, WS_WGU1), RB / 2, RB / 2, RB / 2};
        pg8::SchedMoeL S; moe_tb(ws, S.tb);
        S.o.init(S.tb[8] * 256, 2 * FF, gsz, cid); S.estride = (size_t)2 * FF * RB;
        typedef pg8::EpiSwigluT<0, UPM_FP6 ? 2 : 1, true> ES;
        ES E{WSP(void, WS_HG), pg8::RowTbl{nullptr, nullptr}};
        pg8::gemm_phase6<ES, pg8::SchedMoeL, true>(F.lds, g, S, E);
    } PH_END
    SEAM(14);
    PH_BEGIN(15) {
            Frame F = F0; asm volatile("" : "+v"(F.tid)); F.lane = F.tid & 63; F.wave = __builtin_amdgcn_readfirstlane(F.tid >> 6);
            int cid = F.c, gsz = F.G; asm volatile("" : "+s"(cid), "+s"(gsz)); const int gw = cid * NWAVES + F.wave, NGW = gsz * NWAVES; (void)gw; (void)NGW;
        unsigned char* ws = get_args()->ws;
        pg8::Gemm g{WSP(bf16_t, WS_HG), WSP(bf16_t, WS_WD1), FF / 2, FF / 2, FF / 2};
        pg8::SchedMoe S; moe_tb(ws, S.tb);
        const int nT = S.tb[8], nTa = nT < 128 ? nT : 128;
        S.o.init(nTa * 256, D, gsz, cid); S.estride = (size_t)D * FF;
        pg8::EpiY E{WSP(bf16_t, WS_XG)};
        pg8::gemm_phase<pg8::EpiY, pg8::SchedMoe, true, true>(F.lds, g, S, E);
        if (nT > 128) {
            pg8::Gemm g2{WSP(bf16_t, WS_HG), WSP(bf16_t, WS_WD1), FF / 2, FF / 2, 256};
            pg8::SchedMoeSplit S2;
#pragma unroll
            for (int e = 0; e < 9; ++e) S2.tb[e] = S.tb[e];
            S2.estride = (size_t)D * FF; S2.G = gsz; S2.c = cid; S2.n0 = 128; S2.nUnits = (nT - 128) * 4 * pg8::SchedMoeSplit::KS; S2.ksl = 256;
            pg8::EpiYs E2{WSP(bf16_t, WS_YP), 128, YP_ROWS};
            pg8::gemm_phase<pg8::EpiYs, pg8::SchedMoeSplit, true, true>(F.lds, g2, S2, E2);
        }
    } PH_END
    SEAM(15);
    PH_BEGIN(16) {
            Frame F = F0; asm volatile("" : "+v"(F.tid)); F.lane = F.tid & 63; F.wave = __builtin_amdgcn_readfirstlane(F.tid >> 6);
            int cid = F.c, gsz = F.G; asm volatile("" : "+s"(cid), "+s"(gsz)); const int gw = cid * NWAVES + F.wave, NGW = gsz * NWAVES; (void)gw; (void)NGW;
        ArgsP a = get_args(); unsigned char* ws = a->ws; float* out = a->out; const float* fn = a->final_norm;
        const int* slot = WSP(int, SM_SLOT); const float* tok_g = WSP(float, SM_TOKG); const bf16_t* YG = WSP(bf16_t, WS_XG); const bf16_t* YP = WSP(bf16_t, WS_YP);
        int tb[9]; moe_tb(ws, tb);
        constexpr int NB = 4;
        f32x4 gnv[4];
        { const f32x4* gn = (const f32x4*)fn + F.lane;
#pragma unroll
          for (int j = 0; j < 4; ++j) gnv[j] = gn[64 * j]; }
        for (int t0 = gw; t0 < T; t0 += NB * NGW) {
            int tt[NB], rr[NB][2]; float gg[NB][2]; u32x2 xv[NB][4], yv[NB][2][4];
#pragma unroll
            for (int k = 0; k < NB; ++k) { tt[k] = (t0 + k * NGW < T) ? t0 + k * NGW : t0;
#pragma unroll
                for (int sl = 0; sl < 2; ++sl) { const int sv = slot[2 * tt[k] + sl], ex = sv >> 14; int t0 = 0;
#pragma unroll
                    for (int j = 1; j < 8; ++j) t0 = (ex >= j) ? tb[j] : t0;
                    rr[k][sl] = t0 * 256 + (sv & (XCAP - 1)); } gg[k][0] = tok_g[2 * tt[k]] * (1.0f / (F8_SH * F8_SW)); gg[k][1] = tok_g[2 * tt[k] + 1] * (1.0f / (F8_SH * F8_SW)); }
#pragma unroll
            for (int k = 0; k < NB; ++k) {
                const u32x2* xr = (const u32x2*)(WSP(bf16_t, WS_XR) + (size_t)tt[k] * D) + F.lane;
#pragma unroll
                for (int j = 0; j < 4; ++j) xv[k][j] = xr[64 * j];
#pragma unroll
                for (int sl = 0; sl < 2; ++sl) { const int r = rr[k][sl];
                    if (YG_FP8 && r < 128 * 256) { const unsigned* y8 = (const unsigned*)((const unsigned char*)YG + (size_t)r * D) + F.lane;
#pragma unroll
                        for (int j = 0; j < 4; ++j) yv[k][sl][j] = (u32x2){y8[64 * j], 0u}; }
                    else { const u32x2* y = (const u32x2*)((r < 128 * 256) ? YG + (size_t)r * D : YP + (size_t)(r - 128 * 256) * D) + F.lane;
#pragma unroll
                        for (int j = 0; j < 4; ++j) yv[k][sl][j] = y[64 * j]; } }
            }
#pragma unroll
            for (int k = 0; k < NB; ++k) {
                f32x4 v[4]; float s = 0.f;
#pragma unroll
                for (int j = 0; j < 4; ++j) { const u32x2 p = xv[k][j]; v[j] = (f32x4){__uint_as_float(p.x << 16), __uint_as_float(p.x & 0xffff0000u), __uint_as_float(p.y << 16), __uint_as_float(p.y & 0xffff0000u)}; }
#pragma unroll
                for (int sl = 0; sl < 2; ++sl) {
                    const int r = rr[k][sl]; const float gt = gg[k][sl];
                    if (YG_FP8 && r < 128 * 256) { const float g8 = gt * (F8_SH * F8_SW / F8_SY);
#pragma unroll
                        for (int j = 0; j < 4; ++j) { const unsigned w = yv[k][sl][j].x; const f32x2 lo = __builtin_amdgcn_cvt_pk_f32_fp8((int)w, false), hi2 = __builtin_amdgcn_cvt_pk_f32_fp8((int)w, true);
                            v[j][0] += g8 * lo[0]; v[j][1] += g8 * lo[1]; v[j][2] += g8 * hi2[0]; v[j][3] += g8 * hi2[1]; } }
                    else {
#pragma unroll
                    for (int j = 0; j < 4; ++j) { const u32x2 p = yv[k][sl][j];
                        v[j][0] += gt * __uint_as_float(p.x << 16); v[j][1] += gt * __uint_as_float(p.x & 0xffff0000u);
                        v[j][2] += gt * __uint_as_float(p.y << 16); v[j][3] += gt * __uint_as_float(p.y & 0xffff0000u); } }
                    if (r >= 128 * 256) {
                        for (int ks = 1; ks < 7; ++ks) {
                            const u32x2* y = (const u32x2*)(YP + ((size_t)ks * YP_ROWS + (r - 128 * 256)) * D) + F.lane;
#pragma unroll
                            for (int j = 0; j < 4; ++j) { const u32x2 p = y[64 * j];
                                v[j][0] += gt * __uint_as_float(p.x << 16); v[j][1] += gt * __uint_as_float(p.x & 0xffff0000u);
                                v[j][2] += gt * __uint_as_float(p.y << 16); v[j][3] += gt * __uint_as_float(p.y & 0xffff0000u); }
                        }
                    }
                }
#pragma unroll
                for (int j = 0; j < 4; ++j) s += (v[j][0] * v[j][0] + v[j][1] * v[j][1]) + (v[j][2] * v[j][2] + v[j][3] * v[j][3]);
                s = wave_sum(s);
                const float rs = 1.0f / sqrtf(s * (1.0f / D) + EPS);
                if (t0 + k * NGW < T) { f32x4* o = (f32x4*)(out + (size_t)tt[k] * D) + F.lane;
#pragma unroll
                    for (int j = 0; j < 4; ++j) o[64 * j] = v[j] * rs * gnv[j]; }
            }
        }
    } PH_END
#undef IN
#undef SEAM
}

extern "C" void kernel_launch(void* const* d_in, const int* in_sizes, int n_in, void* d_out, int out_size, void* d_ws, size_t ws_size, hipStream_t stream) {
    static int grid = 0;
    if (grid == 0) {
        int dev = 0, cus = 0;
        if (n_in != 20 || ws_size < WS_END) { fprintf(stderr, "kernel_launch: unexpected inputs (n_in %d, ws %zu)\n", n_in, ws_size); grid = -1; return; }
        if (hipGetDevice(&dev) != hipSuccess || hipDeviceGetAttribute(&cus, hipDeviceAttributeMultiprocessorCount, dev) != hipSuccess) { grid = -1; return; }
        if (hipFuncSetAttribute((const void*)mega_fwd, hipFuncAttributeMaxDynamicSharedMemorySize, LDS_BYTES) != hipSuccess) { grid = -1; return; }
        int per_cu = 0;
        (void)hipOccupancyMaxActiveBlocksPerMultiprocessor(&per_cu, (const void*)mega_fwd, NWAVES * 64, LDS_BYTES);
        (void)hipGetLastError();
        grid = cus;
    }
    if (grid < 0) return;
    (void)hipMemsetAsync((char*)d_ws + WS_CTL, 0, CTL_ZERO_BYTES, stream);
    Args a{};
    a.x = (const float*)d_in[0]; a.pos = (const int*)d_in[1]; a.attn_norm = (const float*)d_in[2]; a.w_in = (const float*)d_in[3]; a.b_forget = (const float*)d_in[4];
    a.mla_q_norm = (const float*)d_in[5]; a.w_q_up = (const float*)d_in[6]; a.mla_kv_norm = (const float*)d_in[7]; a.w_kv_up = (const float*)d_in[8]; a.sinks = (const float*)d_in[9];
    a.w_out = (const float*)d_in[10]; a.ffn_norm = (const float*)d_in[11]; a.dense_w_gate = (const float*)d_in[12]; a.dense_w_up = (const float*)d_in[13]; a.dense_w_down = (const float*)d_in[14];
    a.router = (const float*)d_in[15]; a.moe_w_gate = (const float*)d_in[16]; a.moe_w_up = (const float*)d_in[17]; a.moe_w_down = (const float*)d_in[18]; a.final_norm = (const float*)d_in[19];
    a.out = (float*)d_out; a.ws = (unsigned char*)d_ws;
#if MK_ONE_LAUNCH
    a.ph_lo = 0; a.ph_hi = NPH;
    hipLaunchKernelGGL(mega_fwd, dim3(grid), dim3(NWAVES * 64), LDS_BYTES, stream, a);
#else
    for (int p = 0; p < NPH; ++p) { a.ph_lo = p; a.ph_hi = p + 1; hipLaunchKernelGGL(mega_fwd, dim3(grid), dim3(NWAVES * 64), LDS_BYTES, stream, a); }
#endif
}
```
